# Optimizing an MI355X kernel written in HIP

```python
import math
import jax, jax.numpy as jnp
from jax import lax
import numpy as np

D_MODEL = 1024
BATCH = 16
SEQ = 4096
DEPTH = 1
DEC_BATCH = 2
DEC_SEQ = 8192
PAST_LEN = 128

A_HEADS = 8
A_QK_DIM = 64
A_V_DIM = 2 * A_QK_DIM
A_QK_WIDTH = 2 * A_HEADS * A_QK_DIM
A_WIDTH = A_HEADS * A_V_DIM
B_HEADS = 8
B_KV_HEADS = 2
B_GROUP = B_HEADS // B_KV_HEADS
B_HEAD_DIM = 128
B_WIDTH = B_HEADS * B_HEAD_DIM
B_KV_WIDTH = B_KV_HEADS * B_HEAD_DIM
ROPE_AXIS_DIM = B_HEAD_DIM // 2
ROPE_THETA = 10000.0
GRID_W = 64
REL_BUCKETS = 32
REL_MAX_DIST = 128
Q_BLOCK = 128
EPS = 1e-6
IN_SIZES = (A_QK_WIDTH, A_QK_WIDTH, A_WIDTH, A_WIDTH, B_WIDTH, B_KV_WIDTH, B_KV_WIDTH, B_WIDTH, D_MODEL, D_MODEL)
IN_WIDTH = 2 * A_QK_WIDTH + 2 * A_WIDTH + 2 * B_WIDTH + 2 * B_KV_WIDTH + 2 * D_MODEL

kernel_name = "hybrid_gated_diffattn_gqa_axialrope_encoder"


def _rms_norm(x, g):
    x32 = x.astype(jnp.float32)
    y = x32 * lax.rsqrt(jnp.mean(x32 * x32, axis=-1, keepdims=True) + EPS)
    return (y * g.astype(jnp.float32)).astype(x.dtype)


def _to_blocks(q):
    shp = q.shape
    q = q.reshape(shp[:-2] + (shp[-2] // Q_BLOCK, Q_BLOCK, shp[-1]))
    return jnp.moveaxis(q, -3, 0)


def _from_blocks(o):
    o = jnp.moveaxis(o, 0, -3)
    shp = o.shape
    return o.reshape(shp[:-3] + (shp[-3] * shp[-2], shp[-1]))


def _rel_bucket(rel):
    half = REL_BUCKETS // 2
    max_exact = half // 2
    ret = (rel > 0).astype(jnp.int32) * half
    n = jnp.abs(rel)
    nf = jnp.maximum(n, 1).astype(jnp.float32)
    large = max_exact + (jnp.log(nf / max_exact) / math.log(REL_MAX_DIST / max_exact)
                         * (half - max_exact)).astype(jnp.int32)
    large = jnp.minimum(large, half - 1)
    return ret + jnp.where(n < max_exact, n, large)


def _diff_attention(q1, q2, k1, k2, v, rel_bias, lam):
    S = q1.shape[2]
    nb = S // Q_BLOCK
    scale = A_QK_DIM ** -0.5
    kpos = jnp.arange(S, dtype=jnp.int32)

    def blk(args):
        i, qa, qb = args
        qpos = i * Q_BLOCK + jnp.arange(Q_BLOCK, dtype=jnp.int32)
        bucket = _rel_bucket(kpos[None, :] - qpos[:, None])
        bias = jnp.transpose(rel_bias[bucket], (2, 0, 1)).astype(jnp.float32)
        s1 = jnp.einsum('bhqd,bhkd->bhqk', qa, k1).astype(jnp.float32) * scale + bias
        s2 = jnp.einsum('bhqd,bhkd->bhqk', qb, k2).astype(jnp.float32) * scale + bias
        p = jax.nn.softmax(s1, axis=-1) - lam * jax.nn.softmax(s2, axis=-1)
        return jnp.einsum('bhqk,bhkd->bhqd', p.astype(v.dtype), v)

    out = lax.map(blk, (jnp.arange(nb, dtype=jnp.int32), _to_blocks(q1), _to_blocks(q2)))
    return _from_blocks(out)


def _gqa_attention(q, k, v):
    scale = B_HEAD_DIM ** -0.5

    def blk(qb):
        s = jnp.einsum('bngqd,bnkd->bngqk', qb, k).astype(jnp.float32) * scale
        p = jax.nn.softmax(s, axis=-1)
        return jnp.einsum('bngqk,bnkd->bngqd', p.astype(v.dtype), v)

    return _from_blocks(lax.map(blk, _to_blocks(q)))


def _axial_angles(S):
    rows = S // GRID_W
    row_idx = jnp.repeat(jnp.arange(rows, dtype=jnp.float32), GRID_W)
    col_idx = jnp.tile(jnp.arange(GRID_W, dtype=jnp.float32), rows)
    inv_freq = ROPE_THETA ** (-jnp.arange(0, ROPE_AXIS_DIM, 2, dtype=jnp.float32) / ROPE_AXIS_DIM)
    ang_r = row_idx[:, None] * inv_freq[None, :]
    ang_c = col_idx[:, None] * inv_freq[None, :]
    return jnp.cos(ang_r), jnp.sin(ang_r), jnp.cos(ang_c), jnp.sin(ang_c)


def _rot(u, c, s):
    h = u.shape[-1] // 2
    u1, u2 = u[..., :h], u[..., h:]
    return jnp.concatenate([u1 * c - u2 * s, u1 * s + u2 * c], axis=-1)


def _apply_axial_rope(x, angles):
    cr, sr, cc, sc = [a[:, None, :] for a in angles]
    x32 = x.astype(jnp.float32)
    out = jnp.concatenate([_rot(x32[..., :ROPE_AXIS_DIM], cr, sr),
                           _rot(x32[..., ROPE_AXIS_DIM:], cc, sc)], axis=-1)
    return out.astype(x.dtype)


def _layer(x, l, g_norm, w_in, lambda_q1, lambda_k1, lambda_q2, lambda_k2, subln_w,
           q_norm_b, k_norm_b, w_proj_a, w_proj_b, w_out, rel_bias):
    B, S, _ = x.shape
    xn = _rms_norm(x, g_norm)
    proj = xn @ w_in
    offs = [int(o) for o in np.cumsum(IN_SIZES)[:-1]]
    qa, ka, va, za, qb, kb, vb, zb, ga, gb = jnp.split(proj, offs, axis=-1)

    lambda_init = 0.8 - 0.6 * math.exp(-0.3 * l)
    qa = jnp.transpose(qa.reshape(B, S, A_HEADS, 2, A_QK_DIM), (3, 0, 2, 1, 4))
    ka = jnp.transpose(ka.reshape(B, S, A_HEADS, 2, A_QK_DIM), (3, 0, 2, 1, 4))
    va = jnp.transpose(va.reshape(B, S, A_HEADS, A_V_DIM), (0, 2, 1, 3))
    lam = (jnp.exp(jnp.sum(lambda_q1.astype(jnp.float32) * lambda_k1.astype(jnp.float32)))
           - jnp.exp(jnp.sum(lambda_q2.astype(jnp.float32) * lambda_k2.astype(jnp.float32)))
           + lambda_init)
    oa = _diff_attention(qa[0], qa[1], ka[0], ka[1], va, rel_bias, lam)
    oa = _rms_norm(oa, subln_w) * (1.0 - lambda_init)
    oa = jnp.transpose(oa, (0, 2, 1, 3)).reshape(B, S, A_WIDTH)
    ya = (oa * jax.nn.silu(za)) @ w_proj_a

    angles = _axial_angles(S)
    qb = _apply_axial_rope(_rms_norm(qb.reshape(B, S, B_HEADS, B_HEAD_DIM), q_norm_b), angles)
    kb = _apply_axial_rope(_rms_norm(kb.reshape(B, S, B_KV_HEADS, B_HEAD_DIM), k_norm_b), angles)
    qb = jnp.transpose(qb.reshape(B, S, B_KV_HEADS, B_GROUP, B_HEAD_DIM), (0, 2, 3, 1, 4))
    kb = jnp.transpose(kb, (0, 2, 1, 3))
    vb = jnp.transpose(vb.reshape(B, S, B_KV_HEADS, B_HEAD_DIM), (0, 2, 1, 3))
    ob = _gqa_attention(qb, kb, vb)
    ob = jnp.transpose(ob, (0, 3, 1, 2, 4)).reshape(B, S, B_WIDTH)
    yb = (ob * jax.nn.silu(zb)) @ w_proj_b

    merged = jax.nn.sigmoid(ga) * ya + jax.nn.sigmoid(gb) * yb
    return x + merged @ w_out


def _trunk(x, g_norm, w_in, lambda_q1, lambda_k1, lambda_q2, lambda_k2, subln_w,
           q_norm_b, k_norm_b, w_proj_a, w_proj_b, w_out, rel_bias, g_final):
    h = x
    for l in range(DEPTH):
        h = _layer(h, l, g_norm[l], w_in[l], lambda_q1[l], lambda_k1[l], lambda_q2[l], lambda_k2[l],
                   subln_w[l], q_norm_b[l], k_norm_b[l], w_proj_a[l], w_proj_b[l], w_out[l], rel_bias)
    return _rms_norm(h, g_final)


def setup_inputs(seed: int = 0) -> dict:
    key = jax.random.key(seed)
    ks = jax.random.split(key, 18)
    f32 = jnp.float32
    nrm = lambda k, shp, s: jax.random.normal(k, shp, f32) * s
    return {
        "x_prompt": nrm(ks[0], (BATCH, SEQ, D_MODEL), 1.0),
        "x_sample": nrm(ks[1], (DEC_BATCH, DEC_SEQ, D_MODEL), 1.0),
        "g_norm": 1.0 + nrm(ks[2], (DEPTH, D_MODEL), 0.02),
        "w_in": nrm(ks[3], (DEPTH, D_MODEL, IN_WIDTH), D_MODEL ** -0.5),
        "lambda_q1": nrm(ks[4], (DEPTH, A_QK_DIM), 0.1),
        "lambda_k1": nrm(ks[5], (DEPTH, A_QK_DIM), 0.1),
        "lambda_q2": nrm(ks[6], (DEPTH, A_QK_DIM), 0.1),
        "lambda_k2": nrm(ks[7], (DEPTH, A_QK_DIM), 0.1),
        "subln_w": 1.0 + nrm(ks[8], (DEPTH, A_V_DIM), 0.02),
        "q_norm_b": 1.0 + nrm(ks[9], (DEPTH, B_HEAD_DIM), 0.02),
        "k_norm_b": 1.0 + nrm(ks[10], (DEPTH, B_HEAD_DIM), 0.02),
        "w_proj_a": nrm(ks[11], (DEPTH, A_WIDTH, D_MODEL), A_WIDTH ** -0.5),
        "w_proj_b": nrm(ks[12], (DEPTH, B_WIDTH, D_MODEL), B_WIDTH ** -0.5),
        "w_out": nrm(ks[13], (DEPTH, D_MODEL, D_MODEL), D_MODEL ** -0.5),
        "rel_bias": nrm(ks[14], (REL_BUCKETS, A_HEADS), 0.3),
        "g_final": 1.0 + nrm(ks[15], (D_MODEL,), 0.02),
    }


def reference(x_prompt, x_sample, g_norm, w_in, lambda_q1, lambda_k1, lambda_q2, lambda_k2, subln_w,
              q_norm_b, k_norm_b, w_proj_a, w_proj_b, w_out, rel_bias, g_final):
    y_prompt = _trunk(x_prompt, g_norm, w_in, lambda_q1, lambda_k1, lambda_q2, lambda_k2, subln_w,
                      q_norm_b, k_norm_b, w_proj_a, w_proj_b, w_out, rel_bias, g_final)
    y_sample = _trunk(x_sample, g_norm, w_in, lambda_q1, lambda_k1, lambda_q2, lambda_k2, subln_w,
                      q_norm_b, k_norm_b, w_proj_a, w_proj_b, w_out, rel_bias, g_final)
    return (y_prompt, y_sample)
```

```cpp
#include <hip/hip_runtime.h>
#include <hip/hip_cooperative_groups.h>
#include <cstdio>
#include <cstdint>
namespace cg = cooperative_groups;

constexpr int DM = 1024;
constexpr int NTOK = 81920, NPTOK = 65536;
constexpr int GMAX = 49152, G1BASE = 49152, G1ROWS = 32768, G1SAMPLE = 16384;
constexpr int NGRP = 2;
constexpr int NIN = 8704;
constexpr float EPS = 1e-6f;
#ifndef PROBE
#define PROBE 0
#endif
namespace pg8 {
#define PG8_LAS __attribute__((address_space(3)))
typedef unsigned short bf16_t;
typedef short bf16x8 __attribute__((ext_vector_type(8)));
typedef float f32x4 __attribute__((ext_vector_type(4)));
typedef unsigned u32x4 __attribute__((ext_vector_type(4)));
constexpr int BM = 256, BK = 64, HALF = 128, HTB = HALF * BK * 2  , STAGE_BYTES = 8 * HTB, NXCD = 8, WGM = 8;

__host__ __device__ __forceinline__ int lds_byte(int r, int c) { const int st = (r >> 4) * 2 + (c >> 5), rr = r & 15, cc = c & 31, ob = rr * 64 + cc * 2; return st * 1024 + (ob ^ (((ob >> 9) & 1) << 5)); }
__host__ __device__ __forceinline__ void stage_rc(int b, int& R, int& C) { const int st = b / 1024, sb = b % 1024, swz = sb ^ (((sb >> 9) & 1) << 5); R = (st >> 1) * 16 + swz / 64; C = (st & 1) * 32 + (swz % 64) / 2; }
__host__ __device__ __forceinline__ int perm32(int rho) { const int n = rho >> 4, i = rho & 15; return 8 * (i >> 2) + 4 * n + (i & 3); }

struct Unit { int pm, pn, sec; };
struct Gemm { const bf16_t* A; const bf16_t* Bt; int M, N, K; const bf16_t* A2; const bf16_t* Bt2; };

struct StaticOrder {
    int nM, nN, nwg, G, c;
    __host__ __device__ void init(int M, int N, int G_, int c_) { nM = M / BM; nN = N / BM; nwg = nM * nN; G = G_; c = c_; }
    __host__ __device__ bool next(int i, Unit& u) const {
        const long L = (long)i * G + c; if (L >= nwg) return false;
        int wgid = (int)L; { const int q = nwg / NXCD, r = nwg % NXCD, xcd = wgid % NXCD, off = wgid / NXCD; wgid = (xcd < r ? xcd * (q + 1) : r * (q + 1) + (xcd - r) * q) + off; }
        const int nig = WGM * nN, gid = wgid / nig, fm = gid * WGM, gsz = (nM - fm) < WGM ? (nM - fm) : WGM;
        u.pm = fm + ((wgid % nig) % gsz); u.pn = (wgid % nig) / gsz; u.sec = 0; return true;
    }
    __device__ __forceinline__ void a_ready(const Unit&) const {}
    __device__ __forceinline__ void done(const Unit&) const {}
};
struct PairOrder {
    StaticOrder S;
    __host__ __device__ void init(int M, int N, int G_, int c_) { S.init(M, N, G_, c_); }
    __host__ __device__ bool next(int i, Unit& u) const { if (!S.next(i >> 1, u)) return false; u.sec = i & 1; return true; }
    __device__ __forceinline__ void a_ready(const Unit&) const {}
    __device__ __forceinline__ void done(const Unit&) const {}
};
__device__ __forceinline__ unsigned cvt_pk_bf16(float lo, float hi) { unsigned r; asm volatile("v_cvt_pk_bf16_f32 %0, %1, %2" : "=v"(r) : "v"(lo), "v"(hi)); return r; }
typedef float f32x2 __attribute__((ext_vector_type(2)));
typedef unsigned u32x4e __attribute__((ext_vector_type(4)));
constexpr size_t BUFE = (size_t)49152 * 1024;
__device__ __forceinline__ float bf2f(unsigned short v) { return __uint_as_float(((unsigned)v) << 16); }
__device__ __forceinline__ float sigm(float x) { return __builtin_amdgcn_rcpf(1.0f + __builtin_amdgcn_exp2f(-1.4426950408889634f * x)); }

struct EpiProj { static constexpr bool PERM = true, AFTER_DRAIN = false;
    bf16_t* big; bf16_t* kb; bf16_t* vb;
    __device__ __forceinline__ void operator()(const f32x4 (&acc)[2][2][4][2], const Unit& u, int wr, int wc, int fr, int fq) const {
        const int pn = u.pn; bf16_t* base; int ldc, colt;
        if (pn < 20) { base = big + (size_t)(pn >> 2) * BUFE; ldc = 1024; colt = (pn & 3) * 256; }
        else if (pn == 20) { base = kb; ldc = 256; colt = 0; }
        else if (pn == 21) { base = vb; ldc = 256; colt = 0; }
        else { const int q = pn - 22; base = big + (size_t)(5 + (q >> 2)) * BUFE; ldc = 1024; colt = (q & 3) * 256; }
        const int row0 = u.pm * BM + wr * 64 + fr, col0 = colt + wc * 32 + 8 * fq;
        const float sc = pn < 4 ? 0.125f * 1.4426950408889634f : 1.0f;
#pragma unroll
        for (int ai = 0; ai < 2; ++ai)
#pragma unroll
            for (int m = 0; m < 4; ++m) { bf16_t* rowp = base + (size_t)(row0 + ai * HALF + m * 16) * ldc + col0;
#pragma unroll
                for (int bj = 0; bj < 2; ++bj) { const f32x4 v0 = acc[ai][bj][m][0] * sc, v1 = acc[ai][bj][m][1] * sc;
                    u32x4 w; w.x = cvt_pk_bf16(v0[0], v0[1]); w.y = cvt_pk_bf16(v0[2], v0[3]); w.z = cvt_pk_bf16(v1[0], v1[1]); w.w = cvt_pk_bf16(v1[2], v1[3]);
                    *(u32x4*)(rowp + bj * HALF) = w; } }
    }
};
__device__ __forceinline__ float en2(unsigned hbits) { return __builtin_amdgcn_exp2f(-1.4426950408889634f * __uint_as_float(hbits)); }
struct EpiPair { static constexpr bool PERM = true, AFTER_DRAIN = false;
    const bf16_t* ga; const bf16_t* gb; bf16_t* merged;
    __device__ __forceinline__ void operator()(f32x4 (&acc)[2][2][4][2], const Unit& u, int wr, int wc, int fr, int fq) const {
        const int row0 = u.pm * BM + wr * 64 + fr, col0 = u.pn * BM + wc * 32 + 8 * fq;
        if (u.sec == 0) {
#pragma unroll
            for (int ai = 0; ai < 2; ++ai)
#pragma unroll
                for (int m = 0; m < 4; ++m) { const size_t off = (size_t)(row0 + ai * HALF + m * 16) * 1024 + col0;
#pragma unroll
                    for (int bj = 0; bj < 2; ++bj) { const u32x4 av = *(const u32x4*)(ga + off + bj * HALF), bv = *(const u32x4*)(gb + off + bj * HALF);
                        const unsigned aw[4] = {av.x, av.y, av.z, av.w}, bw[4] = {bv.x, bv.y, bv.z, bv.w};
#pragma unroll
                        for (int q = 0; q < 4; ++q) { const int n = q >> 1, e = (q & 1) * 2;
                            const float r0 = (1.0f + en2(bw[q] << 16)) * __builtin_amdgcn_rcpf(1.0f + en2(aw[q] << 16));
                            const float r1 = (1.0f + en2(bw[q] & 0xffff0000u)) * __builtin_amdgcn_rcpf(1.0f + en2(aw[q] & 0xffff0000u));
                            acc[ai][bj][m][n][e] *= r0; acc[ai][bj][m][n][e + 1] *= r1; } } }
        } else {
#pragma unroll
            for (int ai = 0; ai < 2; ++ai)
#pragma unroll
                for (int m = 0; m < 4; ++m) { const size_t off = (size_t)(row0 + ai * HALF + m * 16) * 1024 + col0;
#pragma unroll
                    for (int bj = 0; bj < 2; ++bj) { const u32x4 gv = *(const u32x4*)(gb + off + bj * HALF);
                        const f32x4 v0 = acc[ai][bj][m][0], v1 = acc[ai][bj][m][1];
                        u32x4 w; w.x = cvt_pk_bf16(v0[0] * sigm(__uint_as_float(gv.x << 16)), v0[1] * sigm(__uint_as_float(gv.x & 0xffff0000u)));
                        w.y = cvt_pk_bf16(v0[2] * sigm(__uint_as_float(gv.y << 16)), v0[3] * sigm(__uint_as_float(gv.y & 0xffff0000u)));
                        w.z = cvt_pk_bf16(v1[0] * sigm(__uint_as_float(gv.z << 16)), v1[1] * sigm(__uint_as_float(gv.z & 0xffff0000u)));
                        w.w = cvt_pk_bf16(v1[2] * sigm(__uint_as_float(gv.w << 16)), v1[3] * sigm(__uint_as_float(gv.w & 0xffff0000u)));
                        *(u32x4*)(merged + off + bj * HALF) = w; } }
        }
    }
};
struct EpiOut { static constexpr bool PERM = true, AFTER_DRAIN = false;
    float* out; int base;
    __device__ __forceinline__ void operator()(const f32x4 (&acc)[2][2][4][2], const Unit& u, int wr, int wc, int fr, int fq) const {
        bf16_t* ob = (bf16_t*)(out + ((size_t)base + (size_t)u.pm * BM) * 1024);
        const int row0 = wr * 64 + fr, col0 = u.pn * BM + wc * 32 + 8 * fq;
#pragma unroll
        for (int ai = 0; ai < 2; ++ai)
#pragma unroll
            for (int m = 0; m < 4; ++m) { bf16_t* rowp = ob + (size_t)(row0 + ai * HALF + m * 16) * 2048 + col0;
#pragma unroll
                for (int bj = 0; bj < 2; ++bj) { const f32x4 v0 = acc[ai][bj][m][0], v1 = acc[ai][bj][m][1];
                    u32x4 w; w.x = cvt_pk_bf16(v0[0], v0[1]); w.y = cvt_pk_bf16(v0[2], v0[3]); w.z = cvt_pk_bf16(v1[0], v1[1]); w.w = cvt_pk_bf16(v1[2], v1[3]);
                    *(u32x4*)(rowp + bj * HALF) = w; } }
    }
};
template <class Epi, class Sched, bool ALIGN_EPI = false, bool SP2 = false>
__device__ __forceinline__ void gemm_phase(PG8_LAS unsigned char* lds, const Gemm g, const Sched& S, const Epi& E) {
    int tid_ = threadIdx.x; asm volatile("" : "+v"(tid_));
    const int tid = tid_, wid = __builtin_amdgcn_readfirstlane(tid >> 6), lane = tid & 63, wr = wid >> 2, wc = wid & 3, fr = lane & 15, fq = lane >> 4;
    const int K = g.K, nt = K / BK;
    unsigned voffA[2], voffB[2];
#pragma unroll
    for (int i = 0; i < 2; ++i) { int R, C; stage_rc(tid * 16 + i * 8192, R, C); const int Rb = Epi::PERM ? ((R & ~31) + perm32(R & 31)) : R;
        voffA[i] = (unsigned)(R * K + C) * 2u; voffB[i] = (unsigned)(Rb * K + C) * 2u; }
    const size_t kstep = (size_t)(BK * 2);
    const size_t hstep = (size_t)HALF * K * 2;
    const size_t tstep = 2 * hstep;
    const unsigned ldsw = (unsigned)wid * 1024u;
    const int aoff = lds_byte(wr * 64 + fr, fq * 8), boff = lds_byte(wc * 32 + fr, fq * 8);
#define PG8_SA(b, h) (((b) * 2 + (h)) * HTB)
#define PG8_SB(b, h) ((4 + (b) * 2 + (h)) * HTB)
#define PG8_STAGE(bufoff, gbase, voff) do { _Pragma("unroll") for (int _i = 0; _i < 2; ++_i) \
        __builtin_amdgcn_global_load_lds((const unsigned*)((const char*)(gbase) + (voff)[_i]), (PG8_LAS unsigned*)(lds + (bufoff) + ldsw + _i * 8192), 16, 0, 0); } while (0)
#define PG8_LDA(dst, b, h) do { _Pragma("unroll") for (int m = 0; m < 4; ++m) _Pragma("unroll") for (int k = 0; k < 2; ++k) dst[m][k] = *(const PG8_LAS bf16x8*)(lds + PG8_SA(b, h) + aoff + m * 2048 + k * 1024); } while (0)
#define PG8_LDB(dst, b, h) do { _Pragma("unroll") for (int n = 0; n < 2; ++n) _Pragma("unroll") for (int k = 0; k < 2; ++k) dst[n][k] = *(const PG8_LAS bf16x8*)(lds + PG8_SB(b, h) + boff + n * 2048 + k * 1024); } while (0)
#define PG8_MMA(ai, bj, At, Bt) do { __builtin_amdgcn_s_setprio(1); _Pragma("unroll") for (int m = 0; m < 4; ++m) _Pragma("unroll") for (int n = 0; n < 2; ++n) _Pragma("unroll") for (int k = 0; k < 2; ++k) \
        acc[ai][bj][m][n] = __builtin_amdgcn_mfma_f32_16x16x32_bf16(Bt[n][k], At[m][k], acc[ai][bj][m][n], 0, 0, 0); __builtin_amdgcn_s_setprio(0); } while (0)
#define PG8_WAIT_V(n) asm volatile("s_waitcnt vmcnt(" #n ")" ::: "memory")
#define PG8_WAIT_L(n) asm volatile("s_waitcnt lgkmcnt(" #n ")" ::: "memory")
#define PG8_BAR __builtin_amdgcn_s_barrier()
#define PG8_SCHED __builtin_amdgcn_sched_barrier(0)
    Unit cur, nxt; int ui = 0;
    if (!S.next(0, cur)) return;
    f32x4 acc[2][2][4][2];
#pragma unroll
    for (int a = 0; a < 2; ++a)
#pragma unroll
        for (int b = 0; b < 2; ++b)
#pragma unroll
            for (int m = 0; m < 4; ++m)
#pragma unroll
                for (int n = 0; n < 2; ++n) acc[a][b][m][n] = (f32x4){0.f, 0.f, 0.f, 0.f};
    bf16x8 At[4][2], B0[2][2], B1[2][2];
    const char* cA = (const char*)(cur.sec ? g.A2 : g.A) + (size_t)cur.pm * tstep; const char* cB = (const char*)(cur.sec ? g.Bt2 : g.Bt) + (size_t)cur.pn * tstep;
    S.a_ready(cur);
    if constexpr (SP2) {
        PG8_STAGE(PG8_SB(0, 0), cB, voffB); PG8_STAGE(PG8_SB(0, 1), cB + hstep, voffB); PG8_STAGE(PG8_SA(0, 0), cA, voffA); PG8_STAGE(PG8_SA(0, 1), cA + hstep, voffA);
        if (wr == 1) PG8_BAR;
        PG8_WAIT_V(2); PG8_BAR;
        PG8_STAGE(PG8_SB(1, 0), cB + kstep, voffB); PG8_STAGE(PG8_SA(1, 0), cA + kstep, voffA); PG8_STAGE(PG8_SB(1, 1), cB + hstep + kstep, voffB);
        PG8_WAIT_V(6); PG8_BAR;
    } else {
        PG8_STAGE(PG8_SB(0, 0), cB, voffB); PG8_STAGE(PG8_SA(0, 0), cA, voffA); PG8_STAGE(PG8_SB(0, 1), cB + hstep, voffB); PG8_STAGE(PG8_SA(0, 1), cA + hstep, voffA);
        if (wr == 1) PG8_BAR;
        PG8_WAIT_V(4); PG8_BAR;
        PG8_STAGE(PG8_SB(1, 0), cB + kstep, voffB); PG8_STAGE(PG8_SA(1, 0), cA + kstep, voffA); PG8_STAGE(PG8_SB(1, 1), cB + hstep + kstep, voffB);
        PG8_WAIT_V(6); PG8_BAR;
    }
    for (;;) {
        const bool has_next = S.next(ui + 1, nxt);
        const char* nA = has_next ? (const char*)(nxt.sec ? g.A2 : g.A) + (size_t)nxt.pm * tstep : cA; const char* nB = has_next ? (const char*)(nxt.sec ? g.Bt2 : g.Bt) + (size_t)nxt.pn * tstep : cB;
        for (int t = 0; t < nt; t += 2) {
            const bool last = (t == nt - 2);
            const char* a1 = cA + (size_t)(t + 1) * kstep;
            const char* a2 = last ? nA : cA + (size_t)(t + 2) * kstep; const char* b2 = last ? nB : cB + (size_t)(t + 2) * kstep;
            const char* a3 = a2 + kstep; const char* b3 = b2 + kstep;
            if (last && has_next) S.a_ready(nxt);
            if constexpr (SP2) {
            PG8_LDB(B0, 0, 0); PG8_LDB(B1, 0, 1); PG8_SCHED; PG8_LDA(At, 0, 0); PG8_STAGE(PG8_SA(1, 1), a1 + hstep, voffA);
            PG8_WAIT_V(8); PG8_WAIT_L(0); PG8_BAR; PG8_MMA(0, 0, At, B0); PG8_MMA(0, 1, At, B1); PG8_BAR; PG8_SCHED;
            PG8_LDA(At, 0, 1); PG8_STAGE(PG8_SB(0, 0), b2, voffB); PG8_STAGE(PG8_SB(0, 1), b2 + hstep, voffB); PG8_STAGE(PG8_SA(0, 0), a2, voffA);
            PG8_WAIT_V(8); PG8_WAIT_L(0); PG8_BAR; PG8_MMA(1, 0, At, B0); PG8_MMA(1, 1, At, B1); PG8_BAR; PG8_SCHED;
            PG8_LDB(B0, 1, 0); PG8_LDB(B1, 1, 1); PG8_SCHED; PG8_LDA(At, 1, 0); PG8_STAGE(PG8_SA(0, 1), a2 + hstep, voffA);
            PG8_WAIT_V(8); PG8_WAIT_L(0); PG8_BAR; PG8_MMA(0, 0, At, B0); PG8_MMA(0, 1, At, B1); PG8_BAR; PG8_SCHED;
            PG8_LDA(At, 1, 1); PG8_STAGE(PG8_SB(1, 0), b3, voffB); PG8_STAGE(PG8_SB(1, 1), b3 + hstep, voffB); PG8_STAGE(PG8_SA(1, 0), a3, voffA);
            PG8_WAIT_V(8); PG8_WAIT_L(0); PG8_BAR; PG8_MMA(1, 0, At, B0); PG8_MMA(1, 1, At, B1); PG8_BAR; PG8_SCHED;
            } else {
            PG8_LDB(B0, 0, 0); PG8_SCHED; PG8_LDA(At, 0, 0); PG8_STAGE(PG8_SA(1, 1), a1 + hstep, voffA);
            PG8_WAIT_L(8); PG8_BAR; PG8_WAIT_L(0); PG8_MMA(0, 0, At, B0); PG8_BAR; PG8_SCHED;
            PG8_LDB(B1, 0, 1); PG8_STAGE(PG8_SB(0, 0), b2, voffB);
            PG8_BAR; PG8_WAIT_L(0); PG8_MMA(0, 1, At, B1); PG8_BAR;
            PG8_LDA(At, 0, 1); PG8_STAGE(PG8_SA(0, 0), a2, voffA);
            PG8_BAR; PG8_WAIT_L(0); PG8_MMA(1, 0, At, B0); PG8_BAR; PG8_SCHED;
            PG8_STAGE(PG8_SB(0, 1), b2 + hstep, voffB);
            PG8_WAIT_V(6); PG8_BAR; PG8_MMA(1, 1, At, B1); PG8_BAR;
            PG8_LDB(B0, 1, 0); PG8_SCHED; PG8_LDA(At, 1, 0); PG8_STAGE(PG8_SA(0, 1), a2 + hstep, voffA);
            PG8_WAIT_L(8); PG8_BAR; PG8_WAIT_L(0); PG8_MMA(0, 0, At, B0); PG8_BAR; PG8_SCHED;
            PG8_LDB(B1, 1, 1); PG8_STAGE(PG8_SB(1, 0), b3, voffB);
            PG8_BAR; PG8_WAIT_L(0); PG8_MMA(0, 1, At, B1); PG8_BAR;
            PG8_LDA(At, 1, 1); PG8_STAGE(PG8_SA(1, 0), a3, voffA);
            PG8_BAR; PG8_WAIT_L(0); PG8_MMA(1, 0, At, B0); PG8_BAR; PG8_SCHED;
            PG8_STAGE(PG8_SB(1, 1), b3 + hstep, voffB);
            PG8_WAIT_V(6); PG8_BAR; PG8_MMA(1, 1, At, B1); PG8_BAR;
            }
        }
        if constexpr (ALIGN_EPI) { if (wr == 0) PG8_BAR; }
        if constexpr (!Epi::AFTER_DRAIN) { E(acc, cur, wr, wc, fr, fq); S.done(cur); }
        if (!has_next) break;
        if (!nxt.sec)
#pragma unroll
        for (int a = 0; a < 2; ++a)
#pragma unroll
            for (int b = 0; b < 2; ++b)
#pragma unroll
                for (int m = 0; m < 4; ++m)
#pragma unroll
                    for (int n = 0; n < 2; ++n) acc[a][b][m][n] = (f32x4){0.f, 0.f, 0.f, 0.f};
        cur = nxt; cA = nA; cB = nB; ++ui;
        if constexpr (ALIGN_EPI) { if (wr == 1) PG8_BAR; }
    }
    PG8_WAIT_V(0);
    if constexpr (!ALIGN_EPI) { if (wr == 0) PG8_BAR; }
    PG8_BAR;
    if constexpr (Epi::AFTER_DRAIN) { E.fused(acc, cur, wr, wc, fr, fq, lds, wid, lane); S.done(cur); }
#undef PG8_SA
#undef PG8_SB
#undef PG8_STAGE
#undef PG8_LDA
#undef PG8_LDB
#undef PG8_MMA
#undef PG8_WAIT_V
#undef PG8_WAIT_L
#undef PG8_BAR
#undef PG8_SCHED
}
}
namespace att {
typedef unsigned short bf16_t;
using bf16x8 = __attribute__((ext_vector_type(8))) short;
using s16x4  = __attribute__((ext_vector_type(4))) short;
using f32x16 = __attribute__((ext_vector_type(16))) float;
using f32x4  = __attribute__((ext_vector_type(4))) float;
using f32x2  = __attribute__((ext_vector_type(2))) float;
using u32x4  = __attribute__((ext_vector_type(4))) unsigned;
constexpr int NW = 8, QBLK = 32, KVBLK = 64;
constexpr int SHM_V = 16384, SHM_K = 16384;
constexpr int LDS_WSOFF = 3 * SHM_V + 4 * SHM_K;
constexpr int LDS_TB = LDS_WSOFF + NW * 64 * 4;
constexpr int ATT_LDS = LDS_TB + 1024;
constexpr float THR = 8.f;
#define KSWZ128(row, colB) ((row) * 256 + ((colB) ^ (((row) & 7) << 4)))
#define KSWZ64(row, colB)  ((row) * 128 + ((colB) ^ ((((row) >> 1) & 7) << 4)))
#define SBAR() __builtin_amdgcn_sched_barrier(0)
__device__ __forceinline__ int crow(int r, int hi) { return (r & 3) + 8 * (r >> 2) + 4 * hi; }
__device__ __forceinline__ unsigned cvtpk(float lo, float hi) { unsigned r; asm volatile("v_cvt_pk_bf16_f32 %0, %1, %2" : "=v"(r) : "v"(lo), "v"(hi)); return r; }
__device__ __forceinline__ bf16x8 ld8(const bf16_t* p) { return *reinterpret_cast<const bf16x8*>(p); }
__device__ __forceinline__ float bf2f(short v) { return __uint_as_float(((unsigned)(unsigned short)v) << 16); }

constexpr float THR2 = THR * 1.4426950408889634f;
template <int DK>
__device__ __forceinline__ void partialSM(f32x16& p0, f32x16& p1, float& m_reg, float& mn, float& alpha, const float cb) {
  float pmax = p0[0];
#pragma unroll
  for (int r = 1; r < 16; ++r) pmax = fmaxf(pmax, p0[r]);
#pragma unroll
  for (int r = 0; r < 16; ++r) pmax = fmaxf(pmax, p1[r]);
  { auto rr = __builtin_amdgcn_permlane32_swap(__float_as_uint(pmax), __float_as_uint(pmax), false, false);
    pmax = fmaxf(__uint_as_float(rr[0]), __uint_as_float(rr[1])); }
  pmax += cb;
  if (__builtin_expect(__all(pmax - m_reg <= THR2), 1)) { mn = m_reg; alpha = 1.f; }
  else { mn = fmaxf(m_reg, pmax); alpha = __builtin_amdgcn_exp2f(m_reg - mn); m_reg = mn; }
  const float mnC = cb - mn;
#pragma unroll
  for (int r = 0; r < 16; ++r) p0[r] += mnC;
#pragma unroll
  for (int r = 0; r < 16; ++r) p1[r] += mnC;
#pragma unroll
  for (int r = 0; r < 16; ++r) p0[r] = __builtin_amdgcn_exp2f(p0[r]);
}
template <bool NOEXP>
__device__ __forceinline__ void finishSM(f32x16& p0, f32x16& p1, float alpha, float& l_reg, bf16x8& pa0, bf16x8& pa1, bf16x8& pa2, bf16x8& pa3) {
  if constexpr (!NOEXP) {
#pragma unroll
  for (int r = 0; r < 16; ++r) p1[r] = __builtin_amdgcn_exp2f(p1[r]); }
  float ps = 0;
#pragma unroll
  for (int r = 0; r < 16; ++r) ps += p0[r];
#pragma unroll
  for (int r = 0; r < 16; ++r) ps += p1[r];
  { auto rr = __builtin_amdgcn_permlane32_swap(__float_as_uint(ps), __float_as_uint(ps), false, false);
    ps = __uint_as_float(rr[0]) + __uint_as_float(rr[1]); }
  l_reg = l_reg * alpha + ps;
#define PK4(P, BASE, OUT) do { unsigned a0 = cvtpk(P[BASE + 0], P[BASE + 1]), a1 = cvtpk(P[BASE + 2], P[BASE + 3]);   \
    unsigned b0 = cvtpk(P[BASE + 4], P[BASE + 5]), b1 = cvtpk(P[BASE + 6], P[BASE + 7]);                              \
    auto r0 = __builtin_amdgcn_permlane32_swap(a0, b0, false, false); auto r1 = __builtin_amdgcn_permlane32_swap(a1, b1, false, false); \
    u32x4 w = {r0[0], r1[0], r0[1], r1[1]}; OUT = *reinterpret_cast<bf16x8*>(&w); } while (0)
  PK4(p0, 0, pa0); PK4(p0, 8, pa1); PK4(p1, 0, pa2); PK4(p1, 8, pa3);
#undef PK4
}
__device__ __forceinline__ void add_bias(f32x16& p0, f32x16& p1, const float* tb, int relb, int hi) {
#pragma unroll
  for (int r = 0; r < 16; ++r) { const int i0 = relb + crow(r, hi), i1 = i0 + 32;
    p0[r] += tb[min(max(i0, 0), 255)]; p1[r] += tb[min(max(i1, 0), 255)]; }
}
template <int DK>
__device__ __forceinline__ void qkt(f32x16& p0, f32x16& p1, const char* Ks, const bf16x8* qr, int r32, int hi) {
  p0 = f32x16{}; p1 = f32x16{};
#pragma unroll
  for (int d0 = 0; d0 < DK / 16; ++d0) { const int cb = (d0 * 16 + hi * 8) * 2;
    bf16x8 b0, b1;
    if constexpr (DK == 128) { b0 = *reinterpret_cast<const bf16x8*>(Ks + KSWZ128(r32, cb)); b1 = *reinterpret_cast<const bf16x8*>(Ks + KSWZ128(32 + r32, cb)); }
    else { b0 = *reinterpret_cast<const bf16x8*>(Ks + KSWZ64(r32, cb)); b1 = *reinterpret_cast<const bf16x8*>(Ks + KSWZ64(32 + r32, cb)); }
    p0 = __builtin_amdgcn_mfma_f32_32x32x16_bf16(b0, qr[d0], p0, 0, 0, 0);
    p1 = __builtin_amdgcn_mfma_f32_32x32x16_bf16(b1, qr[d0], p1, 0, 0, 0); }
}
__device__ __forceinline__ int v_st(int k, int c) { const int kk = (k & ~0xC) | ((k & 4) << 1) | ((k & 8) >> 1); return ((kk >> 3) * 4 + (c >> 5)) * 512 + ((kk & 7) * 32 + (c & 31)) * 2; }
__device__ __forceinline__ int v_rd_base(int lane) { return ((lane & 3) << 3) | (((lane >> 2) & 3) << 6) | (((lane >> 4) & 1) << 5) | (((lane >> 5) & 1) << 8); }
constexpr int v_rd_off(int d0, int ks, int half) { return d0 * 512 + ks * 4096 + half * 2048; }
template <int OFF> __device__ __forceinline__ s16x4 tr_read(int vb) {
  s16x4 r; asm volatile("ds_read_b64_tr_b16 %0, %1 offset:%2" : "=&v"(r) : "v"(vb), "i"(OFF) : "memory"); return r;
}
template <int D0> __device__ __forceinline__ void pv_one(f32x16& od, int vb, bf16x8 pa0, bf16x8 pa1, bf16x8 pa2, bf16x8 pa3) {
  const s16x4 l0 = tr_read<v_rd_off(D0, 0, 0)>(vb), h0 = tr_read<v_rd_off(D0, 0, 1)>(vb), l1 = tr_read<v_rd_off(D0, 1, 0)>(vb), h1 = tr_read<v_rd_off(D0, 1, 1)>(vb);
  const s16x4 l2 = tr_read<v_rd_off(D0, 2, 0)>(vb), h2 = tr_read<v_rd_off(D0, 2, 1)>(vb), l3 = tr_read<v_rd_off(D0, 3, 0)>(vb), h3 = tr_read<v_rd_off(D0, 3, 1)>(vb);
  asm volatile("s_waitcnt lgkmcnt(0)" ::: "memory"); SBAR();
#define PK(L, H) (bf16x8){L[0], L[1], L[2], L[3], H[0], H[1], H[2], H[3]}
  od = __builtin_amdgcn_mfma_f32_32x32x16_bf16(pa0, PK(l0, h0), od, 0, 0, 0);
  od = __builtin_amdgcn_mfma_f32_32x32x16_bf16(pa1, PK(l1, h1), od, 0, 0, 0);
  od = __builtin_amdgcn_mfma_f32_32x32x16_bf16(pa2, PK(l2, h2), od, 0, 0, 0);
  od = __builtin_amdgcn_mfma_f32_32x32x16_bf16(pa3, PK(l3, h3), od, 0, 0, 0);
#undef PK
}
__device__ __forceinline__ void pv_d0(f32x16* o, int vb, bf16x8 pa0, bf16x8 pa1, bf16x8 pa2, bf16x8 pa3) {
  pv_one<0>(o[0], vb, pa0, pa1, pa2, pa3); pv_one<1>(o[1], vb, pa0, pa1, pa2, pa3); pv_one<2>(o[2], vb, pa0, pa1, pa2, pa3); pv_one<3>(o[3], vb, pa0, pa1, pa2, pa3);
}

typedef __attribute__((address_space(3))) const char* lds_cptr;
typedef short v4i16_t __attribute__((ext_vector_type(4)));
__device__ __forceinline__ s16x4 vtr(lds_cptr p) { return __builtin_bit_cast(s16x4, __builtin_amdgcn_ds_read_tr16_b64_v4i16((__attribute__((address_space(3))) v4i16_t*)p)); }
__device__ __forceinline__ float max3f(float a, float b, float c) { return fmaxf(fmaxf(a, b), c); }
#define PIN(x) asm volatile("" : "+v"(x))
#define PK4R(P, BASE, OUT) do { unsigned a0 = cvtpk(P[BASE + 0], P[BASE + 1]), a1 = cvtpk(P[BASE + 2], P[BASE + 3]);   \
    unsigned b0 = cvtpk(P[BASE + 4], P[BASE + 5]), b1 = cvtpk(P[BASE + 6], P[BASE + 7]);                              \
    auto r0 = __builtin_amdgcn_permlane32_swap(a0, b0, false, false); auto r1 = __builtin_amdgcn_permlane32_swap(a1, b1, false, false); \
    u32x4 w = {r0[0], r1[0], r0[1], r1[1]}; OUT = *reinterpret_cast<bf16x8*>(&w); } while (0)
template <int DK, bool NOMAX>
__device__ __forceinline__ void qk_fs(f32x16& c0, f32x16& c1, const char* Ks, const bf16x8* qr, const int r32, const int hi,
                                      f32x16& p0, f32x16& p1, const float alpha, float& l_reg, bf16x8* pa,
                                      bf16x8 (&kf)[2][2], const lds_cptr vp, s16x4 (&vl)[3], s16x4 (&vh)[3]) {
  constexpr int NS = DK / 16, RPS = 16 / NS;
#define KRD_(S, D0) do { const int cb_ = ((D0) * 16 + hi * 8) * 2; \
    if constexpr (DK == 128) { kf[S][0] = *reinterpret_cast<const bf16x8*>(Ks + KSWZ128(r32, cb_)); kf[S][1] = *reinterpret_cast<const bf16x8*>(Ks + KSWZ128(32 + r32, cb_)); } \
    else { kf[S][0] = *reinterpret_cast<const bf16x8*>(Ks + KSWZ64(r32, cb_)); kf[S][1] = *reinterpret_cast<const bf16x8*>(Ks + KSWZ64(32 + r32, cb_)); } } while (0)
  float psa = 0.f, psb = 0.f;
  SBAR();
#pragma unroll
  for (int d0 = 0; d0 < NS; ++d0) {
    if (d0 == 0) { c0 = __builtin_amdgcn_mfma_f32_32x32x16_bf16(kf[0][0], qr[0], f32x16{}, 0, 0, 0); c1 = __builtin_amdgcn_mfma_f32_32x32x16_bf16(kf[0][1], qr[0], f32x16{}, 0, 0, 0); }
    else { c0 = __builtin_amdgcn_mfma_f32_32x32x16_bf16(kf[d0 & 1][0], qr[d0], c0, 0, 0, 0); c1 = __builtin_amdgcn_mfma_f32_32x32x16_bf16(kf[d0 & 1][1], qr[d0], c1, 0, 0, 0); }
    if (d0 + 2 < NS) KRD_(d0 & 1, d0 + 2);
    if constexpr (NOMAX) { }
    else {
#pragma unroll
    for (int r = d0 * RPS; r < (d0 + 1) * RPS; ++r) { p1[r] = __builtin_amdgcn_exp2f(p1[r]); psa += p0[r]; }
    if (d0 > 0) {
#pragma unroll
      for (int r = (d0 - 1) * RPS; r < d0 * RPS; ++r) psb += p1[r]; } }
    if constexpr (NOMAX) {
      if (d0 == NS / 4 - 1) { PK4R(p0, 0, pa[0]); PIN(pa[0]); }
      if (d0 == NS / 2 - 1) { PK4R(p0, 8, pa[1]); PIN(pa[1]); }
      if (d0 == 3 * NS / 4 - 1) { PK4R(p1, 0, pa[2]); PIN(pa[2]); }
      if (d0 == NS - 1) { PK4R(p1, 8, pa[3]); PIN(pa[3]); }
    } else {
    if (d0 == NS / 2 - 1) { PK4R(p0, 0, pa[0]); PIN(pa[0]); }
    if (d0 == NS / 2) { PK4R(p0, 8, pa[1]); PIN(pa[1]); }
    if (d0 == NS - 1) { PK4R(p1, 0, pa[2]); PIN(pa[2]); }
    }
    if (d0 == NS - 1) {
      vl[0] = vtr(vp + v_rd_off(0, 0, 0)); vh[0] = vtr(vp + v_rd_off(0, 0, 1)); vl[1] = vtr(vp + v_rd_off(1, 0, 0)); vh[1] = vtr(vp + v_rd_off(1, 0, 1)); }
    PIN(p1); PIN(psa); PIN(psb);
    SBAR();
  }
#undef KRD_
  if constexpr (!NOMAX) {
#pragma unroll
  for (int r = (NS - 1) * RPS; r < 16; ++r) psb += p1[r];
  float ps = psa + psb;
  { auto rr = __builtin_amdgcn_permlane32_swap(__float_as_uint(ps), __float_as_uint(ps), false, false);
    ps = __uint_as_float(rr[0]) + __uint_as_float(rr[1]); }
  l_reg = l_reg * alpha + ps;
  PK4R(p1, 8, pa[3]); }
}
template <int DK, bool NOMAX>
__device__ __forceinline__ void pv_psm(f32x16* o, const lds_cptr vp, const bf16x8* pa, f32x16& c0, f32x16& c1, float& m_reg, float& alpha, const float cb,
                                       s16x4 (&vl)[3], s16x4 (&vh)[3], bf16x8 (&kf)[2][2], const char* Kn, const int r32, const int hi, float& l_reg) {
  float psa = 0.f, psb = 0.f;
#define VRD_(S, I) do { vl[S] = vtr(vp + v_rd_off((I) & 3, (I) >> 2, 0)); vh[S] = vtr(vp + v_rd_off((I) & 3, (I) >> 2, 1)); } while (0)
#define VFR_(S) (bf16x8){vl[S][0], vl[S][1], vl[S][2], vl[S][3], vh[S][0], vh[S][1], vh[S][2], vh[S][3]}
  float ma = 0.f, mb = 0.f, mnC = 0.f;
  SBAR();
#pragma unroll
  for (int i = 0; i < 16; ++i) {
    if (i + 2 < 16) VRD_((i + 2) % 3, i + 2);
    if (i == 12 || i == 13) { const int cb_ = ((i - 12) * 16 + hi * 8) * 2;
      if constexpr (DK == 128) { kf[i - 12][0] = *reinterpret_cast<const bf16x8*>(Kn + KSWZ128(r32, cb_)); kf[i - 12][1] = *reinterpret_cast<const bf16x8*>(Kn + KSWZ128(32 + r32, cb_)); }
      else { kf[i - 12][0] = *reinterpret_cast<const bf16x8*>(Kn + KSWZ64(r32, cb_)); kf[i - 12][1] = *reinterpret_cast<const bf16x8*>(Kn + KSWZ64(32 + r32, cb_)); } }
    SBAR();
    o[i & 3] = __builtin_amdgcn_mfma_f32_32x32x16_bf16(pa[i >> 2], VFR_(i % 3), o[i & 3], 0, 0, 0);
    if constexpr (NOMAX) { c0[i] = __builtin_amdgcn_exp2f(c0[i]); c1[i] = __builtin_amdgcn_exp2f(c1[i]); if (i > 0) { psa += c0[i - 1]; psb += c1[i - 1]; } PIN(c0); PIN(c1); PIN(psa); PIN(psb); }
    else {
    if (i == 0) { ma = max3f(c0[0], c0[1], c1[0]); mb = max3f(c0[2], c0[3], c1[1]); ma = max3f(ma, c1[2], c1[3]); }
    if (i >= 1 && i <= 3) { const int r = 4 * i; ma = max3f(ma, c0[r], c0[r + 1]); mb = max3f(mb, c0[r + 2], c0[r + 3]); ma = max3f(ma, c1[r], c1[r + 1]); mb = max3f(mb, c1[r + 2], c1[r + 3]); }
    if (i == 4) { float pmax = fmaxf(ma, mb);
      { auto rr = __builtin_amdgcn_permlane32_swap(__float_as_uint(pmax), __float_as_uint(pmax), false, false);
        pmax = fmaxf(__uint_as_float(rr[0]), __uint_as_float(rr[1])); }
      pmax += cb;
      const bool keep = __all(pmax - m_reg <= THR2);
      const float mn = keep ? m_reg : fmaxf(m_reg, pmax);
      alpha = __builtin_amdgcn_exp2f(m_reg - mn); m_reg = mn; mnC = cb - mn; }
    if (i >= 5 && i <= 8) { const int r = 4 * (i - 5);
#pragma unroll
      for (int q = 0; q < 4; ++q) { c0[r + q] += mnC; c1[r + q] += mnC; } }
    if (i >= 9) { const int r0 = (i - 9) * 2 + (i > 14 ? 1 : 0), n = i >= 14 ? 3 : 2;
#pragma unroll
      for (int q = 0; q < n; ++q) c0[r0 + q] = __builtin_amdgcn_exp2f(c0[r0 + q]); }
    if (i <= 3) { PIN(ma); PIN(mb); }
    if (i == 4) { PIN(mnC); PIN(alpha); PIN(m_reg); }
    if (i >= 5 && i <= 8) { PIN(c0); PIN(c1); }
    if (i >= 9) PIN(c0);
    }
    SBAR();
  }
#undef VRD_
#undef VFR_
  if constexpr (NOMAX) { float ps = (psa + c0[15]) + (psb + c1[15]);
    { auto rr = __builtin_amdgcn_permlane32_swap(__float_as_uint(ps), __float_as_uint(ps), false, false);
      ps = __uint_as_float(rr[0]) + __uint_as_float(rr[1]); }
    l_reg = l_reg * alpha + ps; }
}

constexpr int RING_K = 0, RING_V = 4 * SHM_K;
template <int DK, int LDK, bool BIAS, bool NOMAX>
__device__ __forceinline__ void flash_pass(const bf16x8* qr, const bf16_t* __restrict__ Kh, const bf16_t* __restrict__ Vh, const int seq, char* lds,
                                           f32x16* o, float& l_out, const int qlo, const float b_neg, const float b_pos) {
  int tid_ = threadIdx.x; asm volatile("" : "+v"(tid_));
  const int tid = tid_, lane = tid & 63, r32 = lane & 31, hi = lane >> 5; const int wid = __builtin_amdgcn_readfirstlane(tid >> 6);
  typedef __attribute__((address_space(3))) unsigned* lds_uptr;
  char* K_lds = lds + RING_K; char* V_lds = lds + RING_V;
  float* ws = (float*)(lds + LDS_WSOFF) + wid * 64; float* al_l = ws + 32;
  const float* tb = (const float*)(lds + LDS_TB);
  float m_reg = -1e30f, l_reg = 0.f;
  o[0] = f32x16{}; o[1] = f32x16{}; o[2] = f32x16{}; o[3] = f32x16{};
  int koff0, koff1 = 0, voff0, voff1;
  if constexpr (DK == 128) { { const int r = 4 * wid + (lane >> 4), c = (lane & 15) ^ (r & 7); koff0 = r * LDK + c * 8; }
                             { const int r = 4 * (wid + 8) + (lane >> 4), c = (lane & 15) ^ (r & 7); koff1 = r * LDK + c * 8; } }
  else { const int r = 8 * wid + (lane >> 3), c = (lane & 7) ^ ((r >> 1) & 7); koff0 = r * LDK + c * 8; }
  { const int st = 2 * wid + (lane >> 5), kk = (st >> 2) * 8 + ((lane & 31) >> 2), k = (kk & ~0xC) | ((kk & 4) << 1) | ((kk & 8) >> 1); voff0 = k * LDK + (st & 3) * 32 + (lane & 3) * 8; }
  { const int st = 2 * (wid + 8) + (lane >> 5), kk = (st >> 2) * 8 + ((lane & 31) >> 2), k = (kk & ~0xC) | ((kk & 4) << 1) | ((kk & 8) >> 1); voff1 = k * LDK + (st & 3) * 32 + (lane & 3) * 8; }
  const bf16_t* ks0 = Kh + koff0; const bf16_t* ks1 = Kh + koff1; const bf16_t* vs0 = Vh + voff0; const bf16_t* vs1 = Vh + voff1;
  const lds_uptr kdst = (lds_uptr)(K_lds + wid * 1024), vdst = (lds_uptr)(V_lds + wid * 1024);
#define GLDS(G, L) __builtin_amdgcn_global_load_lds((const unsigned*)(G), (L), 16, 0, 0)
#define DMA_K(T, SL) do { const long t_ = (long)(T) * (KVBLK * LDK); GLDS(ks0 + t_, (lds_uptr)((__attribute__((address_space(3))) char*)kdst + (SL))); \
    if constexpr (DK == 128) GLDS(ks1 + t_, (lds_uptr)((__attribute__((address_space(3))) char*)kdst + (SL) + 8192)); } while (0)
#define DMA_V(T, SL) do { const long t_ = (long)(T) * (KVBLK * LDK); GLDS(vs0 + t_, (lds_uptr)((__attribute__((address_space(3))) char*)vdst + (SL))); \
    GLDS(vs1 + t_, (lds_uptr)((__attribute__((address_space(3))) char*)vdst + (SL) + 8192)); } while (0)
#define WBAR(N) asm volatile("s_waitcnt vmcnt(" #N ") lgkmcnt(0)\n\ts_barrier" ::: "memory")
#define RESC(a) do { if (__any((a) != 1.f)) { if (hi == 0) al_l[r32] = (a); asm volatile("s_waitcnt lgkmcnt(0)" ::: "memory"); \
    _Pragma("unroll") for (int d = 0; d < 4; ++d) _Pragma("unroll") for (int r = 0; r < 16; ++r) o[d][r] *= al_l[crow(r, hi)]; } } while (0)
#define PSM(P0, P1, T, MN, AL) do { float cb_ = 0.f; \
    if constexpr (BIAS) { const int k0_ = (T) * KVBLK; const int rmin_ = k0_ - (qlo + 31), rmax_ = k0_ + 63 - qlo; \
      if (rmin_ >= 91) cb_ = b_pos; else if (rmax_ <= -91) cb_ = b_neg; \
      else add_bias(P0, P1, tb, k0_ - (qlo + r32) + 128, hi); } \
    partialSM<DK>(P0, P1, m_reg, MN, AL, cb_); } while (0)
#define TBIAS(P0, P1, T) float cb_ = 0.f; \
    if constexpr (BIAS) { const int k0_ = (T) * KVBLK; const int rmin_ = k0_ - (qlo + 31), rmax_ = k0_ + 63 - qlo; \
      if (rmin_ >= 91) cb_ = b_pos; else if (rmax_ <= -91) cb_ = b_neg; \
      else add_bias(P0, P1, tb, k0_ - (qlo + r32) + 128, hi); }
  float curb = 0.f;
  f32x16 pA0, pA1, pB0, pB1; float mnA, alA, alB; bf16x8 pa[4]; const int NT = seq / KVBLK;
  const lds_cptr vp0 = (lds_cptr)V_lds + v_rd_base(lane);
  const int vb0 = (int)(uintptr_t)V_lds + v_rd_base(lane);
  WBAR(0);
  DMA_K(0, 0); DMA_V(0, 0); DMA_K(1, SHM_K); DMA_K(2, 2 * SHM_K);
  if constexpr (DK == 128) WBAR(6); else WBAR(4);
  qkt<DK>(pA0, pA1, K_lds, qr, r32, hi);
  if constexpr (NOMAX) { TBIAS(pA0, pA1, 0); curb = cb_; alA = 1.f;
#pragma unroll
    for (int r = 0; r < 16; ++r) { pA0[r] = __builtin_amdgcn_exp2f(pA0[r]); pA1[r] = __builtin_amdgcn_exp2f(pA1[r]); }
    float ps0 = 0.f;
#pragma unroll
    for (int r = 0; r < 16; ++r) ps0 += pA0[r] + pA1[r];
    { auto rr = __builtin_amdgcn_permlane32_swap(__float_as_uint(ps0), __float_as_uint(ps0), false, false);
      ps0 = __uint_as_float(rr[0]) + __uint_as_float(rr[1]); }
    l_reg = ps0; }
  else PSM(pA0, pA1, 0, mnA, alA);
  DMA_K(3, 3 * SHM_K); DMA_V(1, SHM_V);
  if constexpr (DK == 128) WBAR(4); else WBAR(3);
  bf16x8 kf[2][2]; s16x4 vl[3], vh[3];
#pragma unroll
  for (int q = 0; q < 2; ++q) { const int cbq = (q * 16 + hi * 8) * 2;
    if constexpr (DK == 128) { kf[q][0] = *reinterpret_cast<const bf16x8*>(K_lds + SHM_K + KSWZ128(r32, cbq)); kf[q][1] = *reinterpret_cast<const bf16x8*>(K_lds + SHM_K + KSWZ128(32 + r32, cbq)); }
    else { kf[q][0] = *reinterpret_cast<const bf16x8*>(K_lds + SHM_K + KSWZ64(r32, cbq)); kf[q][1] = *reinterpret_cast<const bf16x8*>(K_lds + SHM_K + KSWZ64(32 + r32, cbq)); } }
  int sp = 0, sj = SHM_V, sn = 2 * SHM_V;
#define STEPT(C0, C1, P0, P1, ALP, ALC, J) do { \
    qk_fs<DK, NOMAX>(C0, C1, K_lds + ((J) & 3) * SHM_K, qr, r32, hi, P0, P1, ALP, l_reg, pa, kf, vp0 + sp, vl, vh); \
    if ((J) + 3 < NT) DMA_K((J) + 3, (((J) + 3) & 3) * SHM_K); if ((J) + 1 < NT) DMA_V((J) + 1, sn); SBAR(); \
    { TBIAS(C0, C1, J); if constexpr (NOMAX) { ALC = __builtin_amdgcn_exp2f(curb - cb_); curb = cb_; } \
      pv_psm<DK, NOMAX>(o, vp0 + sp, pa, C0, C1, m_reg, ALC, cb_, vl, vh, kf, K_lds + (((J) + 1) & 3) * SHM_K, r32, hi, l_reg); } \
    RESC(ALC); \
    if ((J) + 3 < NT) { if constexpr (DK == 128) WBAR(4); else WBAR(3); } else WBAR(0); \
    { const int t_ = sp; sp = sj; sj = sn; sn = t_; } } while (0)
  for (int j = 1; j + 1 < NT; j += 2) {
    STEPT(pB0, pB1, pA0, pA1, alA, alB, j);
    STEPT(pA0, pA1, pB0, pB1, alB, alA, j + 1);
  }
  STEPT(pB0, pB1, pA0, pA1, alA, alB, NT - 1);
  if constexpr (NOMAX) { PK4R(pB0, 0, pa[0]); PK4R(pB0, 8, pa[1]); PK4R(pB1, 0, pa[2]); PK4R(pB1, 8, pa[3]); }
  else finishSM<false>(pB0, pB1, alB, l_reg, pa[0], pa[1], pa[2], pa[3]);
  SBAR();
  pv_d0(o, vb0 + sp, pa[0], pa[1], pa[2], pa[3]);
  l_out = l_reg;
#undef GLDS
#undef DMA_K
#undef DMA_V
#undef WBAR
#undef RESC
#undef PSM
#undef TBIAS
#undef STEPT
}
__device__ __forceinline__ void row_rcp(float l_reg, float* ws, int r32, int hi, float* rli) {
  if (hi == 0) ws[r32] = l_reg; asm volatile("s_waitcnt lgkmcnt(0)" ::: "memory");
#pragma unroll
  for (int r = 0; r < 16; ++r) rli[r] = __builtin_amdgcn_rcpf(ws[crow(r, hi)]);
  asm volatile("s_waitcnt lgkmcnt(0)" ::: "memory");
}
__device__ __forceinline__ float silu(float z) { return z * __builtin_amdgcn_rcpf(1.0f + __builtin_amdgcn_exp2f(-1.4426950408889634f * z)); }
constexpr int STG_LD = 132;
constexpr int STG_WAVE = 32 * STG_LD * 4;
template <bool NORM>
__device__ __forceinline__ void out_rows(const f32x16* o, const float* rli_or_null, char* lds, const float* gain, const float gscale,
                                         const bf16_t* Z, bf16_t* O, const size_t obase  ) {
  int tid_ = threadIdx.x; asm volatile("" : "+v"(tid_));
  const int tid = tid_, wid = tid >> 6, lane = tid & 63, r32 = lane & 31, hi = lane >> 5;
  float* stg = (float*)(lds + wid * STG_WAVE);
  const int c8 = (lane & 15) * 8, rsub = lane >> 4;
  u32x4 zq[8];
#pragma unroll
  for (int it = 0; it < 8; ++it) zq[it] = *(const u32x4*)(Z + obase + (size_t)(it * 4 + rsub) * 1024 + c8);
#pragma unroll
  for (int d0 = 0; d0 < 4; ++d0)
#pragma unroll
    for (int r = 0; r < 16; ++r) stg[crow(r, hi) * STG_LD + d0 * 32 + r32] = rli_or_null ? o[d0][r] * rli_or_null[r] : o[d0][r];
  asm volatile("s_waitcnt lgkmcnt(0)" ::: "memory");
  f32x4 g0 = {1.f, 1.f, 1.f, 1.f}, g1 = {1.f, 1.f, 1.f, 1.f};
  if constexpr (NORM) { g0 = *(const f32x4*)(gain + c8) * gscale; g1 = *(const f32x4*)(gain + c8 + 4) * gscale; }
#pragma unroll
  for (int it = 0; it < 8; ++it) { const int row = it * 4 + rsub;
    f32x4 v0 = *(const f32x4*)(stg + row * STG_LD + c8), v1 = *(const f32x4*)(stg + row * STG_LD + c8 + 4);
    const size_t off = obase + (size_t)row * 1024 + c8;
    const u32x4 zv = zq[it];
    if constexpr (NORM) {
      float ssq = (v0[0] * v0[0] + v0[1] * v0[1]) + (v0[2] * v0[2] + v0[3] * v0[3]) + (v1[0] * v1[0] + v1[1] * v1[1]) + (v1[2] * v1[2] + v1[3] * v1[3]);
      ssq += __shfl_xor(ssq, 1); ssq += __shfl_xor(ssq, 2); ssq += __shfl_xor(ssq, 4); ssq += __shfl_xor(ssq, 8);
      const float rstd = __builtin_amdgcn_rsqf(ssq * (1.0f / 128.0f) + 1e-6f);
      v0 = v0 * rstd * g0; v1 = v1 * rstd * g1; }
    v0[0] *= silu(__uint_as_float(zv.x << 16)); v0[1] *= silu(__uint_as_float(zv.x & 0xffff0000u));
    v0[2] *= silu(__uint_as_float(zv.y << 16)); v0[3] *= silu(__uint_as_float(zv.y & 0xffff0000u));
    v1[0] *= silu(__uint_as_float(zv.z << 16)); v1[1] *= silu(__uint_as_float(zv.z & 0xffff0000u));
    v1[2] *= silu(__uint_as_float(zv.w << 16)); v1[3] *= silu(__uint_as_float(zv.w & 0xffff0000u));
    u32x4 w = {cvtpk(v0[0], v0[1]), cvtpk(v0[2], v0[3]), cvtpk(v1[0], v1[1]), cvtpk(v1[2], v1[3])};
    __builtin_nontemporal_store(w, (u32x4*)(O + off)); }
}

__device__ __forceinline__ void item_a(bf16_t* OUT, const bf16_t* QA, const bf16_t* KA, const bf16_t* VA, const bf16_t* ZA, const float* tabA, const float* subln, const float lam,
                                       float* scr, const int rowbase, const int q0, const int h, const int S, char* lds) {
  int tid_ = threadIdx.x; asm volatile("" : "+v"(tid_));
  const int tid = tid_, wid = tid >> 6, lane = tid & 63, r32 = lane & 31, hi = lane >> 5;
  float* tb = (float*)(lds + LDS_TB); float* ws = (float*)(lds + LDS_WSOFF) + wid * 64;
  if (tid < 256) tb[tid] = tabA[h * 256 + tid];
  const float b_neg = tabA[h * 256], b_pos = tabA[h * 256 + 255];
  const int qlo = q0 + wid * 32;
  const bf16_t* Kh = KA + (size_t)rowbase * 1024 + h * 128; const bf16_t* Vh = VA + (size_t)rowbase * 1024 + h * 128;
  const bf16_t* Qrow = QA + (size_t)(rowbase + qlo + r32) * 1024 + h * 128 + hi * 8;
  f32x16 o[4]; float l; bf16x8 qr[4];
#pragma unroll 1
  for (int mp = 0; mp < 2; ++mp) {
#pragma unroll
    for (int d0 = 0; d0 < 4; ++d0) qr[d0] = ld8(Qrow + mp * 64 + d0 * 16);
    volatile unsigned* badf = (volatile unsigned*)(lds + LDS_TB + 1024);
    if (tid == 0) *badf = 0u;
    flash_pass<64, 1024, true, true>(qr, Kh + mp * 64, Vh, S, lds, o, l, qlo, b_neg, b_pos);
    if (!(l > 1e-30f && l < 1e30f)) *badf = 1u;
    __syncthreads(); const unsigned redo = (PROBE == 20) ? 1u : *badf; __syncthreads();
    if (redo != 0u) flash_pass<64, 1024, true, false>(qr, Kh + mp * 64, Vh, S, lds, o, l, qlo, b_neg, b_pos);
    float rli[16]; row_rcp(l, ws, r32, hi, rli);
    if (mp == 0) {
#pragma unroll
      for (int d0 = 0; d0 < 4; ++d0)
#pragma unroll
        for (int r = 0; r < 16; r += 4) { const f32x4 w = {o[d0][r] * rli[r], o[d0][r + 1] * rli[r + 1], o[d0][r + 2] * rli[r + 2], o[d0][r + 3] * rli[r + 3]};
          ((f32x4*)(scr + tid * 64))[d0 * 4 + (r >> 2)] = w; }
    } else {
#pragma unroll
      for (int d0 = 0; d0 < 4; ++d0)
#pragma unroll
        for (int r = 0; r < 16; r += 4) { const f32x4 w = ((const f32x4*)(scr + tid * 64))[d0 * 4 + (r >> 2)];
          o[d0][r] = w[0] - lam * (o[d0][r] * rli[r]); o[d0][r + 1] = w[1] - lam * (o[d0][r + 1] * rli[r + 1]);
          o[d0][r + 2] = w[2] - lam * (o[d0][r + 2] * rli[r + 2]); o[d0][r + 3] = w[3] - lam * (o[d0][r + 3] * rli[r + 3]); }
    }
  }
  __syncthreads();
  out_rows<true>(o, nullptr, lds, subln, 0.8f, ZA, OUT, (size_t)(rowbase + qlo) * 1024 + h * 128);
  __syncthreads();
}

__device__ __forceinline__ void item_b(bf16_t* OUT, const bf16_t* QB, const bf16_t* KB, const bf16_t* VB, const bf16_t* ZB, const float* qg, const f32x2* rt,
                                       const int rowbase, const int q0, const int h, const int S, char* lds) {
  int tid_ = threadIdx.x; asm volatile("" : "+v"(tid_));
  const int tid = tid_, wid = tid >> 6, lane = tid & 63, r32 = lane & 31, hi = lane >> 5;
  float* ws = (float*)(lds + LDS_WSOFF) + wid * 64;
  const int qlo = q0 + wid * 32, t = qlo + r32, kvh = h >> 2;
  const bf16_t* Kh = KB + (size_t)rowbase * 256 + kvh * 128; const bf16_t* Vh = VB + (size_t)rowbase * 256 + kvh * 128;
  const bf16_t* Qrow = QB + (size_t)(rowbase + t) * 1024 + h * 128 + hi * 8;
  bf16x8 qr[8];
  { float f[8][8]; float ssq = 0.f;
#pragma unroll
    for (int d0 = 0; d0 < 8; ++d0) { const bf16x8 raw = ld8(Qrow + d0 * 16);
#pragma unroll
      for (int j = 0; j < 8; ++j) { f[d0][j] = bf2f(raw[j]); ssq += f[d0][j] * f[d0][j]; } }
    { auto rr = __builtin_amdgcn_permlane32_swap(__float_as_uint(ssq), __float_as_uint(ssq), false, false);
      ssq = __uint_as_float(rr[0]) + __uint_as_float(rr[1]); }
    const float rstd = __builtin_amdgcn_rsqf(ssq * (1.0f / 128.0f) + 1e-6f) * (0.08838834764831845f * 1.4426950408889634f);
#pragma unroll
    for (int d0 = 0; d0 < 8; ++d0) { const f32x4 g0 = *(const f32x4*)(qg + d0 * 16 + hi * 8), g1 = *(const f32x4*)(qg + d0 * 16 + hi * 8 + 4);
#pragma unroll
      for (int j = 0; j < 4; ++j) { f[d0][j] *= rstd * g0[j]; f[d0][4 + j] *= rstd * g1[j]; } }
#pragma unroll
    for (int hf = 0; hf < 2; ++hf) { const int idx = hf == 0 ? (t >> 6) : (t & 63);
#pragma unroll
      for (int dp = 0; dp < 2; ++dp)
#pragma unroll
        for (int j = 0; j < 8; ++j) { const f32x2 cs = rt[idx * 32 + dp * 16 + hi * 8 + j];
          const float u1 = f[hf * 4 + dp][j], u2 = f[hf * 4 + dp + 2][j];
          f[hf * 4 + dp][j] = u1 * cs.x - u2 * cs.y; f[hf * 4 + dp + 2][j] = u1 * cs.y + u2 * cs.x; } }
#pragma unroll
    for (int d0 = 0; d0 < 8; ++d0) { u32x4 w = {cvtpk(f[d0][0], f[d0][1]), cvtpk(f[d0][2], f[d0][3]), cvtpk(f[d0][4], f[d0][5]), cvtpk(f[d0][6], f[d0][7])};
      qr[d0] = *reinterpret_cast<bf16x8*>(&w); }
  }
  f32x16 o[4]; float l; float rli[16];
  volatile unsigned* badf = (volatile unsigned*)(lds + LDS_TB + 1024);
  if (tid == 0) *badf = 0u;
  flash_pass<128, 256, false, true>(qr, Kh, Vh, S, lds, o, l, qlo, 0.f, 0.f);
  if (!(l > 1e-30f && l < 1e30f)) *badf = 1u;
  __syncthreads(); const unsigned redo = (PROBE == 20) ? 1u : *badf; __syncthreads();
  if (redo != 0u) flash_pass<128, 256, false, false>(qr, Kh, Vh, S, lds, o, l, qlo, 0.f, 0.f);
  row_rcp(l, ws, r32, hi, rli);
  __syncthreads();
  out_rows<false>(o, rli, lds, nullptr, 1.f, ZB, OUT, (size_t)(rowbase + qlo) * 1024 + h * 128);
  __syncthreads();
}
#undef SBAR
}
#define LAS __attribute__((address_space(3)))
typedef unsigned short bf16;
typedef unsigned v4u __attribute__((ext_vector_type(4)));
typedef float f32x4 __attribute__((ext_vector_type(4)));
typedef float f32x2 __attribute__((ext_vector_type(2)));
constexpr size_t MiB = 1u << 20;
constexpr size_t WS_WIN = 2 * MiB, WS_WPA = 20 * MiB, WS_WPB = 22 * MiB, WS_WOUT = 24 * MiB, WS_TAB = 26 * MiB;
constexpr size_t WS_XN = 32 * MiB;
constexpr size_t WS_BIG = 192 * MiB;
constexpr size_t WS_KB = 960 * MiB, WS_VB = 984 * MiB;
constexpr size_t WS_SCR = 1008 * MiB;
constexpr size_t WS_END = 1040 * MiB;
constexpr size_t TAB_BIAS = 0, TAB_ROPE = 8192, TAB_LAM = 8192 + 32768;
constexpr int LDS_BYTES = 147456;
constexpr int NWAVES = 8;

__device__ __forceinline__ unsigned f2bf(float f) { unsigned u = __builtin_bit_cast(unsigned, f); return (u + 0x7fffu + ((u >> 16) & 1u)) >> 16; }
__device__ __forceinline__ unsigned pk2(float lo, float hi) { return f2bf(lo) | (f2bf(hi) << 16); }
__device__ __forceinline__ float wave_sum(float v) {
#pragma unroll
    for (int o = 1; o < 64; o <<= 1) v += __shfl_xor(v, o);
    return v;
}
#define LDS_WAIT() asm volatile("s_waitcnt lgkmcnt(0)" ::: "memory")
__device__ __forceinline__ void p0_transpose_item(const float* W, int K, int N, bf16* WT, LAS float* scr, int item, int lane) {
    const int nblk = N / 32, kb = item / nblk, nb = item % nblk, k0 = 64 * kb, n0 = 32 * nb;
#pragma unroll 8
    for (int i = 0; i < 32; ++i) { const int kk = 2 * i + (lane >> 5); scr[kk * 33 + (lane & 31)] = W[(size_t)(k0 + kk) * N + n0 + (lane & 31)]; }
    LDS_WAIT(); asm volatile("" ::: "memory");
    const int c = lane & 7;
#pragma unroll
    for (int j = 0; j < 4; ++j) { const int n = (lane >> 3) + 8 * j; const LAS float* s = scr + (8 * c) * 33 + n;
        v4u o; o.x = pk2(s[0 * 33], s[1 * 33]); o.y = pk2(s[2 * 33], s[3 * 33]); o.z = pk2(s[4 * 33], s[5 * 33]); o.w = pk2(s[6 * 33], s[7 * 33]);
        *(v4u*)(WT + (size_t)(n0 + n) * K + k0 + 8 * c) = o; }
    LDS_WAIT(); asm volatile("" ::: "memory");
}

typedef __attribute__((address_space(1))) unsigned gu32;
#define XB_TMO      128
#define XB_XCNT(j)  (256  + 64 * (j))
#define XB_XSUB(j)  (1280 + 64 * (j))
#define XB_XGEN(j)  (2304 + 64 * (j))
#define XB_TOP      3328
#define XB_TOPGEN   3392
#define XCD_BAR_WORDS 3456
#define XB_SPIN_CAP (1u << 18)

__device__ __forceinline__ unsigned xb_ld(unsigned* p)              { return __hip_atomic_load(p, __ATOMIC_RELAXED, __HIP_MEMORY_SCOPE_AGENT); }
__device__ __forceinline__ unsigned xb_add(unsigned* p, unsigned v) { return __hip_atomic_fetch_add(p, v, __ATOMIC_RELAXED, __HIP_MEMORY_SCOPE_AGENT); }
__device__ __forceinline__ unsigned xb_xcc_id() { return (unsigned)__builtin_amdgcn_s_getreg((3 << 11) | 20) & 0xFu; }
#define XB_SPIN(cond, bar) do { unsigned _sp = 0; while (cond) { __builtin_amdgcn_s_sleep(1); \
    if ((++_sp & 255u) == 0u) { if (xb_ld(&(bar)[XB_TMO])) break; if (_sp > XB_SPIN_CAP) { atomicAdd(&(bar)[XB_TMO], 1u); break; } } } } while (0)

struct XcdBarrier {
    unsigned* bar; unsigned x;
    volatile LAS unsigned* st;
};

__device__ __forceinline__ XcdBarrier xcd_barrier_post(unsigned* bar, volatile LAS unsigned* st) {
    XcdBarrier b; b.bar = bar; b.x = xb_xcc_id(); b.st = st;
    if (threadIdx.x == 0) (void)xb_add(&bar[XB_XCNT(b.x)], 1u);
    return b;
}
__device__ __forceinline__ void xcd_barrier_complete(unsigned* bar, unsigned x, unsigned& nloc, unsigned& nx) {
    const unsigned G = gridDim.x * gridDim.y * gridDim.z;
    unsigned sum, cnt, mine, sp = 0u;
    for (;;) {
        sum = 0u; cnt = 0u; mine = 0u;
#pragma unroll
        for (unsigned j = 0; j < 16; ++j) { const unsigned c = xb_ld(&bar[XB_XCNT(j)]); sum += c; cnt += (c > 0u) ? 1u : 0u; mine = (j == x) ? c : mine; }
        if (sum == G) break;
        __builtin_amdgcn_s_sleep(1);
        if ((++sp & 255u) == 0u) { if (xb_ld(&bar[XB_TMO])) break; if (sp > XB_SPIN_CAP) { atomicAdd(&bar[XB_TMO], 1u); break; } }
    }
    nloc = mine > 0u ? mine : 1u; nx = cnt > 0u ? cnt : 1u;
}

__device__ __forceinline__ void xcd_barrier(const XcdBarrier& b) {
    asm volatile("s_waitcnt vmcnt(0)" ::: "memory");
    __syncthreads();
    if (threadIdx.x == 0) {
        unsigned* bar = b.bar;
        __builtin_amdgcn_s_waitcnt(0);
        unsigned nloc = b.st[0], nx = b.st[1];
        if (nloc == 0u) { xcd_barrier_complete(bar, b.x, nloc, nx); b.st[0] = nloc; b.st[1] = nx; }
        const unsigned old = xb_add(&bar[XB_XSUB(b.x)], 1u);
        const unsigned gen = old / nloc;
        if (old + 1u == (gen + 1u) * nloc) {
            __builtin_amdgcn_fence(__ATOMIC_RELEASE, "agent");
            asm volatile("s_waitcnt vmcnt(0)" ::: "memory");
            const unsigned og = xb_add(&bar[XB_TOP], 1u);
            const unsigned tg = og / nx;
            if (og + 1u == (tg + 1u) * nx) xb_add(&bar[XB_TOPGEN], 1u);
            else XB_SPIN(xb_ld(&bar[XB_TOPGEN]) == tg, bar);
            __builtin_amdgcn_fence(__ATOMIC_ACQUIRE, "agent");
            xb_add(&bar[XB_XGEN(b.x)], 1u);
            asm volatile("s_waitcnt vmcnt(0)" ::: "memory");
        } else {
            XB_SPIN(xb_ld(&bar[XB_XGEN(b.x)]) == gen, bar);
            __builtin_amdgcn_fence(__ATOMIC_ACQUIRE, "agent");
            asm volatile("s_waitcnt vmcnt(0)" ::: "memory");
        }
    }
    __syncthreads();
}

struct Args { const float* in[16]; float* out; unsigned char* ws; };

__global__ void __launch_bounds__(NWAVES * 64, 2) fwd_mega(Args a) {
    extern __shared__ __attribute__((aligned(16))) unsigned char lds[];
    cg::grid_group grid = cg::this_grid();
    const int tid = threadIdx.x, lane = tid & 63, wave = __builtin_amdgcn_readfirstlane(tid >> 6);
    const int G = gridDim.x, bx = blockIdx.x;
    const int vcu = (G % 8 == 0) ? (bx % 8) * (G / 8) + bx / 8 : bx;
    unsigned char* ws = a.ws;
    volatile LAS unsigned* bar_st = (volatile LAS unsigned*)((LAS unsigned char*)lds + (LDS_BYTES - 64));
    if (tid < 2) bar_st[tid] = 0u;
    __syncthreads();
    const XcdBarrier xbar = xcd_barrier_post((unsigned*)ws, bar_st);
#define GRID_BAR() xcd_barrier(xbar)
    const float* xp = a.in[0]; const float* xs = a.in[1]; const float* g_norm = a.in[2]; const float* w_in = a.in[3];
    const float* lq1 = a.in[4]; const float* lk1 = a.in[5]; const float* lq2 = a.in[6]; const float* lk2 = a.in[7];
    const float* subln = a.in[8]; const float* qnb = a.in[9]; const float* knb = a.in[10];
    const float* w_pa = a.in[11]; const float* w_pb = a.in[12]; const float* w_out = a.in[13]; const float* rel_bias = a.in[14]; const float* g_final = a.in[15];
    bf16* WinT = (bf16*)(ws + WS_WIN); bf16* WpaT = (bf16*)(ws + WS_WPA); bf16* WpbT = (bf16*)(ws + WS_WPB); bf16* WoutT = (bf16*)(ws + WS_WOUT);
    float* tabA = (float*)(ws + WS_TAB + TAB_BIAS); f32x2* rt = (f32x2*)(ws + WS_TAB + TAB_ROPE); float* lamp = (float*)(ws + WS_TAB + TAB_LAM);
    bf16* XN = (bf16*)(ws + WS_XN);
    bf16* BIG = (bf16*)(ws + WS_BIG);
    bf16 *QA = BIG, *KA = BIG + pg8::BUFE, *VA = BIG + 2 * pg8::BUFE, *ZA = BIG + 3 * pg8::BUFE, *QB = BIG + 4 * pg8::BUFE, *ZB = BIG + 5 * pg8::BUFE, *GA = BIG + 6 * pg8::BUFE, *GB = BIG + 7 * pg8::BUFE;
    bf16* KB = (bf16*)(ws + WS_KB); bf16* VB = (bf16*)(ws + WS_VB);
    float* scr = (float*)(ws + WS_SCR) + (size_t)bx * 32768;
    const int gw = vcu * NWAVES + wave, NGW = G * NWAVES;

    for (int rep_ = 0; rep_ < (PROBE == 4 ? 2 : 1); ++rep_) {
        LAS float* tscr = (LAS float*)((LAS unsigned char*)lds + wave * 16384);
        constexpr int I_IN = (1024 / 64) * (NIN / 32), I_SQ = (1024 / 64) * (1024 / 32);
        for (int it = gw; it < I_IN + 3 * I_SQ; it += NGW) {
            int r = it;
            if (r < I_IN) { p0_transpose_item(w_in, 1024, NIN, WinT, tscr, r, lane); continue; } r -= I_IN;
            if (r < I_SQ) { p0_transpose_item(w_pa, 1024, 1024, WpaT, tscr, r, lane); continue; } r -= I_SQ;
            if (r < I_SQ) { p0_transpose_item(w_pb, 1024, 1024, WpbT, tscr, r, lane); continue; } r -= I_SQ;
            p0_transpose_item(w_out, 1024, 1024, WoutT, tscr, r, lane);
        }
        f32x4 gv[4];
#pragma unroll
        for (int j = 0; j < 4; ++j) gv[j] = ((const f32x4*)g_norm)[lane + 64 * j];
        for (int m0 = gw; m0 < NTOK; m0 += 4 * NGW) {
            f32x4 v[4][4]; float ssq[4];
#pragma unroll
            for (int q = 0; q < 4; ++q) { const int m = m0 + q * NGW; ssq[q] = 0.f; if (m >= NTOK) continue;
                const f32x4* xr = (const f32x4*)(m < NPTOK ? xp + (size_t)m * 1024 : xs + (size_t)(m - NPTOK) * 1024) + lane;
#pragma unroll
                for (int j = 0; j < 4; ++j) { v[q][j] = xr[64 * j]; ssq[q] += (v[q][j].x * v[q][j].x + v[q][j].y * v[q][j].y) + (v[q][j].z * v[q][j].z + v[q][j].w * v[q][j].w); } }
#pragma unroll
            for (int q = 0; q < 4; ++q) { const int m = m0 + q * NGW; if (m >= NTOK) continue;
                const float rstd = 1.0f / sqrtf(wave_sum(ssq[q]) * (1.f / 1024.f) + EPS);
                unsigned long long* o8 = (unsigned long long*)(XN + (size_t)m * 1024) + lane;
#pragma unroll
                for (int j = 0; j < 4; ++j) { const f32x4 w = v[q][j] * rstd * gv[j];
                    o8[64 * j] = (unsigned long long)pk2(w.x, w.y) | ((unsigned long long)pk2(w.z, w.w) << 32); } }
        }
        if (bx == G - 1) {
            for (int i = tid; i < 8 * 256; i += NWAVES * 64) { const int h = i >> 8, rel = (i & 255) - 128, n = rel < 0 ? -rel : rel;
                const int lg = n < 8 ? n : (n < 12 ? 8 : n < 16 ? 9 : n < 23 ? 10 : n < 32 ? 11 : n < 46 ? 12 : n < 64 ? 13 : n < 91 ? 14 : 15);
                tabA[i] = rel_bias[((rel > 0 ? 16 : 0) + lg) * 8 + h] * 1.4426950408889634f; }
            for (int i = tid; i < 128 * 32; i += NWAVES * 64) { const int idx = i >> 5, fi = i & 31;
                const float inv = __builtin_amdgcn_exp2f(-(float)fi * (13.287712379549449f / 32.0f));
                float rev = (float)idx * inv * 0.15915494309189535f; rev -= rintf(rev);
                rt[i] = (f32x2){__builtin_amdgcn_cosf(rev), __builtin_amdgcn_sinf(rev)}; }
            if (tid == 0) { float s1 = 0.f, s2 = 0.f; for (int i = 0; i < 64; ++i) { s1 += lq1[i] * lk1[i]; s2 += lq2[i] * lk2[i]; }
                lamp[0] = __expf(s1) - __expf(s2) + 0.2f; }
        }
    }
    grid.sync();
#if PROBE == 5
    for (int q_ = 0; q_ < 11; ++q_) GRID_BAR();
#endif
    const float lam = lamp[0];

    for (int g = 0; g < NGRP; ++g) {
        const int GM = g == 0 ? GMAX : G1ROWS, gbase = g == 0 ? 0 : G1BASE;
        bf16* MERGED = XN + (size_t)gbase * 1024;
        {
            pg8::Gemm gm{XN + (size_t)gbase * 1024, WinT, GM, NIN, 1024, nullptr, nullptr}; pg8::StaticOrder S; S.init(GM, NIN, G, bx);
            pg8::EpiProj E{BIG, KB, VB};
            pg8::gemm_phase<pg8::EpiProj, pg8::StaticOrder, true, true>((LAS unsigned char*)lds, gm, S, E);
#if PROBE == 3
            pg8::gemm_phase<pg8::EpiProj, pg8::StaticOrder, true, true>((LAS unsigned char*)lds, gm, S, E);
#endif
        }
        GRID_BAR();
        { int lane_k = threadIdx.x & 63; asm volatile("" : "+v"(lane_k));
          const int c = lane_k & 15, sub = lane_k >> 4;
          const f32x4 kg0 = *(const f32x4*)(knb + c * 8), kg1 = *(const f32x4*)(knb + c * 8 + 4);
          for (int u0 = gw * 4; u0 < GM * 2; u0 += NGW * 4) {
            const int u = u0 + sub, lr = u >> 1, kvh = u & 1;
            bf16* kp = KB + (size_t)lr * 256 + kvh * 128 + c * 8;
            const v4u raw = *(const v4u*)kp;
            float f[8];
            f[0] = __uint_as_float(raw.x << 16); f[1] = __uint_as_float(raw.x & 0xffff0000u); f[2] = __uint_as_float(raw.y << 16); f[3] = __uint_as_float(raw.y & 0xffff0000u);
            f[4] = __uint_as_float(raw.z << 16); f[5] = __uint_as_float(raw.z & 0xffff0000u); f[6] = __uint_as_float(raw.w << 16); f[7] = __uint_as_float(raw.w & 0xffff0000u);
            float ssq = 0.f;
#pragma unroll
            for (int j = 0; j < 8; ++j) ssq += f[j] * f[j];
            ssq += __shfl_xor(ssq, 1); ssq += __shfl_xor(ssq, 2); ssq += __shfl_xor(ssq, 4); ssq += __shfl_xor(ssq, 8);
            const float rstd = 1.0f / sqrtf(ssq * (1.f / 128.f) + EPS);
#pragma unroll
            for (int j = 0; j < 4; ++j) { f[j] *= rstd * kg0[j]; f[4 + j] *= rstd * kg1[j]; }
            const int t = (g == 0 || lr < G1SAMPLE) ? (lr & 4095) : ((lr - G1SAMPLE) & 8191);
            const int idx = c < 8 ? (t >> 6) : (t & 63);
            const f32x4* rp = (const f32x4*)(rt + idx * 32 + (c & 3) * 8);
            const bool second = (c & 4) != 0;
            float o8[8];
#pragma unroll
            for (int j2 = 0; j2 < 4; ++j2) { const f32x4 cs = rp[j2];
              const float pa = __shfl_xor(f[2 * j2], 4), pb = __shfl_xor(f[2 * j2 + 1], 4);
              o8[2 * j2]     = second ? (pa * cs[1] + f[2 * j2] * cs[0])     : (f[2 * j2] * cs[0] - pa * cs[1]);
              o8[2 * j2 + 1] = second ? (pb * cs[3] + f[2 * j2 + 1] * cs[2]) : (f[2 * j2 + 1] * cs[2] - pb * cs[3]); }
            v4u w; w.x = pk2(o8[0], o8[1]); w.y = pk2(o8[2], o8[3]); w.z = pk2(o8[4], o8[5]); w.w = pk2(o8[6], o8[7]);
            *(v4u*)kp = w;
          }
        }
        GRID_BAR();
        {
            char* al = (char*)lds;
            const int nS = g == 0 ? 0 : 512, nP = g == 0 ? 1536 : 512;
            for (int i = vcu; i < nS; i += G) att::item_a(QA, QA, KA, VA, ZA, tabA, subln, lam, scr, G1SAMPLE + (i >> 8) * 8192, (i & 31) * 256, (i >> 5) & 7, 8192, al);
            for (int i = vcu; i < nP; i += G) att::item_a(QA, QA, KA, VA, ZA, tabA, subln, lam, scr, (i >> 7) * 4096, (i & 15) * 256, (i >> 4) & 7, 4096, al);
            for (int i = vcu; i < nS; i += G) att::item_b(QB, QB, KB, VB, ZB, qnb, (const att::f32x2*)rt, G1SAMPLE + (i >> 8) * 8192, (i & 31) * 256, (i >> 5) & 7, 8192, al);
            for (int i = vcu; i < nP; i += G) att::item_b(QB, QB, KB, VB, ZB, qnb, (const att::f32x2*)rt, (i >> 7) * 4096, (i & 15) * 256, (i >> 4) & 7, 4096, al);
        }
        GRID_BAR();
        for (int rep_ = 0; rep_ < (PROBE == 6 ? 2 : 1); ++rep_) {
            pg8::PairOrder S; S.init(GM, 1024, G, bx);
            pg8::Gemm gm{QA, WpaT, GM, 1024, 1024, QB, WpbT}; pg8::EpiPair E{GA, GB, MERGED};
            pg8::gemm_phase<pg8::EpiPair, pg8::PairOrder, true, true>((LAS unsigned char*)lds, gm, S, E);
        }
        GRID_BAR();
        for (int rep_ = 0; rep_ < (PROBE == 6 ? 2 : 1); ++rep_) {
            pg8::StaticOrder S; S.init(GM, 1024, G, bx);
            pg8::Gemm gm{MERGED, WoutT, GM, 1024, 1024, nullptr, nullptr}; pg8::EpiOut E{a.out, gbase};
            pg8::gemm_phase<pg8::EpiOut, pg8::StaticOrder, true, true>((LAS unsigned char*)lds, gm, S, E);
        }
        if (g == NGRP - 1) GRID_BAR();
    }
    {
        int lane5 = threadIdx.x & 63; asm volatile("" : "+v"(lane5)); const int lane = lane5;
        f32x4 gv[4];
#pragma unroll
        for (int j = 0; j < 4; ++j) gv[j] = ((const f32x4*)g_final)[lane + 64 * j];
        for (int m0 = gw; m0 < NTOK; m0 += 2 * NGW) {
            f32x4 v[2][4]; float ssq[2];
#pragma unroll
            for (int q = 0; q < 2; ++q) { const int m = m0 + q * NGW; ssq[q] = 0.f; if (m >= NTOK) continue;
                const f32x4* xr = (const f32x4*)(m < NPTOK ? xp + (size_t)m * 1024 : xs + (size_t)(m - NPTOK) * 1024) + lane;
                const unsigned long long* dr = (const unsigned long long*)(a.out + (size_t)m * 1024) + lane;
#pragma unroll
                for (int j = 0; j < 4; ++j) { const unsigned long long d = dr[64 * j]; const unsigned dlo = (unsigned)d, dhi = (unsigned)(d >> 32);
                    f32x4 h = xr[64 * j];
                    h.x += __uint_as_float(dlo << 16); h.y += __uint_as_float(dlo & 0xffff0000u); h.z += __uint_as_float(dhi << 16); h.w += __uint_as_float(dhi & 0xffff0000u);
                    v[q][j] = h; ssq[q] += (h.x * h.x + h.y * h.y) + (h.z * h.z + h.w * h.w); } }
#pragma unroll
            for (int q = 0; q < 2; ++q) { const int m = m0 + q * NGW; if (m >= NTOK) continue;
                const float rstd = 1.0f / sqrtf(wave_sum(ssq[q]) * (1.f / 1024.f) + EPS);
                f32x4* yr = (f32x4*)(a.out + (size_t)m * 1024) + lane;
#pragma unroll
                for (int j = 0; j < 4; ++j) yr[64 * j] = v[q][j] * rstd * gv[j]; }
        }
    }
}

extern "C" void kernel_launch(void* const* d_in, const int* in_sizes, int n_in, void* d_out, int out_size, void* d_ws, size_t ws_size, hipStream_t stream) {
    static int grid = 0;
    if (grid == 0) {
        if (n_in != 16 || out_size != NTOK * 1024 || ws_size < WS_END) { fprintf(stderr, "kernel_launch: unexpected shapes: n_in %d out %d ws %zu (need %zu)\n", n_in, out_size, ws_size, (size_t)WS_END); grid = -1; return; }
        int dev = 0, cus = 0, per_cu = 0;
        if (hipGetDevice(&dev) != hipSuccess || hipDeviceGetAttribute(&cus, hipDeviceAttributeMultiprocessorCount, dev) != hipSuccess) { grid = -1; return; }
        if (hipFuncSetAttribute((const void*)fwd_mega, hipFuncAttributeMaxDynamicSharedMemorySize, LDS_BYTES) != hipSuccess) { fprintf(stderr, "kernel_launch: hipFuncSetAttribute failed\n"); grid = -1; return; }
        if (hipOccupancyMaxActiveBlocksPerMultiprocessor(&per_cu, (const void*)fwd_mega, NWAVES * 64, LDS_BYTES) != hipSuccess || per_cu < 1) { fprintf(stderr, "kernel_launch: occupancy query gave %d\n", per_cu); per_cu = 1; }
        (void)hipGetLastError();
        grid = cus * (per_cu > 1 ? 1 : per_cu);
    }
    if (grid < 0) return;
    Args a{};
    for (int i = 0; i < 16; ++i) a.in[i] = (const float*)d_in[i];
    a.out = (float*)d_out; a.ws = (unsigned char*)d_ws;
    if (hipMemsetAsync(d_ws, 0, 16384, stream) != hipSuccess) { fprintf(stderr, "kernel_launch: memset failed\n"); return; }
    void* args[] = {&a};
    hipError_t e = hipLaunchCooperativeKernel((const void*)fwd_mega, dim3(grid), dim3(NWAVES * 64), args, LDS_BYTES, stream);
    if (e != hipSuccess) fprintf(stderr, "kernel_launch: cooperative launch failed: %s (grid %d)\n", hipGetErrorString(e), grid);
}
```

```cpp
#include <hip/hip_runtime.h>
#include <hip/hip_cooperative_groups.h>
#include <cstdio>
#include <cstdint>
namespace cg = cooperative_groups;

constexpr int DM = 1024;
constexpr int NTOK = 81920, NPTOK = 65536;
constexpr int GMAX = 49152, G1BASE = 49152, G1ROWS = 32768, G1SAMPLE = 16384;
constexpr int NGRP = 2;
constexpr int NIN = 8704;
constexpr float EPS = 1e-6f;
#ifndef PROBE
#define PROBE 0
#endif
namespace pg8 {
#define PG8_LAS __attribute__((address_space(3)))
typedef unsigned short bf16_t;
typedef short bf16x8 __attribute__((ext_vector_type(8)));
typedef float f32x4 __attribute__((ext_vector_type(4)));
typedef unsigned u32x4 __attribute__((ext_vector_type(4)));
constexpr int BM = 256, BK = 64, HALF = 128, HTB = HALF * BK * 2  , STAGE_BYTES = 8 * HTB, NXCD = 8, WGM = 8;

__host__ __device__ __forceinline__ int lds_byte(int r, int c) { const int st = (r >> 4) * 2 + (c >> 5), rr = r & 15, cc = c & 31, ob = rr * 64 + cc * 2; return st * 1024 + (ob ^ (((ob >> 9) & 1) << 5)); }
__host__ __device__ __forceinline__ void stage_rc(int b, int& R, int& C) { const int st = b / 1024, sb = b % 1024, swz = sb ^ (((sb >> 9) & 1) << 5); R = (st >> 1) * 16 + swz / 64; C = (st & 1) * 32 + (swz % 64) / 2; }
__host__ __device__ __forceinline__ int perm32(int rho) { const int n = rho >> 4, i = rho & 15; return 8 * (i >> 2) + 4 * n + (i & 3); }

struct Unit { int pm, pn, sec; };
struct Gemm { const bf16_t* A; const bf16_t* Bt; int M, N, K; const bf16_t* A2; const bf16_t* Bt2; };

struct StaticOrder {
    int nM, nN, nwg, G, c;
    __host__ __device__ void init(int M, int N, int G_, int c_) { nM = M / BM; nN = N / BM; nwg = nM * nN; G = G_; c = c_; }
    __host__ __device__ bool next(int i, Unit& u) const {
        const long L = (long)i * G + c; if (L >= nwg) return false;
        int wgid = (int)L; { const int q = nwg / NXCD, r = nwg % NXCD, xcd = wgid % NXCD, off = wgid / NXCD; wgid = (xcd < r ? xcd * (q + 1) : r * (q + 1) + (xcd - r) * q) + off; }
        const int nig = WGM * nN, gid = wgid / nig, fm = gid * WGM, gsz = (nM - fm) < WGM ? (nM - fm) : WGM;
        u.pm = fm + ((wgid % nig) % gsz); u.pn = (wgid % nig) / gsz; u.sec = 0; return true;
    }
    __device__ __forceinline__ void a_ready(const Unit&) const {}
    __device__ __forceinline__ void done(const Unit&) const {}
};
struct PairOrder {
    StaticOrder S;
    __host__ __device__ void init(int M, int N, int G_, int c_) { S.init(M, N, G_, c_); }
    __host__ __device__ bool next(int i, Unit& u) const { if (!S.next(i >> 1, u)) return false; u.sec = i & 1; return true; }
    __device__ __forceinline__ void a_ready(const Unit&) const {}
    __device__ __forceinline__ void done(const Unit&) const {}
};
__device__ __forceinline__ unsigned cvt_pk_bf16(float lo, float hi) { unsigned r; asm volatile("v_cvt_pk_bf16_f32 %0, %1, %2" : "=v"(r) : "v"(lo), "v"(hi)); return r; }
typedef float f32x2 __attribute__((ext_vector_type(2)));
typedef unsigned u32x4e __attribute__((ext_vector_type(4)));
constexpr size_t BUFE = (size_t)49152 * 1024;
__device__ __forceinline__ float bf2f(unsigned short v) { return __uint_as_float(((unsigned)v) << 16); }
__device__ __forceinline__ float sigm(float x) { return __builtin_amdgcn_rcpf(1.0f + __builtin_amdgcn_exp2f(-1.4426950408889634f * x)); }

struct EpiProj { static constexpr bool PERM = true, AFTER_DRAIN = false;
    bf16_t* big; bf16_t* kb; bf16_t* vb;
    __device__ __forceinline__ void operator()(const f32x4 (&acc)[2][2][4][2], const Unit& u, int wr, int wc, int fr, int fq) const {
        const int pn = u.pn; bf16_t* base; int ldc, colt;
        if (pn < 20) { base = big + (size_t)(pn >> 2) * BUFE; ldc = 1024; colt = (pn & 3) * 256; }
        else if (pn == 20) { base = kb; ldc = 256; colt = 0; }
        else if (pn == 21) { base = vb; ldc = 256; colt = 0; }
        else { const int q = pn - 22; base = big + (size_t)(5 + (q >> 2)) * BUFE; ldc = 1024; colt = (q & 3) * 256; }
        const int row0 = u.pm * BM + wr * 64 + fr, col0 = colt + wc * 32 + 8 * fq;
        const float sc = pn < 4 ? 0.125f * 1.4426950408889634f : 1.0f;
#pragma unroll
        for (int ai = 0; ai < 2; ++ai)
#pragma unroll
            for (int m = 0; m < 4; ++m) { bf16_t* rowp = base + (size_t)(row0 + ai * HALF + m * 16) * ldc + col0;
#pragma unroll
                for (int bj = 0; bj < 2; ++bj) { const f32x4 v0 = acc[ai][bj][m][0] * sc, v1 = acc[ai][bj][m][1] * sc;
                    u32x4 w; w.x = cvt_pk_bf16(v0[0], v0[1]); w.y = cvt_pk_bf16(v0[2], v0[3]); w.z = cvt_pk_bf16(v1[0], v1[1]); w.w = cvt_pk_bf16(v1[2], v1[3]);
                    *(u32x4*)(rowp + bj * HALF) = w; } }
    }
};
__device__ __forceinline__ float en2(unsigned hbits) { return __builtin_amdgcn_exp2f(-1.4426950408889634f * __uint_as_float(hbits)); }
struct EpiPair { static constexpr bool PERM = true, AFTER_DRAIN = false;
    const bf16_t* ga; const bf16_t* gb; bf16_t* merged;
    __device__ __forceinline__ void operator()(f32x4 (&acc)[2][2][4][2], const Unit& u, int wr, int wc, int fr, int fq) const {
        const int row0 = u.pm * BM + wr * 64 + fr, col0 = u.pn * BM + wc * 32 + 8 * fq;
        if (u.sec == 0) {
#pragma unroll
            for (int ai = 0; ai < 2; ++ai)
#pragma unroll
                for (int m = 0; m < 4; ++m) { const size_t off = (size_t)(row0 + ai * HALF + m * 16) * 1024 + col0;
#pragma unroll
                    for (int bj = 0; bj < 2; ++bj) { const u32x4 av = *(const u32x4*)(ga + off + bj * HALF), bv = *(const u32x4*)(gb + off + bj * HALF);
                        const unsigned aw[4] = {av.x, av.y, av.z, av.w}, bw[4] = {bv.x, bv.y, bv.z, bv.w};
#pragma unroll
                        for (int q = 0; q < 4; ++q) { const int n = q >> 1, e = (q & 1) * 2;
                            const float r0 = (1.0f + en2(bw[q] << 16)) * __builtin_amdgcn_rcpf(1.0f + en2(aw[q] << 16));
                            const float r1 = (1.0f + en2(bw[q] & 0xffff0000u)) * __builtin_amdgcn_rcpf(1.0f + en2(aw[q] & 0xffff0000u));
                            acc[ai][bj][m][n][e] *= r0; acc[ai][bj][m][n][e + 1] *= r1; } } }
        } else {
#pragma unroll
            for (int ai = 0; ai < 2; ++ai)
#pragma unroll
                for (int m = 0; m < 4; ++m) { const size_t off = (size_t)(row0 + ai * HALF + m * 16) * 1024 + col0;
#pragma unroll
                    for (int bj = 0; bj < 2; ++bj) { const u32x4 gv = *(const u32x4*)(gb + off + bj * HALF);
                        const f32x4 v0 = acc[ai][bj][m][0], v1 = acc[ai][bj][m][1];
                        u32x4 w; w.x = cvt_pk_bf16(v0[0] * sigm(__uint_as_float(gv.x << 16)), v0[1] * sigm(__uint_as_float(gv.x & 0xffff0000u)));
                        w.y = cvt_pk_bf16(v0[2] * sigm(__uint_as_float(gv.y << 16)), v0[3] * sigm(__uint_as_float(gv.y & 0xffff0000u)));
                        w.z = cvt_pk_bf16(v1[0] * sigm(__uint_as_float(gv.z << 16)), v1[1] * sigm(__uint_as_float(gv.z & 0xffff0000u)));
                        w.w = cvt_pk_bf16(v1[2] * sigm(__uint_as_float(gv.w << 16)), v1[3] * sigm(__uint_as_float(gv.w & 0xffff0000u)));
                        *(u32x4*)(merged + off + bj * HALF) = w; } }
        }
    }
};
struct EpiOut { static constexpr bool PERM = true, AFTER_DRAIN = false;
    float* out; int base;
    __device__ __forceinline__ void operator()(const f32x4 (&acc)[2][2][4][2], const Unit& u, int wr, int wc, int fr, int fq) const {
        bf16_t* ob = (bf16_t*)(out + ((size_t)base + (size_t)u.pm * BM) * 1024);
        const int row0 = wr * 64 + fr, col0 = u.pn * BM + wc * 32 + 8 * fq;
#pragma unroll
        for (int ai = 0; ai < 2; ++ai)
#pragma unroll
            for (int m = 0; m < 4; ++m) { bf16_t* rowp = ob + (size_t)(row0 + ai * HALF + m * 16) * 2048 + col0;
#pragma unroll
                for (int bj = 0; bj < 2; ++bj) { const f32x4 v0 = acc[ai][bj][m][0], v1 = acc[ai][bj][m][1];
                    u32x4 w; w.x = cvt_pk_bf16(v0[0], v0[1]); w.y = cvt_pk_bf16(v0[2], v0[3]); w.z = cvt_pk_bf16(v1[0], v1[1]); w.w = cvt_pk_bf16(v1[2], v1[3]);
                    *(u32x4*)(rowp + bj * HALF) = w; } }
    }
};
template <class Epi, class Sched, bool ALIGN_EPI = false, bool SP2 = false>
__device__ __forceinline__ void gemm_phase(PG8_LAS unsigned char* lds, const Gemm g, const Sched& S, const Epi& E) {
    int tid_ = threadIdx.x; asm volatile("" : "+v"(tid_));
    const int tid = tid_, wid = __builtin_amdgcn_readfirstlane(tid >> 6), lane = tid & 63, wr = wid >> 2, wc = wid & 3, fr = lane & 15, fq = lane >> 4;
    const int K = g.K, nt = K / BK;
    unsigned voffA[2], voffB[2];
#pragma unroll
    for (int i = 0; i < 2; ++i) { int R, C; stage_rc(tid * 16 + i * 8192, R, C); const int Rb = Epi::PERM ? ((R & ~31) + perm32(R & 31)) : R;
        voffA[i] = (unsigned)(R * K + C) * 2u; voffB[i] = (unsigned)(Rb * K + C) * 2u; }
    const size_t kstep = (size_t)(BK * 2);
    const size_t hstep = (size_t)HALF * K * 2;
    const size_t tstep = 2 * hstep;
    const unsigned ldsw = (unsigned)wid * 1024u;
    const int aoff = lds_byte(wr * 64 + fr, fq * 8), boff = lds_byte(wc * 32 + fr, fq * 8);
#define PG8_SA(b, h) (((b) * 2 + (h)) * HTB)
#define PG8_SB(b, h) ((4 + (b) * 2 + (h)) * HTB)
#define PG8_STAGE(bufoff, gbase, voff) do { _Pragma("unroll") for (int _i = 0; _i < 2; ++_i) \
        __builtin_amdgcn_global_load_lds((const unsigned*)((const char*)(gbase) + (voff)[_i]), (PG8_LAS unsigned*)(lds + (bufoff) + ldsw + _i * 8192), 16, 0, 0); } while (0)
#define PG8_LDA(dst, b, h) do { _Pragma("unroll") for (int m = 0; m < 4; ++m) _Pragma("unroll") for (int k = 0; k < 2; ++k) dst[m][k] = *(const PG8_LAS bf16x8*)(lds + PG8_SA(b, h) + aoff + m * 2048 + k * 1024); } while (0)
#define PG8_LDB(dst, b, h) do { _Pragma("unroll") for (int n = 0; n < 2; ++n) _Pragma("unroll") for (int k = 0; k < 2; ++k) dst[n][k] = *(const PG8_LAS bf16x8*)(lds + PG8_SB(b, h) + boff + n * 2048 + k * 1024); } while (0)
#define PG8_MMA(ai, bj, At, Bt) do { __builtin_amdgcn_s_setprio(1); _Pragma("unroll") for (int m = 0; m < 4; ++m) _Pragma("unroll") for (int n = 0; n < 2; ++n) _Pragma("unroll") for (int k = 0; k < 2; ++k) \
        acc[ai][bj][m][n] = __builtin_amdgcn_mfma_f32_16x16x32_bf16(Bt[n][k], At[m][k], acc[ai][bj][m][n], 0, 0, 0); __builtin_amdgcn_s_setprio(0); } while (0)
#define PG8_WAIT_V(n) asm volatile("s_waitcnt vmcnt(" #n ")" ::: "memory")
#define PG8_WAIT_L(n) asm volatile("s_waitcnt lgkmcnt(" #n ")" ::: "memory")
#define PG8_BAR __builtin_amdgcn_s_barrier()
#define PG8_SCHED __builtin_amdgcn_sched_barrier(0)
    Unit cur, nxt; int ui = 0;
    if (!S.next(0, cur)) return;
    f32x4 acc[2][2][4][2];
#pragma unroll
    for (int a = 0; a < 2; ++a)
#pragma unroll
        for (int b = 0; b < 2; ++b)
#pragma unroll
            for (int m = 0; m < 4; ++m)
#pragma unroll
                for (int n = 0; n < 2; ++n) acc[a][b][m][n] = (f32x4){0.f, 0.f, 0.f, 0.f};
    bf16x8 At[4][2], B0[2][2], B1[2][2];
    const char* cA = (const char*)(cur.sec ? g.A2 : g.A) + (size_t)cur.pm * tstep; const char* cB = (const char*)(cur.sec ? g.Bt2 : g.Bt) + (size_t)cur.pn * tstep;
    S.a_ready(cur);
    if constexpr (SP2) {
        PG8_STAGE(PG8_SB(0, 0), cB, voffB); PG8_STAGE(PG8_SB(0, 1), cB + hstep, voffB); PG8_STAGE(PG8_SA(0, 0), cA, voffA); PG8_STAGE(PG8_SA(0, 1), cA + hstep, voffA);
        if (wr == 1) PG8_BAR;
        PG8_WAIT_V(2); PG8_BAR;
        PG8_STAGE(PG8_SB(1, 0), cB + kstep, voffB); PG8_STAGE(PG8_SA(1, 0), cA + kstep, voffA); PG8_STAGE(PG8_SB(1, 1), cB + hstep + kstep, voffB);
        PG8_WAIT_V(6); PG8_BAR;
    } else {
        PG8_STAGE(PG8_SB(0, 0), cB, voffB); PG8_STAGE(PG8_SA(0, 0), cA, voffA); PG8_STAGE(PG8_SB(0, 1), cB + hstep, voffB); PG8_STAGE(PG8_SA(0, 1), cA + hstep, voffA);
        if (wr == 1) PG8_BAR;
        PG8_WAIT_V(4); PG8_BAR;
        PG8_STAGE(PG8_SB(1, 0), cB + kstep, voffB); PG8_STAGE(PG8_SA(1, 0), cA + kstep, voffA); PG8_STAGE(PG8_SB(1, 1), cB + hstep + kstep, voffB);
        PG8_WAIT_V(6); PG8_BAR;
    }
    for (;;) {
        const bool has_next = S.next(ui + 1, nxt);
        const char* nA = has_next ? (const char*)(nxt.sec ? g.A2 : g.A) + (size_t)nxt.pm * tstep : cA; const char* nB = has_next ? (const char*)(nxt.sec ? g.Bt2 : g.Bt) + (size_t)nxt.pn * tstep : cB;
        for (int t = 0; t < nt; t += 2) {
            const bool last = (t == nt - 2);
            const char* a1 = cA + (size_t)(t + 1) * kstep;
            const char* a2 = last ? nA : cA + (size_t)(t + 2) * kstep; const char* b2 = last ? nB : cB + (size_t)(t + 2) * kstep;
            const char* a3 = a2 + kstep; const char* b3 = b2 + kstep;
            if (last && has_next) S.a_ready(nxt);
            if constexpr (SP2) {
            PG8_LDB(B0, 0, 0); PG8_LDB(B1, 0, 1); PG8_SCHED; PG8_LDA(At, 0, 0); PG8_STAGE(PG8_SA(1, 1), a1 + hstep, voffA);
            PG8_WAIT_V(8); PG8_WAIT_L(0); PG8_BAR; PG8_MMA(0, 0, At, B0); PG8_MMA(0, 1, At, B1); PG8_BAR; PG8_SCHED;
            PG8_LDA(At, 0, 1); PG8_STAGE(PG8_SB(0, 0), b2, voffB); PG8_STAGE(PG8_SB(0, 1), b2 + hstep, voffB); PG8_STAGE(PG8_SA(0, 0), a2, voffA);
            PG8_WAIT_V(8); PG8_WAIT_L(0); PG8_BAR; PG8_MMA(1, 0, At, B0); PG8_MMA(1, 1, At, B1); PG8_BAR; PG8_SCHED;
            PG8_LDB(B0, 1, 0); PG8_LDB(B1, 1, 1); PG8_SCHED; PG8_LDA(At, 1, 0); PG8_STAGE(PG8_SA(0, 1), a2 + hstep, voffA);
            PG8_WAIT_V(8); PG8_WAIT_L(0); PG8_BAR; PG8_MMA(0, 0, At, B0); PG8_MMA(0, 1, At, B1); PG8_BAR; PG8_SCHED;
            PG8_LDA(At, 1, 1); PG8_STAGE(PG8_SB(1, 0), b3, voffB); PG8_STAGE(PG8_SB(1, 1), b3 + hstep, voffB); PG8_STAGE(PG8_SA(1, 0), a3, voffA);
            PG8_WAIT_V(8); PG8_WAIT_L(0); PG8_BAR; PG8_MMA(1, 0, At, B0); PG8_MMA(1, 1, At, B1); PG8_BAR; PG8_SCHED;
            } else {
            PG8_LDB(B0, 0, 0); PG8_SCHED; PG8_LDA(At, 0, 0); PG8_STAGE(PG8_SA(1, 1), a1 + hstep, voffA);
            PG8_WAIT_L(8); PG8_BAR; PG8_WAIT_L(0); PG8_MMA(0, 0, At, B0); PG8_BAR; PG8_SCHED;
            PG8_LDB(B1, 0, 1); PG8_STAGE(PG8_SB(0, 0), b2, voffB);
            PG8_BAR; PG8_WAIT_L(0); PG8_MMA(0, 1, At, B1); PG8_BAR;
            PG8_LDA(At, 0, 1); PG8_STAGE(PG8_SA(0, 0), a2, voffA);
            PG8_BAR; PG8_WAIT_L(0); PG8_MMA(1, 0, At, B0); PG8_BAR; PG8_SCHED;
            PG8_STAGE(PG8_SB(0, 1), b2 + hstep, voffB);
            PG8_WAIT_V(6); PG8_BAR; PG8_MMA(1, 1, At, B1); PG8_BAR;
            PG8_LDB(B0, 1, 0); PG8_SCHED; PG8_LDA(At, 1, 0); PG8_STAGE(PG8_SA(0, 1), a2 + hstep, voffA);
            PG8_WAIT_L(8); PG8_BAR; PG8_WAIT_L(0); PG8_MMA(0, 0, At, B0); PG8_BAR; PG8_SCHED;
            PG8_LDB(B1, 1, 1); PG8_STAGE(PG8_SB(1, 0), b3, voffB);
            PG8_BAR; PG8_WAIT_L(0); PG8_MMA(0, 1, At, B1); PG8_BAR;
            PG8_LDA(At, 1, 1); PG8_STAGE(PG8_SA(1, 0), a3, voffA);
            PG8_BAR; PG8_WAIT_L(0); PG8_MMA(1, 0, At, B0); PG8_BAR; PG8_SCHED;
            PG8_STAGE(PG8_SB(1, 1), b3 + hstep, voffB);
            PG8_WAIT_V(6); PG8_BAR; PG8_MMA(1, 1, At, B1); PG8_BAR;
            }
        }
        if constexpr (ALIGN_EPI) { if (wr == 0) PG8_BAR; }
        if constexpr (!Epi::AFTER_DRAIN) { E(acc, cur, wr, wc, fr, fq); S.done(cur); }
        if (!has_next) break;
        if (!nxt.sec)
#pragma unroll
        for (int a = 0; a < 2; ++a)
#pragma unroll
            for (int b = 0; b < 2; ++b)
#pragma unroll
                for (int m = 0; m < 4; ++m)
#pragma unroll
                    for (int n = 0; n < 2; ++n) acc[a][b][m][n] = (f32x4){0.f, 0.f, 0.f, 0.f};
        cur = nxt; cA = nA; cB = nB; ++ui;
        if constexpr (ALIGN_EPI) { if (wr == 1) PG8_BAR; }
    }
    PG8_WAIT_V(0);
    if constexpr (!ALIGN_EPI) { if (wr == 0) PG8_BAR; }
    PG8_BAR;
    if constexpr (Epi::AFTER_DRAIN) { E.fused(acc, cur, wr, wc, fr, fq, lds, wid, lane); S.done(cur); }
#undef PG8_SA
#undef PG8_SB
#undef PG8_STAGE
#undef PG8_LDA
#undef PG8_LDB
#undef PG8_MMA
#undef PG8_WAIT_V
#undef PG8_WAIT_L
#undef PG8_BAR
#undef PG8_SCHED
}
}
namespace att {
typedef unsigned short bf16_t;
using bf16x8 = __attribute__((ext_vector_type(8))) short;
using s16x4  = __attribute__((ext_vector_type(4))) short;
using f32x16 = __attribute__((ext_vector_type(16))) float;
using f32x4  = __attribute__((ext_vector_type(4))) float;
using f32x2  = __attribute__((ext_vector_type(2))) float;
using u32x4  = __attribute__((ext_vector_type(4))) unsigned;
constexpr int NW = 8, QBLK = 32, KVBLK = 64;
constexpr int SHM_V = 16384, SHM_K = 16384;
constexpr int LDS_WSOFF = 3 * SHM_V + 4 * SHM_K;
constexpr int LDS_TB = LDS_WSOFF + NW * 64 * 4;
constexpr int ATT_LDS = LDS_TB + 1024;
constexpr float THR = 8.f;
#define KSWZ128(row, colB) ((row) * 256 + ((colB) ^ (((row) & 7) << 4)))
#define KSWZ64(row, colB)  ((row) * 128 + ((colB) ^ ((((row) >> 1) & 7) << 4)))
#define SBAR() __builtin_amdgcn_sched_barrier(0)
__device__ __forceinline__ int crow(int r, int hi) { return (r & 3) + 8 * (r >> 2) + 4 * hi; }
__device__ __forceinline__ unsigned cvtpk(float lo, float hi) { unsigned r; asm volatile("v_cvt_pk_bf16_f32 %0, %1, %2" : "=v"(r) : "v"(lo), "v"(hi)); return r; }
__device__ __forceinline__ bf16x8 ld8(const bf16_t* p) { return *reinterpret_cast<const bf16x8*>(p); }
__device__ __forceinline__ float bf2f(short v) { return __uint_as_float(((unsigned)(unsigned short)v) << 16); }

constexpr float THR2 = THR * 1.4426950408889634f;
template <int DK>
__device__ __forceinline__ void partialSM(f32x16& p0, f32x16& p1, float& m_reg, float& mn, float& alpha, const float cb) {
  float pmax = p0[0];
#pragma unroll
  for (int r = 1; r < 16; ++r) pmax = fmaxf(pmax, p0[r]);
#pragma unroll
  for (int r = 0; r < 16; ++r) pmax = fmaxf(pmax, p1[r]);
  { auto rr = __builtin_amdgcn_permlane32_swap(__float_as_uint(pmax), __float_as_uint(pmax), false, false);
    pmax = fmaxf(__uint_as_float(rr[0]), __uint_as_float(rr[1])); }
  pmax += cb;
  if (__builtin_expect(__all(pmax - m_reg <= THR2), 1)) { mn = m_reg; alpha = 1.f; }
  else { mn = fmaxf(m_reg, pmax); alpha = __builtin_amdgcn_exp2f(m_reg - mn); m_reg = mn; }
  const float mnC = cb - mn;
#pragma unroll
  for (int r = 0; r < 16; ++r) p0[r] += mnC;
#pragma unroll
  for (int r = 0; r < 16; ++r) p1[r] += mnC;
#pragma unroll
  for (int r = 0; r < 16; ++r) p0[r] = __builtin_amdgcn_exp2f(p0[r]);
}
template <bool NOEXP>
__device__ __forceinline__ void finishSM(f32x16& p0, f32x16& p1, float alpha, float& l_reg, bf16x8& pa0, bf16x8& pa1, bf16x8& pa2, bf16x8& pa3) {
  if constexpr (!NOEXP) {
#pragma unroll
  for (int r = 0; r < 16; ++r) p1[r] = __builtin_amdgcn_exp2f(p1[r]); }
  float ps = 0;
#pragma unroll
  for (int r = 0; r < 16; ++r) ps += p0[r];
#pragma unroll
  for (int r = 0; r < 16; ++r) ps += p1[r];
  { auto rr = __builtin_amdgcn_permlane32_swap(__float_as_uint(ps), __float_as_uint(ps), false, false);
    ps = __uint_as_float(rr[0]) + __uint_as_float(rr[1]); }
  l_reg = l_reg * alpha + ps;
#define PK4(P, BASE, OUT) do { unsigned a0 = cvtpk(P[BASE + 0], P[BASE + 1]), a1 = cvtpk(P[BASE + 2], P[BASE + 3]);   \
    unsigned b0 = cvtpk(P[BASE + 4], P[BASE + 5]), b1 = cvtpk(P[BASE + 6], P[BASE + 7]);                              \
    auto r0 = __builtin_amdgcn_permlane32_swap(a0, b0, false, false); auto r1 = __builtin_amdgcn_permlane32_swap(a1, b1, false, false); \
    u32x4 w = {r0[0], r1[0], r0[1], r1[1]}; OUT = *reinterpret_cast<bf16x8*>(&w); } while (0)
  PK4(p0, 0, pa0); PK4(p0, 8, pa1); PK4(p1, 0, pa2); PK4(p1, 8, pa3);
#undef PK4
}
__device__ __forceinline__ void add_bias(f32x16& p0, f32x16& p1, const float* tb, int relb, int hi) {
#pragma unroll
  for (int r = 0; r < 16; ++r) { const int i0 = relb + crow(r, hi), i1 = i0 + 32;
    p0[r] += tb[min(max(i0, 0), 255)]; p1[r] += tb[min(max(i1, 0), 255)]; }
}
template <int DK>
__device__ __forceinline__ void qkt(f32x16& p0, f32x16& p1, const char* Ks, const bf16x8* qr, int r32, int hi) {
  p0 = f32x16{}; p1 = f32x16{};
#pragma unroll
  for (int d0 = 0; d0 < DK / 16; ++d0) { const int cb = (d0 * 16 + hi * 8) * 2;
    bf16x8 b0, b1;
    if constexpr (DK == 128) { b0 = *reinterpret_cast<const bf16x8*>(Ks + KSWZ128(r32, cb)); b1 = *reinterpret_cast<const bf16x8*>(Ks + KSWZ128(32 + r32, cb)); }
    else { b0 = *reinterpret_cast<const bf16x8*>(Ks + KSWZ64(r32, cb)); b1 = *reinterpret_cast<const bf16x8*>(Ks + KSWZ64(32 + r32, cb)); }
    p0 = __builtin_amdgcn_mfma_f32_32x32x16_bf16(b0, qr[d0], p0, 0, 0, 0);
    p1 = __builtin_amdgcn_mfma_f32_32x32x16_bf16(b1, qr[d0], p1, 0, 0, 0); }
}
__device__ __forceinline__ int v_st(int k, int c) { const int kk = (k & ~0xC) | ((k & 4) << 1) | ((k & 8) >> 1); return ((kk >> 3) * 4 + (c >> 5)) * 512 + ((kk & 7) * 32 + (c & 31)) * 2; }
__device__ __forceinline__ int v_rd_base(int lane) { return ((lane & 3) << 3) | (((lane >> 2) & 3) << 6) | (((lane >> 4) & 1) << 5) | (((lane >> 5) & 1) << 8); }
constexpr int v_rd_off(int d0, int ks, int half) { return d0 * 512 + ks * 4096 + half * 2048; }
template <int OFF> __device__ __forceinline__ s16x4 tr_read(int vb) {
  s16x4 r; asm volatile("ds_read_b64_tr_b16 %0, %1 offset:%2" : "=&v"(r) : "v"(vb), "i"(OFF) : "memory"); return r;
}
template <int D0> __device__ __forceinline__ void pv_one(f32x16& od, int vb, bf16x8 pa0, bf16x8 pa1, bf16x8 pa2, bf16x8 pa3) {
  const s16x4 l0 = tr_read<v_rd_off(D0, 0, 0)>(vb), h0 = tr_read<v_rd_off(D0, 0, 1)>(vb), l1 = tr_read<v_rd_off(D0, 1, 0)>(vb), h1 = tr_read<v_rd_off(D0, 1, 1)>(vb);
  const s16x4 l2 = tr_read<v_rd_off(D0, 2, 0)>(vb), h2 = tr_read<v_rd_off(D0, 2, 1)>(vb), l3 = tr_read<v_rd_off(D0, 3, 0)>(vb), h3 = tr_read<v_rd_off(D0, 3, 1)>(vb);
  asm volatile("s_waitcnt lgkmcnt(0)" ::: "memory"); SBAR();
#define PK(L, H) (bf16x8){L[0], L[1], L[2], L[3], H[0], H[1], H[2], H[3]}
  od = __builtin_amdgcn_mfma_f32_32x32x16_bf16(pa0, PK(l0, h0), od, 0, 0, 0);
  od = __builtin_amdgcn_mfma_f32_32x32x16_bf16(pa1, PK(l1, h1), od, 0, 0, 0);
  od = __builtin_amdgcn_mfma_f32_32x32x16_bf16(pa2, PK(l2, h2), od, 0, 0, 0);
  od = __builtin_amdgcn_mfma_f32_32x32x16_bf16(pa3, PK(l3, h3), od, 0, 0, 0);
#undef PK
}
__device__ __forceinline__ void pv_d0(f32x16* o, int vb, bf16x8 pa0, bf16x8 pa1, bf16x8 pa2, bf16x8 pa3) {
  pv_one<0>(o[0], vb, pa0, pa1, pa2, pa3); pv_one<1>(o[1], vb, pa0, pa1, pa2, pa3); pv_one<2>(o[2], vb, pa0, pa1, pa2, pa3); pv_one<3>(o[3], vb, pa0, pa1, pa2, pa3);
}

typedef __attribute__((address_space(3))) const char* lds_cptr;
typedef short v4i16_t __attribute__((ext_vector_type(4)));
__device__ __forceinline__ s16x4 vtr(lds_cptr p) { return __builtin_bit_cast(s16x4, __builtin_amdgcn_ds_read_tr16_b64_v4i16((__attribute__((address_space(3))) v4i16_t*)p)); }
__device__ __forceinline__ float max3f(float a, float b, float c) { return fmaxf(fmaxf(a, b), c); }
#define PIN(x) asm volatile("" : "+v"(x))
#define PK4R(P, BASE, OUT) do { unsigned a0 = cvtpk(P[BASE + 0], P[BASE + 1]), a1 = cvtpk(P[BASE + 2], P[BASE + 3]);   \
    unsigned b0 = cvtpk(P[BASE + 4], P[BASE + 5]), b1 = cvtpk(P[BASE + 6], P[BASE + 7]);                              \
    auto r0 = __builtin_amdgcn_permlane32_swap(a0, b0, false, false); auto r1 = __builtin_amdgcn_permlane32_swap(a1, b1, false, false); \
    u32x4 w = {r0[0], r1[0], r0[1], r1[1]}; OUT = *reinterpret_cast<bf16x8*>(&w); } while (0)
template <int DK, bool NOMAX>
__device__ __forceinline__ void qk_fs(f32x16& c0, f32x16& c1, const char* Ks, const bf16x8* qr, const int r32, const int hi,
                                      f32x16& p0, f32x16& p1, const float alpha, float& l_reg, bf16x8* pa,
                                      bf16x8 (&kf)[2][2], const lds_cptr vp, s16x4 (&vl)[3], s16x4 (&vh)[3]) {
  constexpr int NS = DK / 16, RPS = 16 / NS;
#define KRD_(S, D0) do { const int cb_ = ((D0) * 16 + hi * 8) * 2; \
    if constexpr (DK == 128) { kf[S][0] = *reinterpret_cast<const bf16x8*>(Ks + KSWZ128(r32, cb_)); kf[S][1] = *reinterpret_cast<const bf16x8*>(Ks + KSWZ128(32 + r32, cb_)); } \
    else { kf[S][0] = *reinterpret_cast<const bf16x8*>(Ks + KSWZ64(r32, cb_)); kf[S][1] = *reinterpret_cast<const bf16x8*>(Ks + KSWZ64(32 + r32, cb_)); } } while (0)
  float psa = 0.f, psb = 0.f;
  SBAR();
#pragma unroll
  for (int d0 = 0; d0 < NS; ++d0) {
    if (d0 == 0) { c0 = __builtin_amdgcn_mfma_f32_32x32x16_bf16(kf[0][0], qr[0], f32x16{}, 0, 0, 0); c1 = __builtin_amdgcn_mfma_f32_32x32x16_bf16(kf[0][1], qr[0], f32x16{}, 0, 0, 0); }
    else { c0 = __builtin_amdgcn_mfma_f32_32x32x16_bf16(kf[d0 & 1][0], qr[d0], c0, 0, 0, 0); c1 = __builtin_amdgcn_mfma_f32_32x32x16_bf16(kf[d0 & 1][1], qr[d0], c1, 0, 0, 0); }
    if (d0 + 2 < NS) KRD_(d0 & 1, d0 + 2);
    if constexpr (NOMAX) { }
    else {
#pragma unroll
    for (int r = d0 * RPS; r < (d0 + 1) * RPS; ++r) { p1[r] = __builtin_amdgcn_exp2f(p1[r]); psa += p0[r]; }
    if (d0 > 0) {
#pragma unroll
      for (int r = (d0 - 1) * RPS; r < d0 * RPS; ++r) psb += p1[r]; } }
    if constexpr (NOMAX) {
      if (d0 == NS / 4 - 1) { PK4R(p0, 0, pa[0]); PIN(pa[0]); }
      if (d0 == NS / 2 - 1) { PK4R(p0, 8, pa[1]); PIN(pa[1]); }
      if (d0 == 3 * NS / 4 - 1) { PK4R(p1, 0, pa[2]); PIN(pa[2]); }
      if (d0 == NS - 1) { PK4R(p1, 8, pa[3]); PIN(pa[3]); }
    } else {
    if (d0 == NS / 2 - 1) { PK4R(p0, 0, pa[0]); PIN(pa[0]); }
    if (d0 == NS / 2) { PK4R(p0, 8, pa[1]); PIN(pa[1]); }
    if (d0 == NS - 1) { PK4R(p1, 0, pa[2]); PIN(pa[2]); }
    }
    if (d0 == NS - 1) {
      vl[0] = vtr(vp + v_rd_off(0, 0, 0)); vh[0] = vtr(vp + v_rd_off(0, 0, 1)); vl[1] = vtr(vp + v_rd_off(1, 0, 0)); vh[1] = vtr(vp + v_rd_off(1, 0, 1)); }
    PIN(p1); PIN(psa); PIN(psb);
    SBAR();
  }
#undef KRD_
  if constexpr (!NOMAX) {
#pragma unroll
  for (int r = (NS - 1) * RPS; r < 16; ++r) psb += p1[r];
  float ps = psa + psb;
  { auto rr = __builtin_amdgcn_permlane32_swap(__float_as_uint(ps), __float_as_uint(ps), false, false);
    ps = __uint_as_float(rr[0]) + __uint_as_float(rr[1]); }
  l_reg = l_reg * alpha + ps;
  PK4R(p1, 8, pa[3]); }
}
template <int DK, bool NOMAX>
__device__ __forceinline__ void pv_psm(f32x16* o, const lds_cptr vp, const bf16x8* pa, f32x16& c0, f32x16& c1, float& m_reg, float& alpha, const float cb,
                                       s16x4 (&vl)[3], s16x4 (&vh)[3], bf16x8 (&kf)[2][2], const char* Kn, const int r32, const int hi, float& l_reg) {
  float psa = 0.f, psb = 0.f;
#define VRD_(S, I) do { vl[S] = vtr(vp + v_rd_off((I) & 3, (I) >> 2, 0)); vh[S] = vtr(vp + v_rd_off((I) & 3, (I) >> 2, 1)); } while (0)
#define VFR_(S) (bf16x8){vl[S][0], vl[S][1], vl[S][2], vl[S][3], vh[S][0], vh[S][1], vh[S][2], vh[S][3]}
  float ma = 0.f, mb = 0.f, mnC = 0.f;
  SBAR();
#pragma unroll
  for (int i = 0; i < 16; ++i) {
    if (i + 2 < 16) VRD_((i + 2) % 3, i + 2);
    if (i == 12 || i == 13) { const int cb_ = ((i - 12) * 16 + hi * 8) * 2;
      if constexpr (DK == 128) { kf[i - 12][0] = *reinterpret_cast<const bf16x8*>(Kn + KSWZ128(r32, cb_)); kf[i - 12][1] = *reinterpret_cast<const bf16x8*>(Kn + KSWZ128(32 + r32, cb_)); }
      else { kf[i - 12][0] = *reinterpret_cast<const bf16x8*>(Kn + KSWZ64(r32, cb_)); kf[i - 12][1] = *reinterpret_cast<const bf16x8*>(Kn + KSWZ64(32 + r32, cb_)); } }
    SBAR();
    o[i & 3] = __builtin_amdgcn_mfma_f32_32x32x16_bf16(pa[i >> 2], VFR_(i % 3), o[i & 3], 0, 0, 0);
    if constexpr (NOMAX) { c0[i] = __builtin_amdgcn_exp2f(c0[i]); c1[i] = __builtin_amdgcn_exp2f(c1[i]); if (i > 0) { psa += c0[i - 1]; psb += c1[i - 1]; } PIN(c0); PIN(c1); PIN(psa); PIN(psb); }
    else {
    if (i == 0) { ma = max3f(c0[0], c0[1], c1[0]); mb = max3f(c0[2], c0[3], c1[1]); ma = max3f(ma, c1[2], c1[3]); }
    if (i >= 1 && i <= 3) { const int r = 4 * i; ma = max3f(ma, c0[r], c0[r + 1]); mb = max3f(mb, c0[r + 2], c0[r + 3]); ma = max3f(ma, c1[r], c1[r + 1]); mb = max3f(mb, c1[r + 2], c1[r + 3]); }
    if (i == 4) { float pmax = fmaxf(ma, mb);
      { auto rr = __builtin_amdgcn_permlane32_swap(__float_as_uint(pmax), __float_as_uint(pmax), false, false);
        pmax = fmaxf(__uint_as_float(rr[0]), __uint_as_float(rr[1])); }
      pmax += cb;
      const bool keep = __all(pmax - m_reg <= THR2);
      const float mn = keep ? m_reg : fmaxf(m_reg, pmax);
      alpha = __builtin_amdgcn_exp2f(m_reg - mn); m_reg = mn; mnC = cb - mn; }
    if (i >= 5 && i <= 8) { const int r = 4 * (i - 5);
#pragma unroll
      for (int q = 0; q < 4; ++q) { c0[r + q] += mnC; c1[r + q] += mnC; } }
    if (i >= 9) { const int r0 = (i - 9) * 2 + (i > 14 ? 1 : 0), n = i >= 14 ? 3 : 2;
#pragma unroll
      for (int q = 0; q < n; ++q) c0[r0 + q] = __builtin_amdgcn_exp2f(c0[r0 + q]); }
    if (i <= 3) { PIN(ma); PIN(mb); }
    if (i == 4) { PIN(mnC); PIN(alpha); PIN(m_reg); }
    if (i >= 5 && i <= 8) { PIN(c0); PIN(c1); }
    if (i >= 9) PIN(c0);
    }
    SBAR();
  }
#undef VRD_
#undef VFR_
  if constexpr (NOMAX) { float ps = (psa + c0[15]) + (psb + c1[15]);
    { auto rr = __builtin_amdgcn_permlane32_swap(__float_as_uint(ps), __float_as_uint(ps), false, false);
      ps = __uint_as_float(rr[0]) + __uint_as_float(rr[1]); }
    l_reg = l_reg * alpha + ps; }
}

constexpr int RING_K = 0, RING_V = 4 * SHM_K;
template <int DK, int LDK, bool BIAS, bool NOMAX>
__device__ __forceinline__ void flash_pass(const bf16x8* qr, const bf16_t* __restrict__ Kh, const bf16_t* __restrict__ Vh, const int seq, char* lds,
                                           f32x16* o, float& l_out, const int qlo, const float b_neg, const float b_pos) {
  int tid_ = threadIdx.x; asm volatile("" : "+v"(tid_));
  const int tid = tid_, lane = tid & 63, r32 = lane & 31, hi = lane >> 5; const int wid = __builtin_amdgcn_readfirstlane(tid >> 6);
  typedef __attribute__((address_space(3))) unsigned* lds_uptr;
  char* K_lds = lds + RING_K; char* V_lds = lds + RING_V;
  float* ws = (float*)(lds + LDS_WSOFF) + wid * 64; float* al_l = ws + 32;
  const float* tb = (const float*)(lds + LDS_TB);
  float m_reg = -1e30f, l_reg = 0.f;
  o[0] = f32x16{}; o[1] = f32x16{}; o[2] = f32x16{}; o[3] = f32x16{};
  int koff0, koff1 = 0, voff0, voff1;
  if constexpr (DK == 128) { { const int r = 4 * wid + (lane >> 4), c = (lane & 15) ^ (r & 7); koff0 = r * LDK + c * 8; }
                             { const int r = 4 * (wid + 8) + (lane >> 4), c = (lane & 15) ^ (r & 7); koff1 = r * LDK + c * 8; } }
  else { const int r = 8 * wid + (lane >> 3), c = (lane & 7) ^ ((r >> 1) & 7); koff0 = r * LDK + c * 8; }
  { const int st = 2 * wid + (lane >> 5), kk = (st >> 2) * 8 + ((lane & 31) >> 2), k = (kk & ~0xC) | ((kk & 4) << 1) | ((kk & 8) >> 1); voff0 = k * LDK + (st & 3) * 32 + (lane & 3) * 8; }
  { const int st = 2 * (wid + 8) + (lane >> 5), kk = (st >> 2) * 8 + ((lane & 31) >> 2), k = (kk & ~0xC) | ((kk & 4) << 1) | ((kk & 8) >> 1); voff1 = k * LDK + (st & 3) * 32 + (lane & 3) * 8; }
  const bf16_t* ks0 = Kh + koff0; const bf16_t* ks1 = Kh + koff1; const bf16_t* vs0 = Vh + voff0; const bf16_t* vs1 = Vh + voff1;
  const lds_uptr kdst = (lds_uptr)(K_lds + wid * 1024), vdst = (lds_uptr)(V_lds + wid * 1024);
#define GLDS(G, L) __builtin_amdgcn_global_load_lds((const unsigned*)(G), (L), 16, 0, 0)
#define DMA_K(T, SL) do { const long t_ = (long)(T) * (KVBLK * LDK); GLDS(ks0 + t_, (lds_uptr)((__attribute__((address_space(3))) char*)kdst + (SL))); \
    if constexpr (DK == 128) GLDS(ks1 + t_, (lds_uptr)((__attribute__((address_space(3))) char*)kdst + (SL) + 8192)); } while (0)
#define DMA_V(T, SL) do { const long t_ = (long)(T) * (KVBLK * LDK); GLDS(vs0 + t_, (lds_uptr)((__attribute__((address_space(3))) char*)vdst + (SL))); \
    GLDS(vs1 + t_, (lds_uptr)((__attribute__((address_space(3))) char*)vdst + (SL) + 8192)); } while (0)
#define WBAR(N) asm volatile("s_waitcnt vmcnt(" #N ") lgkmcnt(0)\n\ts_barrier" ::: "memory")
#define RESC(a) do { if (__any((a) != 1.f)) { if (hi == 0) al_l[r32] = (a); asm volatile("s_waitcnt lgkmcnt(0)" ::: "memory"); \
    _Pragma("unroll") for (int d = 0; d < 4; ++d) _Pragma("unroll") for (int r = 0; r < 16; ++r) o[d][r] *= al_l[crow(r, hi)]; } } while (0)
#define PSM(P0, P1, T, MN, AL) do { float cb_ = 0.f; \
    if constexpr (BIAS) { const int k0_ = (T) * KVBLK; const int rmin_ = k0_ - (qlo + 31), rmax_ = k0_ + 63 - qlo; \
      if (rmin_ >= 91) cb_ = b_pos; else if (rmax_ <= -91) cb_ = b_neg; \
      else add_bias(P0, P1, tb, k0_ - (qlo + r32) + 128, hi); } \
    partialSM<DK>(P0, P1, m_reg, MN, AL, cb_); } while (0)
#define TBIAS(P0, P1, T) float cb_ = 0.f; \
    if constexpr (BIAS) { const int k0_ = (T) * KVBLK; const int rmin_ = k0_ - (qlo + 31), rmax_ = k0_ + 63 - qlo; \
      if (rmin_ >= 91) cb_ = b_pos; else if (rmax_ <= -91) cb_ = b_neg; \
      else add_bias(P0, P1, tb, k0_ - (qlo + r32) + 128, hi); }
  float curb = 0.f;
  f32x16 pA0, pA1, pB0, pB1; float mnA, alA, alB; bf16x8 pa[4]; const int NT = seq / KVBLK;
  const lds_cptr vp0 = (lds_cptr)V_lds + v_rd_base(lane);
  const int vb0 = (int)(uintptr_t)V_lds + v_rd_base(lane);
  WBAR(0);
  DMA_K(0, 0); DMA_V(0, 0); DMA_K(1, SHM_K); DMA_K(2, 2 * SHM_K);
  if constexpr (DK == 128) WBAR(6); else WBAR(4);
  qkt<DK>(pA0, pA1, K_lds, qr, r32, hi);
  if constexpr (NOMAX) { TBIAS(pA0, pA1, 0); curb = cb_; alA = 1.f;
#pragma unroll
    for (int r = 0; r < 16; ++r) { pA0[r] = __builtin_amdgcn_exp2f(pA0[r]); pA1[r] = __builtin_amdgcn_exp2f(pA1[r]); }
    float ps0 = 0.f;
#pragma unroll
    for (int r = 0; r < 16; ++r) ps0 += pA0[r] + pA1[r];
    { auto rr = __builtin_amdgcn_permlane32_swap(__float_as_uint(ps0), __float_as_uint(ps0), false, false);
      ps0 = __uint_as_float(rr[0]) + __uint_as_float(rr[1]); }
    l_reg = ps0; }
  else PSM(pA0, pA1, 0, mnA, alA);
  DMA_K(3, 3 * SHM_K); DMA_V(1, SHM_V);
  if constexpr (DK == 128) WBAR(4); else WBAR(3);
  bf16x8 kf[2][2]; s16x4 vl[3], vh[3];
#pragma unroll
  for (int q = 0; q < 2; ++q) { const int cbq = (q * 16 + hi * 8) * 2;
    if constexpr (DK == 128) { kf[q][0] = *reinterpret_cast<const bf16x8*>(K_lds + SHM_K + KSWZ128(r32, cbq)); kf[q][1] = *reinterpret_cast<const bf16x8*>(K_lds + SHM_K + KSWZ128(32 + r32, cbq)); }
    else { kf[q][0] = *reinterpret_cast<const bf16x8*>(K_lds + SHM_K + KSWZ64(r32, cbq)); kf[q][1] = *reinterpret_cast<const bf16x8*>(K_lds + SHM_K + KSWZ64(32 + r32, cbq)); } }
  int sp = 0, sj = SHM_V, sn = 2 * SHM_V;
#define STEPT(C0, C1, P0, P1, ALP, ALC, J) do { \
    qk_fs<DK, NOMAX>(C0, C1, K_lds + ((J) & 3) * SHM_K, qr, r32, hi, P0, P1, ALP, l_reg, pa, kf, vp0 + sp, vl, vh); \
    if ((J) + 3 < NT) DMA_K((J) + 3, (((J) + 3) & 3) * SHM_K); if ((J) + 1 < NT) DMA_V((J) + 1, sn); SBAR(); \
    { TBIAS(C0, C1, J); if constexpr (NOMAX) { ALC = __builtin_amdgcn_exp2f(curb - cb_); curb = cb_; } \
      pv_psm<DK, NOMAX>(o, vp0 + sp, pa, C0, C1, m_reg, ALC, cb_, vl, vh, kf, K_lds + (((J) + 1) & 3) * SHM_K, r32, hi, l_reg); } \
    RESC(ALC); \
    if ((J) + 3 < NT) { if constexpr (DK == 128) WBAR(4); else WBAR(3); } else WBAR(0); \
    { const int t_ = sp; sp = sj; sj = sn; sn = t_; } } while (0)
  for (int j = 1; j + 1 < NT; j += 2) {
    STEPT(pB0, pB1, pA0, pA1, alA, alB, j);
    STEPT(pA0, pA1, pB0, pB1, alB, alA, j + 1);
  }
  STEPT(pB0, pB1, pA0, pA1, alA, alB, NT - 1);
  if constexpr (NOMAX) { PK4R(pB0, 0, pa[0]); PK4R(pB0, 8, pa[1]); PK4R(pB1, 0, pa[2]); PK4R(pB1, 8, pa[3]); }
  else finishSM<false>(pB0, pB1, alB, l_reg, pa[0], pa[1], pa[2], pa[3]);
  SBAR();
  pv_d0(o, vb0 + sp, pa[0], pa[1], pa[2], pa[3]);
  l_out = l_reg;
#undef GLDS
#undef DMA_K
#undef DMA_V
#undef WBAR
#undef RESC
#undef PSM
#undef TBIAS
#undef STEPT
}
__device__ __forceinline__ void row_rcp(float l_reg, float* ws, int r32, int hi, float* rli) {
  if (hi == 0) ws[r32] = l_reg; asm volatile("s_waitcnt lgkmcnt(0)" ::: "memory");
#pragma unroll
  for (int r = 0; r < 16; ++r) rli[r] = __builtin_amdgcn_rcpf(ws[crow(r, hi)]);
  asm volatile("s_waitcnt lgkmcnt(0)" ::: "memory");
}
__device__ __forceinline__ float silu(float z) { return z * __builtin_amdgcn_rcpf(1.0f + __builtin_amdgcn_exp2f(-1.4426950408889634f * z)); }
constexpr int STG_LD = 132;
constexpr int STG_WAVE = 32 * STG_LD * 4;
template <bool NORM>
__device__ __forceinline__ void out_rows(const f32x16* o, const float* rli_or_null, char* lds, const float* gain, const float gscale,
                                         const bf16_t* Z, bf16_t* O, const size_t obase  ) {
  int tid_ = threadIdx.x; asm volatile("" : "+v"(tid_));
  const int tid = tid_, wid = tid >> 6, lane = tid & 63, r32 = lane & 31, hi = lane >> 5;
  float* stg = (float*)(lds + wid * STG_WAVE);
  const int c8 = (lane & 15) * 8, rsub = lane >> 4;
  u32x4 zq[8];
#pragma unroll
  for (int it = 0; it < 8; ++it) zq[it] = *(const u32x4*)(Z + obase + (size_t)(it * 4 + rsub) * 1024 + c8);
#pragma unroll
  for (int d0 = 0; d0 < 4; ++d0)
#pragma unroll
    for (int r = 0; r < 16; ++r) stg[crow(r, hi) * STG_LD + d0 * 32 + r32] = rli_or_null ? o[d0][r] * rli_or_null[r] : o[d0][r];
  asm volatile("s_waitcnt lgkmcnt(0)" ::: "memory");
  f32x4 g0 = {1.f, 1.f, 1.f, 1.f}, g1 = {1.f, 1.f, 1.f, 1.f};
  if constexpr (NORM) { g0 = *(const f32x4*)(gain + c8) * gscale; g1 = *(const f32x4*)(gain + c8 + 4) * gscale; }
#pragma unroll
  for (int it = 0; it < 8; ++it) { const int row = it * 4 + rsub;
    f32x4 v0 = *(const f32x4*)(stg + row * STG_LD + c8), v1 = *(const f32x4*)(stg + row * STG_LD + c8 + 4);
    const size_t off = obase + (size_t)row * 1024 + c8;
    const u32x4 zv = zq[it];
    if constexpr (NORM) {
      float ssq = (v0[0] * v0[0] + v0[1] * v0[1]) + (v0[2] * v0[2] + v0[3] * v0[3]) + (v1[0] * v1[0] + v1[1] * v1[1]) + (v1[2] * v1[2] + v1[3] * v1[3]);
      ssq += __shfl_xor(ssq, 1); ssq += __shfl_xor(ssq, 2); ssq += __shfl_xor(ssq, 4); ssq += __shfl_xor(ssq, 8);
      const float rstd = __builtin_amdgcn_rsqf(ssq * (1.0f / 128.0f) + 1e-6f);
      v0 = v0 * rstd * g0; v1 = v1 * rstd * g1; }
    v0[0] *= silu(__uint_as_float(zv.x << 16)); v0[1] *= silu(__uint_as_float(zv.x & 0xffff0000u));
    v0[2] *= silu(__uint_as_float(zv.y << 16)); v0[3] *= silu(__uint_as_float(zv.y & 0xffff0000u));
    v1[0] *= silu(__uint_as_float(zv.z << 16)); v1[1] *= silu(__uint_as_float(zv.z & 0xffff0000u));
    v1[2] *= silu(__uint_as_float(zv.w << 16)); v1[3] *= silu(__uint_as_float(zv.w & 0xffff0000u));
    u32x4 w = {cvtpk(v0[0], v0[1]), cvtpk(v0[2], v0[3]), cvtpk(v1[0], v1[1]), cvtpk(v1[2], v1[3])};
    *(u32x4*)(O + off) = w; }
}

__device__ __forceinline__ void item_a(bf16_t* OUT, const bf16_t* QA, const bf16_t* KA, const bf16_t* VA, const bf16_t* ZA, const float* tabA, const float* subln, const float lam,
                                       float* scr, const int rowbase, const int q0, const int h, const int S, char* lds) {
  int tid_ = threadIdx.x; asm volatile("" : "+v"(tid_));
  const int tid = tid_, wid = tid >> 6, lane = tid & 63, r32 = lane & 31, hi = lane >> 5;
  float* tb = (float*)(lds + LDS_TB); float* ws = (float*)(lds + LDS_WSOFF) + wid * 64;
  if (tid < 256) tb[tid] = tabA[h * 256 + tid];
  const float b_neg = tabA[h * 256], b_pos = tabA[h * 256 + 255];
  const int qlo = q0 + wid * 32;
  const bf16_t* Kh = KA + (size_t)rowbase * 1024 + h * 128; const bf16_t* Vh = VA + (size_t)rowbase * 1024 + h * 128;
  const bf16_t* Qrow = QA + (size_t)(rowbase + qlo + r32) * 1024 + h * 128 + hi * 8;
  f32x16 o[4]; float l; bf16x8 qr[4];
#pragma unroll 1
  for (int mp = 0; mp < 2; ++mp) {
#pragma unroll
    for (int d0 = 0; d0 < 4; ++d0) qr[d0] = ld8(Qrow + mp * 64 + d0 * 16);
    volatile unsigned* badf = (volatile unsigned*)(lds + LDS_TB + 1024);
    if (tid == 0) *badf = 0u;
    flash_pass<64, 1024, true, true>(qr, Kh + mp * 64, Vh, S, lds, o, l, qlo, b_neg, b_pos);
    if (!(l > 1e-30f && l < 1e30f)) *badf = 1u;
    __syncthreads(); const unsigned redo = (PROBE == 20) ? 1u : *badf; __syncthreads();
    if (redo != 0u) flash_pass<64, 1024, true, false>(qr, Kh + mp * 64, Vh, S, lds, o, l, qlo, b_neg, b_pos);
    float rli[16]; row_rcp(l, ws, r32, hi, rli);
    if (mp == 0) {
#pragma unroll
      for (int d0 = 0; d0 < 4; ++d0)
#pragma unroll
        for (int r = 0; r < 16; r += 8) { u32x4 w;
          w.x = cvtpk(o[d0][r] * rli[r], o[d0][r + 1] * rli[r + 1]);         w.y = cvtpk(o[d0][r + 2] * rli[r + 2], o[d0][r + 3] * rli[r + 3]);
          w.z = cvtpk(o[d0][r + 4] * rli[r + 4], o[d0][r + 5] * rli[r + 5]); w.w = cvtpk(o[d0][r + 6] * rli[r + 6], o[d0][r + 7] * rli[r + 7]);
          ((u32x4*)(scr + tid * 32))[d0 * 2 + (r >> 3)] = w; }
    } else {
#pragma unroll
      for (int d0 = 0; d0 < 4; ++d0)
#pragma unroll
        for (int r = 0; r < 16; r += 8) { const u32x4 w = ((const u32x4*)(scr + tid * 32))[d0 * 2 + (r >> 3)];
          const unsigned ww[4] = {w.x, w.y, w.z, w.w};
#pragma unroll
          for (int q = 0; q < 4; ++q) { o[d0][r + 2 * q] = __uint_as_float(ww[q] << 16) - lam * (o[d0][r + 2 * q] * rli[r + 2 * q]);
            o[d0][r + 2 * q + 1] = __uint_as_float(ww[q] & 0xffff0000u) - lam * (o[d0][r + 2 * q + 1] * rli[r + 2 * q + 1]); } }
    }
  }
  __syncthreads();
  out_rows<true>(o, nullptr, lds, subln, 0.8f, ZA, OUT, (size_t)(rowbase + qlo) * 1024 + h * 128);
  __syncthreads();
}

__device__ __forceinline__ void item_b(bf16_t* OUT, const bf16_t* QB, const bf16_t* KB, const bf16_t* VB, const bf16_t* ZB, const float* qg, const f32x2* rt,
                                       const int rowbase, const int q0, const int h, const int S, char* lds) {
  int tid_ = threadIdx.x; asm volatile("" : "+v"(tid_));
  const int tid = tid_, wid = tid >> 6, lane = tid & 63, r32 = lane & 31, hi = lane >> 5;
  float* ws = (float*)(lds + LDS_WSOFF) + wid * 64;
  const int qlo = q0 + wid * 32, t = qlo + r32, kvh = h >> 2;
  const bf16_t* Kh = KB + (size_t)rowbase * 256 + kvh * 128; const bf16_t* Vh = VB + (size_t)rowbase * 256 + kvh * 128;
  const bf16_t* Qrow = QB + (size_t)(rowbase + t) * 1024 + h * 128 + hi * 8;
  bf16x8 qr[8];
  { float f[8][8]; float ssq = 0.f;
#pragma unroll
    for (int d0 = 0; d0 < 8; ++d0) { const bf16x8 raw = ld8(Qrow + d0 * 16);
#pragma unroll
      for (int j = 0; j < 8; ++j) { f[d0][j] = bf2f(raw[j]); ssq += f[d0][j] * f[d0][j]; } }
    { auto rr = __builtin_amdgcn_permlane32_swap(__float_as_uint(ssq), __float_as_uint(ssq), false, false);
      ssq = __uint_as_float(rr[0]) + __uint_as_float(rr[1]); }
    const float rstd = __builtin_amdgcn_rsqf(ssq * (1.0f / 128.0f) + 1e-6f) * (0.08838834764831845f * 1.4426950408889634f);
#pragma unroll
    for (int d0 = 0; d0 < 8; ++d0) { const f32x4 g0 = *(const f32x4*)(qg + d0 * 16 + hi * 8), g1 = *(const f32x4*)(qg + d0 * 16 + hi * 8 + 4);
#pragma unroll
      for (int j = 0; j < 4; ++j) { f[d0][j] *= rstd * g0[j]; f[d0][4 + j] *= rstd * g1[j]; } }
#pragma unroll
    for (int hf = 0; hf < 2; ++hf) { const int idx = hf == 0 ? (t >> 6) : (t & 63);
#pragma unroll
      for (int dp = 0; dp < 2; ++dp)
#pragma unroll
        for (int j = 0; j < 8; ++j) { const f32x2 cs = rt[idx * 32 + dp * 16 + hi * 8 + j];
          const float u1 = f[hf * 4 + dp][j], u2 = f[hf * 4 + dp + 2][j];
          f[hf * 4 + dp][j] = u1 * cs.x - u2 * cs.y; f[hf * 4 + dp + 2][j] = u1 * cs.y + u2 * cs.x; } }
#pragma unroll
    for (int d0 = 0; d0 < 8; ++d0) { u32x4 w = {cvtpk(f[d0][0], f[d0][1]), cvtpk(f[d0][2], f[d0][3]), cvtpk(f[d0][4], f[d0][5]), cvtpk(f[d0][6], f[d0][7])};
      qr[d0] = *reinterpret_cast<bf16x8*>(&w); }
  }
  f32x16 o[4]; float l; float rli[16];
  volatile unsigned* badf = (volatile unsigned*)(lds + LDS_TB + 1024);
  if (tid == 0) *badf = 0u;
  flash_pass<128, 256, false, true>(qr, Kh, Vh, S, lds, o, l, qlo, 0.f, 0.f);
  if (!(l > 1e-30f && l < 1e30f)) *badf = 1u;
  __syncthreads(); const unsigned redo = (PROBE == 20) ? 1u : *badf; __syncthreads();
  if (redo != 0u) flash_pass<128, 256, false, false>(qr, Kh, Vh, S, lds, o, l, qlo, 0.f, 0.f);
  row_rcp(l, ws, r32, hi, rli);
  __syncthreads();
  out_rows<false>(o, rli, lds, nullptr, 1.f, ZB, OUT, (size_t)(rowbase + qlo) * 1024 + h * 128);
  __syncthreads();
}
#undef SBAR
}
#define LAS __attribute__((address_space(3)))
typedef unsigned short bf16;
typedef unsigned v4u __attribute__((ext_vector_type(4)));
typedef float f32x4 __attribute__((ext_vector_type(4)));
typedef float f32x2 __attribute__((ext_vector_type(2)));
constexpr size_t MiB = 1u << 20;
constexpr size_t WS_WIN = 2 * MiB, WS_WPA = 20 * MiB, WS_WPB = 22 * MiB, WS_WOUT = 24 * MiB, WS_TAB = 26 * MiB;
constexpr size_t WS_XN = 32 * MiB;
constexpr size_t WS_BIG = 192 * MiB;
constexpr size_t WS_KB = 960 * MiB, WS_VB = 984 * MiB;
constexpr size_t WS_SCR = 1008 * MiB;
constexpr size_t WS_END = 1040 * MiB;
constexpr size_t TAB_BIAS = 0, TAB_ROPE = 8192, TAB_LAM = 8192 + 32768;
constexpr int LDS_BYTES = 147456;
constexpr int NWAVES = 8;

__device__ __forceinline__ unsigned f2bf(float f) { unsigned u = __builtin_bit_cast(unsigned, f); return (u + 0x7fffu + ((u >> 16) & 1u)) >> 16; }
__device__ __forceinline__ unsigned pk2(float lo, float hi) { return f2bf(lo) | (f2bf(hi) << 16); }
__device__ __forceinline__ float wave_sum(float v) {
#pragma unroll
    for (int o = 1; o < 64; o <<= 1) v += __shfl_xor(v, o);
    return v;
}
#define LDS_WAIT() asm volatile("s_waitcnt lgkmcnt(0)" ::: "memory")
__device__ __forceinline__ void p0_transpose_item(const float* W, int K, int N, bf16* WT, LAS float* scr, int item, int lane) {
    const int nblk = N / 32, kb = item / nblk, nb = item % nblk, k0 = 64 * kb, n0 = 32 * nb;
#pragma unroll 8
    for (int i = 0; i < 32; ++i) { const int kk = 2 * i + (lane >> 5); scr[kk * 33 + (lane & 31)] = W[(size_t)(k0 + kk) * N + n0 + (lane & 31)]; }
    LDS_WAIT(); asm volatile("" ::: "memory");
    const int c = lane & 7;
#pragma unroll
    for (int j = 0; j < 4; ++j) { const int n = (lane >> 3) + 8 * j; const LAS float* s = scr + (8 * c) * 33 + n;
        v4u o; o.x = pk2(s[0 * 33], s[1 * 33]); o.y = pk2(s[2 * 33], s[3 * 33]); o.z = pk2(s[4 * 33], s[5 * 33]); o.w = pk2(s[6 * 33], s[7 * 33]);
        *(v4u*)(WT + (size_t)(n0 + n) * K + k0 + 8 * c) = o; }
    LDS_WAIT(); asm volatile("" ::: "memory");
}

typedef __attribute__((address_space(1))) unsigned gu32;
#define XB_TMO      128
#define XB_XCNT(j)  (256  + 64 * (j))
#define XB_XSUB(j)  (1280 + 64 * (j))
#define XB_XGEN(j)  (2304 + 64 * (j))
#define XB_TOP      3328
#define XB_TOPGEN   3392
#define XCD_BAR_WORDS 3456
#define XB_SPIN_CAP (1u << 18)

__device__ __forceinline__ unsigned xb_ld(unsigned* p)              { return __hip_atomic_load(p, __ATOMIC_RELAXED, __HIP_MEMORY_SCOPE_AGENT); }
__device__ __forceinline__ unsigned xb_add(unsigned* p, unsigned v) { return __hip_atomic_fetch_add(p, v, __ATOMIC_RELAXED, __HIP_MEMORY_SCOPE_AGENT); }
__device__ __forceinline__ unsigned xb_xcc_id() { return (unsigned)__builtin_amdgcn_s_getreg((3 << 11) | 20) & 0xFu; }
#define XB_SPIN(cond, bar) do { unsigned _sp = 0; while (cond) { __builtin_amdgcn_s_sleep(1); \
    if ((++_sp & 255u) == 0u) { if (xb_ld(&(bar)[XB_TMO])) break; if (_sp > XB_SPIN_CAP) { atomicAdd(&(bar)[XB_TMO], 1u); break; } } } } while (0)

struct XcdBarrier {
    unsigned* bar; unsigned x;
    volatile LAS unsigned* st;
};

__device__ __forceinline__ XcdBarrier xcd_barrier_post(unsigned* bar, volatile LAS unsigned* st) {
    XcdBarrier b; b.bar = bar; b.x = xb_xcc_id(); b.st = st;
    if (threadIdx.x == 0) (void)xb_add(&bar[XB_XCNT(b.x)], 1u);
    return b;
}
__device__ __forceinline__ void xcd_barrier_complete(unsigned* bar, unsigned x, unsigned& nloc, unsigned& nx) {
    const unsigned G = gridDim.x * gridDim.y * gridDim.z;
    unsigned sum, cnt, mine, sp = 0u;
    for (;;) {
        sum = 0u; cnt = 0u; mine = 0u;
#pragma unroll
        for (unsigned j = 0; j < 16; ++j) { const unsigned c = xb_ld(&bar[XB_XCNT(j)]); sum += c; cnt += (c > 0u) ? 1u : 0u; mine = (j == x) ? c : mine; }
        if (sum == G) break;
        __builtin_amdgcn_s_sleep(1);
        if ((++sp & 255u) == 0u) { if (xb_ld(&bar[XB_TMO])) break; if (sp > XB_SPIN_CAP) { atomicAdd(&bar[XB_TMO], 1u); break; } }
    }
    nloc = mine > 0u ? mine : 1u; nx = cnt > 0u ? cnt : 1u;
}

__device__ __forceinline__ void xcd_barrier(const XcdBarrier& b) {
    asm volatile("s_waitcnt vmcnt(0)" ::: "memory");
    __syncthreads();
    if (threadIdx.x == 0) {
        unsigned* bar = b.bar;
        __builtin_amdgcn_s_waitcnt(0);
        unsigned nloc = b.st[0], nx = b.st[1];
        if (nloc == 0u) { xcd_barrier_complete(bar, b.x, nloc, nx); b.st[0] = nloc; b.st[1] = nx; }
        const unsigned old = xb_add(&bar[XB_XSUB(b.x)], 1u);
        const unsigned gen = old / nloc;
        if (old + 1u == (gen + 1u) * nloc) {
            __builtin_amdgcn_fence(__ATOMIC_RELEASE, "agent");
            asm volatile("s_waitcnt vmcnt(0)" ::: "memory");
            const unsigned og = xb_add(&bar[XB_TOP], 1u);
            const unsigned tg = og / nx;
            if (og + 1u == (tg + 1u) * nx) xb_add(&bar[XB_TOPGEN], 1u);
            else XB_SPIN(xb_ld(&bar[XB_TOPGEN]) == tg, bar);
            __builtin_amdgcn_fence(__ATOMIC_ACQUIRE, "agent");
            xb_add(&bar[XB_XGEN(b.x)], 1u);
            asm volatile("s_waitcnt vmcnt(0)" ::: "memory");
        } else {
            XB_SPIN(xb_ld(&bar[XB_XGEN(b.x)]) == gen, bar);
            __builtin_amdgcn_fence(__ATOMIC_ACQUIRE, "agent");
            asm volatile("s_waitcnt vmcnt(0)" ::: "memory");
        }
    }
    __syncthreads();
}

struct Args { const float* in[16]; float* out; unsigned char* ws; };

__global__ void __launch_bounds__(NWAVES * 64, 2) fwd_mega(Args a) {
    extern __shared__ __attribute__((aligned(16))) unsigned char lds[];
    cg::grid_group grid = cg::this_grid();
    const int tid = threadIdx.x, lane = tid & 63, wave = __builtin_amdgcn_readfirstlane(tid >> 6);
    const int G = gridDim.x, bx = blockIdx.x;
    const int vcu = (G % 8 == 0) ? (bx % 8) * (G / 8) + bx / 8 : bx;
    unsigned char* ws = a.ws;
    volatile LAS unsigned* bar_st = (volatile LAS unsigned*)((LAS unsigned char*)lds + (LDS_BYTES - 64));
    if (tid < 2) bar_st[tid] = 0u;
    __syncthreads();
    const XcdBarrier xbar = xcd_barrier_post((unsigned*)ws, bar_st);
#define GRID_BAR() xcd_barrier(xbar)
    const float* xp = a.in[0]; const float* xs = a.in[1]; const float* g_norm = a.in[2]; const float* w_in = a.in[3];
    const float* lq1 = a.in[4]; const float* lk1 = a.in[5]; const float* lq2 = a.in[6]; const float* lk2 = a.in[7];
    const float* subln = a.in[8]; const float* qnb = a.in[9]; const float* knb = a.in[10];
    const float* w_pa = a.in[11]; const float* w_pb = a.in[12]; const float* w_out = a.in[13]; const float* rel_bias = a.in[14]; const float* g_final = a.in[15];
    bf16* WinT = (bf16*)(ws + WS_WIN); bf16* WpaT = (bf16*)(ws + WS_WPA); bf16* WpbT = (bf16*)(ws + WS_WPB); bf16* WoutT = (bf16*)(ws + WS_WOUT);
    float* tabA = (float*)(ws + WS_TAB + TAB_BIAS); f32x2* rt = (f32x2*)(ws + WS_TAB + TAB_ROPE); float* lamp = (float*)(ws + WS_TAB + TAB_LAM);
    bf16* XN = (bf16*)(ws + WS_XN);
    bf16* BIG = (bf16*)(ws + WS_BIG);
    bf16 *QA = BIG, *KA = BIG + pg8::BUFE, *VA = BIG + 2 * pg8::BUFE, *ZA = BIG + 3 * pg8::BUFE, *QB = BIG + 4 * pg8::BUFE, *ZB = BIG + 5 * pg8::BUFE, *GA = BIG + 6 * pg8::BUFE, *GB = BIG + 7 * pg8::BUFE;
    bf16* KB = (bf16*)(ws + WS_KB); bf16* VB = (bf16*)(ws + WS_VB);
    float* scr = (float*)(ws + WS_SCR) + (size_t)bx * 32768;
    const int gw = vcu * NWAVES + wave, NGW = G * NWAVES;

    for (int rep_ = 0; rep_ < (PROBE == 4 ? 2 : 1); ++rep_) {
        LAS float* tscr = (LAS float*)((LAS unsigned char*)lds + wave * 16384);
        constexpr int I_IN = (1024 / 64) * (NIN / 32), I_SQ = (1024 / 64) * (1024 / 32);
        for (int it = gw; it < I_IN + 3 * I_SQ; it += NGW) {
            int r = it;
            if (r < I_IN) { p0_transpose_item(w_in, 1024, NIN, WinT, tscr, r, lane); continue; } r -= I_IN;
            if (r < I_SQ) { p0_transpose_item(w_pa, 1024, 1024, WpaT, tscr, r, lane); continue; } r -= I_SQ;
            if (r < I_SQ) { p0_transpose_item(w_pb, 1024, 1024, WpbT, tscr, r, lane); continue; } r -= I_SQ;
            p0_transpose_item(w_out, 1024, 1024, WoutT, tscr, r, lane);
        }
        f32x4 gv[4];
#pragma unroll
        for (int j = 0; j < 4; ++j) gv[j] = ((const f32x4*)g_norm)[lane + 64 * j];
        for (int m0 = gw; m0 < NTOK; m0 += 4 * NGW) {
            f32x4 v[4][4]; float ssq[4];
#pragma unroll
            for (int q = 0; q < 4; ++q) { const int m = m0 + q * NGW; ssq[q] = 0.f; if (m >= NTOK) continue;
                const f32x4* xr = (const f32x4*)(m < NPTOK ? xp + (size_t)m * 1024 : xs + (size_t)(m - NPTOK) * 1024) + lane;
#pragma unroll
                for (int j = 0; j < 4; ++j) { v[q][j] = xr[64 * j]; ssq[q] += (v[q][j].x * v[q][j].x + v[q][j].y * v[q][j].y) + (v[q][j].z * v[q][j].z + v[q][j].w * v[q][j].w); } }
#pragma unroll
            for (int q = 0; q < 4; ++q) { const int m = m0 + q * NGW; if (m >= NTOK) continue;
                const float rstd = 1.0f / sqrtf(wave_sum(ssq[q]) * (1.f / 1024.f) + EPS);
                unsigned long long* o8 = (unsigned long long*)(XN + (size_t)m * 1024) + lane;
#pragma unroll
                for (int j = 0; j < 4; ++j) { const f32x4 w = v[q][j] * rstd * gv[j];
                    o8[64 * j] = (unsigned long long)pk2(w.x, w.y) | ((unsigned long long)pk2(w.z, w.w) << 32); } }
        }
        if (bx == G - 1) {
            for (int i = tid; i < 8 * 256; i += NWAVES * 64) { const int h = i >> 8, rel = (i & 255) - 128, n = rel < 0 ? -rel : rel;
                const int lg = n < 8 ? n : (n < 12 ? 8 : n < 16 ? 9 : n < 23 ? 10 : n < 32 ? 11 : n < 46 ? 12 : n < 64 ? 13 : n < 91 ? 14 : 15);
                tabA[i] = rel_bias[((rel > 0 ? 16 : 0) + lg) * 8 + h] * 1.4426950408889634f; }
            for (int i = tid; i < 128 * 32; i += NWAVES * 64) { const int idx = i >> 5, fi = i & 31;
                const float inv = __builtin_amdgcn_exp2f(-(float)fi * (13.287712379549449f / 32.0f));
                float rev = (float)idx * inv * 0.15915494309189535f; rev -= rintf(rev);
                rt[i] = (f32x2){__builtin_amdgcn_cosf(rev), __builtin_amdgcn_sinf(rev)}; }
            if (tid == 0) { float s1 = 0.f, s2 = 0.f; for (int i = 0; i < 64; ++i) { s1 += lq1[i] * lk1[i]; s2 += lq2[i] * lk2[i]; }
                lamp[0] = __expf(s1) - __expf(s2) + 0.2f; }
        }
    }
    grid.sync();
#if PROBE == 5
    for (int q_ = 0; q_ < 11; ++q_) GRID_BAR();
#endif
    const float lam = lamp[0];

    for (int g = 0; g < NGRP; ++g) {
        const int GM = g == 0 ? GMAX : G1ROWS, gbase = g == 0 ? 0 : G1BASE;
        bf16* MERGED = XN + (size_t)gbase * 1024;
        {
            pg8::Gemm gm{XN + (size_t)gbase * 1024, WinT, GM, NIN, 1024, nullptr, nullptr}; pg8::StaticOrder S; S.init(GM, NIN, G, bx);
            pg8::EpiProj E{BIG, KB, VB};
            pg8::gemm_phase<pg8::EpiProj, pg8::StaticOrder, true, true>((LAS unsigned char*)lds, gm, S, E);
#if PROBE == 3
            pg8::gemm_phase<pg8::EpiProj, pg8::StaticOrder, true, true>((LAS unsigned char*)lds, gm, S, E);
#endif
        }
        GRID_BAR();
        { int lane_k = threadIdx.x & 63; asm volatile("" : "+v"(lane_k));
          const int c = lane_k & 15, sub = lane_k >> 4;
          const f32x4 kg0 = *(const f32x4*)(knb + c * 8), kg1 = *(const f32x4*)(knb + c * 8 + 4);
          for (int u0 = gw * 4; u0 < GM * 2; u0 += NGW * 4) {
            const int u = u0 + sub, lr = u >> 1, kvh = u & 1;
            bf16* kp = KB + (size_t)lr * 256 + kvh * 128 + c * 8;
            const v4u raw = *(const v4u*)kp;
            float f[8];
            f[0] = __uint_as_float(raw.x << 16); f[1] = __uint_as_float(raw.x & 0xffff0000u); f[2] = __uint_as_float(raw.y << 16); f[3] = __uint_as_float(raw.y & 0xffff0000u);
            f[4] = __uint_as_float(raw.z << 16); f[5] = __uint_as_float(raw.z & 0xffff0000u); f[6] = __uint_as_float(raw.w << 16); f[7] = __uint_as_float(raw.w & 0xffff0000u);
            float ssq = 0.f;
#pragma unroll
            for (int j = 0; j < 8; ++j) ssq += f[j] * f[j];
            ssq += __shfl_xor(ssq, 1); ssq += __shfl_xor(ssq, 2); ssq += __shfl_xor(ssq, 4); ssq += __shfl_xor(ssq, 8);
            const float rstd = 1.0f / sqrtf(ssq * (1.f / 128.f) + EPS);
#pragma unroll
            for (int j = 0; j < 4; ++j) { f[j] *= rstd * kg0[j]; f[4 + j] *= rstd * kg1[j]; }
            const int t = (g == 0 || lr < G1SAMPLE) ? (lr & 4095) : ((lr - G1SAMPLE) & 8191);
            const int idx = c < 8 ? (t >> 6) : (t & 63);
            const f32x4* rp = (const f32x4*)(rt + idx * 32 + (c & 3) * 8);
            const bool second = (c & 4) != 0;
            float o8[8];
#pragma unroll
            for (int j2 = 0; j2 < 4; ++j2) { const f32x4 cs = rp[j2];
              const float pa = __shfl_xor(f[2 * j2], 4), pb = __shfl_xor(f[2 * j2 + 1], 4);
              o8[2 * j2]     = second ? (pa * cs[1] + f[2 * j2] * cs[0])     : (f[2 * j2] * cs[0] - pa * cs[1]);
              o8[2 * j2 + 1] = second ? (pb * cs[3] + f[2 * j2 + 1] * cs[2]) : (f[2 * j2 + 1] * cs[2] - pb * cs[3]); }
            v4u w; w.x = pk2(o8[0], o8[1]); w.y = pk2(o8[2], o8[3]); w.z = pk2(o8[4], o8[5]); w.w = pk2(o8[6], o8[7]);
            *(v4u*)kp = w;
          }
        }
        GRID_BAR();
        {
            char* al = (char*)lds;
            const int nS = g == 0 ? 0 : 512, nP = g == 0 ? 1536 : 512;
            for (int i = vcu; i < nS; i += G) att::item_a(QA, QA, KA, VA, ZA, tabA, subln, lam, scr, G1SAMPLE + (i >> 8) * 8192, (i & 31) * 256, (i >> 5) & 7, 8192, al);
            for (int i = vcu; i < nP; i += G) att::item_a(QA, QA, KA, VA, ZA, tabA, subln, lam, scr, (i >> 7) * 4096, (i & 15) * 256, (i >> 4) & 7, 4096, al);
            for (int i = vcu; i < nS; i += G) att::item_b(QB, QB, KB, VB, ZB, qnb, (const att::f32x2*)rt, G1SAMPLE + (i >> 8) * 8192, (i & 31) * 256, (i >> 5) & 7, 8192, al);
            for (int i = vcu; i < nP; i += G) att::item_b(QB, QB, KB, VB, ZB, qnb, (const att::f32x2*)rt, (i >> 7) * 4096, (i & 15) * 256, (i >> 4) & 7, 4096, al);
        }
        GRID_BAR();
        for (int rep_ = 0; rep_ < (PROBE == 6 ? 2 : 1); ++rep_) {
            pg8::PairOrder S; S.init(GM, 1024, G, bx);
            pg8::Gemm gm{QA, WpaT, GM, 1024, 1024, QB, WpbT}; pg8::EpiPair E{GA, GB, MERGED};
            pg8::gemm_phase<pg8::EpiPair, pg8::PairOrder, true, true>((LAS unsigned char*)lds, gm, S, E);
        }
        GRID_BAR();
        for (int rep_ = 0; rep_ < (PROBE == 6 ? 2 : 1); ++rep_) {
            pg8::StaticOrder S; S.init(GM, 1024, G, bx);
            pg8::Gemm gm{MERGED, WoutT, GM, 1024, 1024, nullptr, nullptr}; pg8::EpiOut E{a.out, gbase};
            pg8::gemm_phase<pg8::EpiOut, pg8::StaticOrder, true, true>((LAS unsigned char*)lds, gm, S, E);
        }
        if (g == NGRP - 1) GRID_BAR();
    }
    {
        int lane5 = threadIdx.x & 63; asm volatile("" : "+v"(lane5)); const int lane = lane5;
        f32x4 gv[4];
#pragma unroll
        for (int j = 0; j < 4; ++j) gv[j] = ((const f32x4*)g_final)[lane + 64 * j];
        for (int m0 = gw; m0 < NTOK; m0 += 2 * NGW) {
            f32x4 v[2][4]; float ssq[2];
#pragma unroll
            for (int q = 0; q < 2; ++q) { const int m = m0 + q * NGW; ssq[q] = 0.f; if (m >= NTOK) continue;
                const f32x4* xr = (const f32x4*)(m < NPTOK ? xp + (size_t)m * 1024 : xs + (size_t)(m - NPTOK) * 1024) + lane;
                const unsigned long long* dr = (const unsigned long long*)(a.out + (size_t)m * 1024) + lane;
#pragma unroll
                for (int j = 0; j < 4; ++j) { const unsigned long long d = dr[64 * j]; const unsigned dlo = (unsigned)d, dhi = (unsigned)(d >> 32);
                    f32x4 h = xr[64 * j];
                    h.x += __uint_as_float(dlo << 16); h.y += __uint_as_float(dlo & 0xffff0000u); h.z += __uint_as_float(dhi << 16); h.w += __uint_as_float(dhi & 0xffff0000u);
                    v[q][j] = h; ssq[q] += (h.x * h.x + h.y * h.y) + (h.z * h.z + h.w * h.w); } }
#pragma unroll
            for (int q = 0; q < 2; ++q) { const int m = m0 + q * NGW; if (m >= NTOK) continue;
                const float rstd = 1.0f / sqrtf(wave_sum(ssq[q]) * (1.f / 1024.f) + EPS);
                f32x4* yr = (f32x4*)(a.out + (size_t)m * 1024) + lane;
#pragma unroll
                for (int j = 0; j < 4; ++j) yr[64 * j] = v[q][j] * rstd * gv[j]; }
        }
    }
}

extern "C" void kernel_launch(void* const* d_in, const int* in_sizes, int n_in, void* d_out, int out_size, void* d_ws, size_t ws_size, hipStream_t stream) {
    static int grid = 0;
    if (grid == 0) {
        if (n_in != 16 || out_size != NTOK * 1024 || ws_size < WS_END) { fprintf(stderr, "kernel_launch: unexpected shapes: n_in %d out %d ws %zu (need %zu)\n", n_in, out_size, ws_size, (size_t)WS_END); grid = -1; return; }
        int dev = 0, cus = 0, per_cu = 0;
        if (hipGetDevice(&dev) != hipSuccess || hipDeviceGetAttribute(&cus, hipDeviceAttributeMultiprocessorCount, dev) != hipSuccess) { grid = -1; return; }
        if (hipFuncSetAttribute((const void*)fwd_mega, hipFuncAttributeMaxDynamicSharedMemorySize, LDS_BYTES) != hipSuccess) { fprintf(stderr, "kernel_launch: hipFuncSetAttribute failed\n"); grid = -1; return; }
        if (hipOccupancyMaxActiveBlocksPerMultiprocessor(&per_cu, (const void*)fwd_mega, NWAVES * 64, LDS_BYTES) != hipSuccess || per_cu < 1) { fprintf(stderr, "kernel_launch: occupancy query gave %d\n", per_cu); per_cu = 1; }
        (void)hipGetLastError();
        grid = cus * (per_cu > 1 ? 1 : per_cu);
    }
    if (grid < 0) return;
    Args a{};
    for (int i = 0; i < 16; ++i) a.in[i] = (const float*)d_in[i];
    a.out = (float*)d_out; a.ws = (unsigned char*)d_ws;
    if (hipMemsetAsync(d_ws, 0, 16384, stream) != hipSuccess) { fprintf(stderr, "kernel_launch: memset failed\n"); return; }
    void* args[] = {&a};
    hipError_t e = hipLaunchCooperativeKernel((const void*)fwd_mega, dim3(grid), dim3(NWAVES * 64), args, LDS_BYTES, stream);
    if (e != hipSuccess) fprintf(stderr, "kernel_launch: cooperative launch failed: %s (grid %d)\n", hipGetErrorString(e), grid);
}
```

```cpp
#include <hip/hip_runtime.h>
#include <hip/hip_cooperative_groups.h>
#include <cstdio>
#include <cstdint>
namespace cg = cooperative_groups;

constexpr int DM = 1024;
constexpr int NTOK = 81920, NPTOK = 65536;
constexpr int GMAX = 49152, G1BASE = 49152, G1ROWS = 32768, G1SAMPLE = 16384;
constexpr int NGRP = 2;
constexpr int NIN = 8704;
constexpr float EPS = 1e-6f;
#ifndef PROBE
#define PROBE 0
#endif
namespace pg8 {
#define PG8_LAS __attribute__((address_space(3)))
typedef unsigned short bf16_t;
typedef short bf16x8 __attribute__((ext_vector_type(8)));
typedef float f32x4 __attribute__((ext_vector_type(4)));
typedef unsigned u32x4 __attribute__((ext_vector_type(4)));
constexpr int BM = 256, BK = 64, HALF = 128, HTB = HALF * BK * 2  , STAGE_BYTES = 8 * HTB, NXCD = 8, WGM = 8;

__host__ __device__ __forceinline__ int lds_byte(int r, int c) { const int st = (r >> 4) * 2 + (c >> 5), rr = r & 15, cc = c & 31, ob = rr * 64 + cc * 2; return st * 1024 + (ob ^ (((ob >> 9) & 1) << 5)); }
__host__ __device__ __forceinline__ void stage_rc(int b, int& R, int& C) { const int st = b / 1024, sb = b % 1024, swz = sb ^ (((sb >> 9) & 1) << 5); R = (st >> 1) * 16 + swz / 64; C = (st & 1) * 32 + (swz % 64) / 2; }
__host__ __device__ __forceinline__ int perm32(int rho) { const int n = rho >> 4, i = rho & 15; return 8 * (i >> 2) + 4 * n + (i & 3); }

struct Unit { int pm, pn, sec; };
struct Gemm { const bf16_t* A; const bf16_t* Bt; int M, N, K; const bf16_t* A2; const bf16_t* Bt2; };

struct StaticOrder {
    int nM, nN, nwg, G, c;
    __host__ __device__ void init(int M, int N, int G_, int c_) { nM = M / BM; nN = N / BM; nwg = nM * nN; G = G_; c = c_; }
    __host__ __device__ bool next(int i, Unit& u) const {
        const long L = (long)i * G + c; if (L >= nwg) return false;
        int wgid = (int)L; { const int q = nwg / NXCD, r = nwg % NXCD, xcd = wgid % NXCD, off = wgid / NXCD; wgid = (xcd < r ? xcd * (q + 1) : r * (q + 1) + (xcd - r) * q) + off; }
        const int nig = WGM * nN, gid = wgid / nig, fm = gid * WGM, gsz = (nM - fm) < WGM ? (nM - fm) : WGM;
        u.pm = fm + ((wgid % nig) % gsz); u.pn = (wgid % nig) / gsz; u.sec = 0; return true;
    }
    __device__ __forceinline__ void a_ready(const Unit&) const {}
    __device__ __forceinline__ void done(const Unit&) const {}
};
struct PairOrder {
    StaticOrder S;
    __host__ __device__ void init(int M, int N, int G_, int c_) { S.init(M, N, G_, c_); }
    __host__ __device__ bool next(int i, Unit& u) const { if (!S.next(i >> 1, u)) return false; u.sec = i & 1; return true; }
    __device__ __forceinline__ void a_ready(const Unit&) const {}
    __device__ __forceinline__ void done(const Unit&) const {}
};
__device__ __forceinline__ unsigned cvt_pk_bf16(float lo, float hi) { unsigned r; asm volatile("v_cvt_pk_bf16_f32 %0, %1, %2" : "=v"(r) : "v"(lo), "v"(hi)); return r; }
typedef float f32x2 __attribute__((ext_vector_type(2)));
typedef unsigned u32x4e __attribute__((ext_vector_type(4)));
constexpr size_t BUFE = (size_t)49152 * 1024;
__device__ __forceinline__ float bf2f(unsigned short v) { return __uint_as_float(((unsigned)v) << 16); }
__device__ __forceinline__ float sigm(float x) { return __builtin_amdgcn_rcpf(1.0f + __builtin_amdgcn_exp2f(-1.4426950408889634f * x)); }

struct EpiProj { static constexpr bool PERM = true, AFTER_DRAIN = false;
    bf16_t* big; bf16_t* kb; bf16_t* vb;
    __device__ __forceinline__ void operator()(const f32x4 (&acc)[2][2][4][2], const Unit& u, int wr, int wc, int fr, int fq) const {
        const int pn = u.pn; bf16_t* base; int ldc, colt;
        if (pn < 20) { base = big + (size_t)(pn >> 2) * BUFE; ldc = 1024; colt = (pn & 3) * 256; }
        else if (pn == 20) { base = kb; ldc = 256; colt = 0; }
        else if (pn == 21) { base = vb; ldc = 256; colt = 0; }
        else { const int q = pn - 22; base = big + (size_t)(5 + (q >> 2)) * BUFE; ldc = 1024; colt = (q & 3) * 256; }
        const int row0 = u.pm * BM + wr * 64 + fr, col0 = colt + wc * 32 + 8 * fq;
        const float sc = pn < 4 ? 0.125f * 1.4426950408889634f : 1.0f;
#pragma unroll
        for (int ai = 0; ai < 2; ++ai)
#pragma unroll
            for (int m = 0; m < 4; ++m) { bf16_t* rowp = base + (size_t)(row0 + ai * HALF + m * 16) * ldc + col0;
#pragma unroll
                for (int bj = 0; bj < 2; ++bj) { const f32x4 v0 = acc[ai][bj][m][0] * sc, v1 = acc[ai][bj][m][1] * sc;
                    u32x4 w; w.x = cvt_pk_bf16(v0[0], v0[1]); w.y = cvt_pk_bf16(v0[2], v0[3]); w.z = cvt_pk_bf16(v1[0], v1[1]); w.w = cvt_pk_bf16(v1[2], v1[3]);
                    *(u32x4*)(rowp + bj * HALF) = w; } }
    }
};
__device__ __forceinline__ float en2(unsigned hbits) { return __builtin_amdgcn_exp2f(-1.4426950408889634f * __uint_as_float(hbits)); }
struct EpiPair { static constexpr bool PERM = true, AFTER_DRAIN = false;
    const bf16_t* ga; const bf16_t* gb; bf16_t* merged;
    __device__ __forceinline__ void operator()(f32x4 (&acc)[2][2][4][2], const Unit& u, int wr, int wc, int fr, int fq) const {
        const int row0 = u.pm * BM + wr * 64 + fr, col0 = u.pn * BM + wc * 32 + 8 * fq;
        if (u.sec == 0) {
#pragma unroll
            for (int ai = 0; ai < 2; ++ai)
#pragma unroll
                for (int m = 0; m < 4; ++m) { const size_t off = (size_t)(row0 + ai * HALF + m * 16) * 1024 + col0;
#pragma unroll
                    for (int bj = 0; bj < 2; ++bj) { const u32x4 av = *(const u32x4*)(ga + off + bj * HALF), bv = *(const u32x4*)(gb + off + bj * HALF);
                        const unsigned aw[4] = {av.x, av.y, av.z, av.w}, bw[4] = {bv.x, bv.y, bv.z, bv.w};
#pragma unroll
                        for (int q = 0; q < 4; ++q) { const int n = q >> 1, e = (q & 1) * 2;
                            const float r0 = (1.0f + en2(bw[q] << 16)) * __builtin_amdgcn_rcpf(1.0f + en2(aw[q] << 16));
                            const float r1 = (1.0f + en2(bw[q] & 0xffff0000u)) * __builtin_amdgcn_rcpf(1.0f + en2(aw[q] & 0xffff0000u));
                            acc[ai][bj][m][n][e] *= r0; acc[ai][bj][m][n][e + 1] *= r1; } } }
        } else {
#pragma unroll
            for (int ai = 0; ai < 2; ++ai)
#pragma unroll
                for (int m = 0; m < 4; ++m) { const size_t off = (size_t)(row0 + ai * HALF + m * 16) * 1024 + col0;
#pragma unroll
                    for (int bj = 0; bj < 2; ++bj) { const u32x4 gv = *(const u32x4*)(gb + off + bj * HALF);
                        const f32x4 v0 = acc[ai][bj][m][0], v1 = acc[ai][bj][m][1];
                        u32x4 w; w.x = cvt_pk_bf16(v0[0] * sigm(__uint_as_float(gv.x << 16)), v0[1] * sigm(__uint_as_float(gv.x & 0xffff0000u)));
                        w.y = cvt_pk_bf16(v0[2] * sigm(__uint_as_float(gv.y << 16)), v0[3] * sigm(__uint_as_float(gv.y & 0xffff0000u)));
                        w.z = cvt_pk_bf16(v1[0] * sigm(__uint_as_float(gv.z << 16)), v1[1] * sigm(__uint_as_float(gv.z & 0xffff0000u)));
                        w.w = cvt_pk_bf16(v1[2] * sigm(__uint_as_float(gv.w << 16)), v1[3] * sigm(__uint_as_float(gv.w & 0xffff0000u)));
                        *(u32x4*)(merged + off + bj * HALF) = w; } }
        }
    }
};
struct EpiOut { static constexpr bool PERM = true, AFTER_DRAIN = false;
    float* out; int base;
    __device__ __forceinline__ void operator()(const f32x4 (&acc)[2][2][4][2], const Unit& u, int wr, int wc, int fr, int fq) const {
        bf16_t* ob = (bf16_t*)(out + ((size_t)base + (size_t)u.pm * BM) * 1024);
        const int row0 = wr * 64 + fr, col0 = u.pn * BM + wc * 32 + 8 * fq;
#pragma unroll
        for (int ai = 0; ai < 2; ++ai)
#pragma unroll
            for (int m = 0; m < 4; ++m) { bf16_t* rowp = ob + (size_t)(row0 + ai * HALF + m * 16) * 2048 + col0;
#pragma unroll
                for (int bj = 0; bj < 2; ++bj) { const f32x4 v0 = acc[ai][bj][m][0], v1 = acc[ai][bj][m][1];
                    u32x4 w; w.x = cvt_pk_bf16(v0[0], v0[1]); w.y = cvt_pk_bf16(v0[2], v0[3]); w.z = cvt_pk_bf16(v1[0], v1[1]); w.w = cvt_pk_bf16(v1[2], v1[3]);
                    *(u32x4*)(rowp + bj * HALF) = w; } }
    }
};
template <class Epi, class Sched, bool ALIGN_EPI = false, bool SP2 = false>
__device__ __forceinline__ void gemm_phase(PG8_LAS unsigned char* lds, const Gemm g, const Sched& S, const Epi& E) {
    int tid_ = threadIdx.x; asm volatile("" : "+v"(tid_));
    const int tid = tid_, wid = __builtin_amdgcn_readfirstlane(tid >> 6), lane = tid & 63, wr = wid >> 2, wc = wid & 3, fr = lane & 15, fq = lane >> 4;
    const int K = g.K, nt = K / BK;
    unsigned voffA[2], voffB[2];
#pragma unroll
    for (int i = 0; i < 2; ++i) { int R, C; stage_rc(tid * 16 + i * 8192, R, C); const int Rb = Epi::PERM ? ((R & ~31) + perm32(R & 31)) : R;
        voffA[i] = (unsigned)(R * K + C) * 2u; voffB[i] = (unsigned)(Rb * K + C) * 2u; }
    const size_t kstep = (size_t)(BK * 2);
    const size_t hstep = (size_t)HALF * K * 2;
    const size_t tstep = 2 * hstep;
    const unsigned ldsw = (unsigned)wid * 1024u;
    const int aoff = lds_byte(wr * 64 + fr, fq * 8), boff = lds_byte(wc * 32 + fr, fq * 8);
#define PG8_SA(b, h) (((b) * 2 + (h)) * HTB)
#define PG8_SB(b, h) ((4 + (b) * 2 + (h)) * HTB)
#define PG8_STAGE(bufoff, gbase, voff) do { _Pragma("unroll") for (int _i = 0; _i < 2; ++_i) \
        __builtin_amdgcn_global_load_lds((const unsigned*)((const char*)(gbase) + (voff)[_i]), (PG8_LAS unsigned*)(lds + (bufoff) + ldsw + _i * 8192), 16, 0, 0); } while (0)
#define PG8_LDA(dst, b, h) do { _Pragma("unroll") for (int m = 0; m < 4; ++m) _Pragma("unroll") for (int k = 0; k < 2; ++k) dst[m][k] = *(const PG8_LAS bf16x8*)(lds + PG8_SA(b, h) + aoff + m * 2048 + k * 1024); } while (0)
#define PG8_LDB(dst, b, h) do { _Pragma("unroll") for (int n = 0; n < 2; ++n) _Pragma("unroll") for (int k = 0; k < 2; ++k) dst[n][k] = *(const PG8_LAS bf16x8*)(lds + PG8_SB(b, h) + boff + n * 2048 + k * 1024); } while (0)
#define PG8_MMA(ai, bj, At, Bt) do { __builtin_amdgcn_s_setprio(1); _Pragma("unroll") for (int m = 0; m < 4; ++m) _Pragma("unroll") for (int n = 0; n < 2; ++n) _Pragma("unroll") for (int k = 0; k < 2; ++k) \
        acc[ai][bj][m][n] = __builtin_amdgcn_mfma_f32_16x16x32_bf16(Bt[n][k], At[m][k], acc[ai][bj][m][n], 0, 0, 0); __builtin_amdgcn_s_setprio(0); } while (0)
#define PG8_WAIT_V(n) asm volatile("s_waitcnt vmcnt(" #n ")" ::: "memory")
#define PG8_WAIT_L(n) asm volatile("s_waitcnt lgkmcnt(" #n ")" ::: "memory")
#define PG8_BAR __builtin_amdgcn_s_barrier()
#define PG8_SCHED __builtin_amdgcn_sched_barrier(0)
    Unit cur, nxt; int ui = 0;
    if (!S.next(0, cur)) return;
    f32x4 acc[2][2][4][2];
#pragma unroll
    for (int a = 0; a < 2; ++a)
#pragma unroll
        for (int b = 0; b < 2; ++b)
#pragma unroll
            for (int m = 0; m < 4; ++m)
#pragma unroll
                for (int n = 0; n < 2; ++n) acc[a][b][m][n] = (f32x4){0.f, 0.f, 0.f, 0.f};
    bf16x8 At[4][2], B0[2][2], B1[2][2];
    const char* cA = (const char*)(cur.sec ? g.A2 : g.A) + (size_t)cur.pm * tstep; const char* cB = (const char*)(cur.sec ? g.Bt2 : g.Bt) + (size_t)cur.pn * tstep;
    S.a_ready(cur);
    if constexpr (SP2) {
        PG8_STAGE(PG8_SB(0, 0), cB, voffB); PG8_STAGE(PG8_SB(0, 1), cB + hstep, voffB); PG8_STAGE(PG8_SA(0, 0), cA, voffA); PG8_STAGE(PG8_SA(0, 1), cA + hstep, voffA);
        if (wr == 1) PG8_BAR;
        PG8_WAIT_V(2); PG8_BAR;
        PG8_STAGE(PG8_SB(1, 0), cB + kstep, voffB); PG8_STAGE(PG8_SA(1, 0), cA + kstep, voffA); PG8_STAGE(PG8_SB(1, 1), cB + hstep + kstep, voffB);
        PG8_WAIT_V(6); PG8_BAR;
    } else {
        PG8_STAGE(PG8_SB(0, 0), cB, voffB); PG8_STAGE(PG8_SA(0, 0), cA, voffA); PG8_STAGE(PG8_SB(0, 1), cB + hstep, voffB); PG8_STAGE(PG8_SA(0, 1), cA + hstep, voffA);
        if (wr == 1) PG8_BAR;
        PG8_WAIT_V(4); PG8_BAR;
        PG8_STAGE(PG8_SB(1, 0), cB + kstep, voffB); PG8_STAGE(PG8_SA(1, 0), cA + kstep, voffA); PG8_STAGE(PG8_SB(1, 1), cB + hstep + kstep, voffB);
        PG8_WAIT_V(6); PG8_BAR;
    }
    for (;;) {
        const bool has_next = S.next(ui + 1, nxt);
        const char* nA = has_next ? (const char*)(nxt.sec ? g.A2 : g.A) + (size_t)nxt.pm * tstep : cA; const char* nB = has_next ? (const char*)(nxt.sec ? g.Bt2 : g.Bt) + (size_t)nxt.pn * tstep : cB;
        for (int t = 0; t < nt; t += 2) {
            const bool last = (t == nt - 2);
            const char* a1 = cA + (size_t)(t + 1) * kstep;
            const char* a2 = last ? nA : cA + (size_t)(t + 2) * kstep; const char* b2 = last ? nB : cB + (size_t)(t + 2) * kstep;
            const char* a3 = a2 + kstep; const char* b3 = b2 + kstep;
            if (last && has_next) S.a_ready(nxt);
            if constexpr (SP2) {
            PG8_LDB(B0, 0, 0); PG8_LDB(B1, 0, 1); PG8_SCHED; PG8_LDA(At, 0, 0); PG8_STAGE(PG8_SA(1, 1), a1 + hstep, voffA);
            PG8_WAIT_V(8); PG8_WAIT_L(0); PG8_BAR; PG8_MMA(0, 0, At, B0); PG8_MMA(0, 1, At, B1); PG8_BAR; PG8_SCHED;
            PG8_LDA(At, 0, 1); PG8_STAGE(PG8_SB(0, 0), b2, voffB); PG8_STAGE(PG8_SB(0, 1), b2 + hstep, voffB); PG8_STAGE(PG8_SA(0, 0), a2, voffA);
            PG8_WAIT_V(8); PG8_WAIT_L(0); PG8_BAR; PG8_MMA(1, 0, At, B0); PG8_MMA(1, 1, At, B1); PG8_BAR; PG8_SCHED;
            PG8_LDB(B0, 1, 0); PG8_LDB(B1, 1, 1); PG8_SCHED; PG8_LDA(At, 1, 0); PG8_STAGE(PG8_SA(0, 1), a2 + hstep, voffA);
            PG8_WAIT_V(8); PG8_WAIT_L(0); PG8_BAR; PG8_MMA(0, 0, At, B0); PG8_MMA(0, 1, At, B1); PG8_BAR; PG8_SCHED;
            PG8_LDA(At, 1, 1); PG8_STAGE(PG8_SB(1, 0), b3, voffB); PG8_STAGE(PG8_SB(1, 1), b3 + hstep, voffB); PG8_STAGE(PG8_SA(1, 0), a3, voffA);
            PG8_WAIT_V(8); PG8_WAIT_L(0); PG8_BAR; PG8_MMA(1, 0, At, B0); PG8_MMA(1, 1, At, B1); PG8_BAR; PG8_SCHED;
            } else {
            PG8_LDB(B0, 0, 0); PG8_SCHED; PG8_LDA(At, 0, 0); PG8_STAGE(PG8_SA(1, 1), a1 + hstep, voffA);
            PG8_WAIT_L(8); PG8_BAR; PG8_WAIT_L(0); PG8_MMA(0, 0, At, B0); PG8_BAR; PG8_SCHED;
            PG8_LDB(B1, 0, 1); PG8_STAGE(PG8_SB(0, 0), b2, voffB);
            PG8_BAR; PG8_WAIT_L(0); PG8_MMA(0, 1, At, B1); PG8_BAR;
            PG8_LDA(At, 0, 1); PG8_STAGE(PG8_SA(0, 0), a2, voffA);
            PG8_BAR; PG8_WAIT_L(0); PG8_MMA(1, 0, At, B0); PG8_BAR; PG8_SCHED;
            PG8_STAGE(PG8_SB(0, 1), b2 + hstep, voffB);
            PG8_WAIT_V(6); PG8_BAR; PG8_MMA(1, 1, At, B1); PG8_BAR;
            PG8_LDB(B0, 1, 0); PG8_SCHED; PG8_LDA(At, 1, 0); PG8_STAGE(PG8_SA(0, 1), a2 + hstep, voffA);
            PG8_WAIT_L(8); PG8_BAR; PG8_WAIT_L(0); PG8_MMA(0, 0, At, B0); PG8_BAR; PG8_SCHED;
            PG8_LDB(B1, 1, 1); PG8_STAGE(PG8_SB(1, 0), b3, voffB);
            PG8_BAR; PG8_WAIT_L(0); PG8_MMA(0, 1, At, B1); PG8_BAR;
            PG8_LDA(At, 1, 1); PG8_STAGE(PG8_SA(1, 0), a3, voffA);
            PG8_BAR; PG8_WAIT_L(0); PG8_MMA(1, 0, At, B0); PG8_BAR; PG8_SCHED;
            PG8_STAGE(PG8_SB(1, 1), b3 + hstep, voffB);
            PG8_WAIT_V(6); PG8_BAR; PG8_MMA(1, 1, At, B1); PG8_BAR;
            }
        }
        if constexpr (ALIGN_EPI) { if (wr == 0) PG8_BAR; }
        if constexpr (!Epi::AFTER_DRAIN) { E(acc, cur, wr, wc, fr, fq); S.done(cur); }
        if (!has_next) break;
        if (!nxt.sec)
#pragma unroll
        for (int a = 0; a < 2; ++a)
#pragma unroll
            for (int b = 0; b < 2; ++b)
#pragma unroll
                for (int m = 0; m < 4; ++m)
#pragma unroll
                    for (int n = 0; n < 2; ++n) acc[a][b][m][n] = (f32x4){0.f, 0.f, 0.f, 0.f};
        cur = nxt; cA = nA; cB = nB; ++ui;
        if constexpr (ALIGN_EPI) { if (wr == 1) PG8_BAR; }
    }
    PG8_WAIT_V(0);
    if constexpr (!ALIGN_EPI) { if (wr == 0) PG8_BAR; }
    PG8_BAR;
    if constexpr (Epi::AFTER_DRAIN) { E.fused(acc, cur, wr, wc, fr, fq, lds, wid, lane); S.done(cur); }
#undef PG8_SA
#undef PG8_SB
#undef PG8_STAGE
#undef PG8_LDA
#undef PG8_LDB
#undef PG8_MMA
#undef PG8_WAIT_V
#undef PG8_WAIT_L
#undef PG8_BAR
#undef PG8_SCHED
}
}
namespace att {
typedef unsigned short bf16_t;
using bf16x8 = __attribute__((ext_vector_type(8))) short;
using s16x4  = __attribute__((ext_vector_type(4))) short;
using f32x16 = __attribute__((ext_vector_type(16))) float;
using f32x4  = __attribute__((ext_vector_type(4))) float;
using f32x2  = __attribute__((ext_vector_type(2))) float;
using u32x4  = __attribute__((ext_vector_type(4))) unsigned;
constexpr int NW = 8, QBLK = 32, KVBLK = 64;
constexpr int SHM_V = 16384, SHM_K = 16384;
constexpr int LDS_WSOFF = 3 * SHM_V + 4 * SHM_K;
constexpr int LDS_TB = LDS_WSOFF + NW * 64 * 4;
constexpr int ATT_LDS = LDS_TB + 2048;
constexpr float THR = 8.f;
#define KSWZ128(row, colB) ((row) * 256 + ((colB) ^ (((row) & 7) << 4)))
#define KSWZ64(row, colB)  ((row) * 128 + ((colB) ^ ((((row) >> 1) & 7) << 4)))
#define SBAR() __builtin_amdgcn_sched_barrier(0)
__device__ __forceinline__ int crow(int r, int hi) { return (r & 3) + 8 * (r >> 2) + 4 * hi; }
__device__ __forceinline__ unsigned cvtpk(float lo, float hi) { unsigned r; asm volatile("v_cvt_pk_bf16_f32 %0, %1, %2" : "=v"(r) : "v"(lo), "v"(hi)); return r; }
__device__ __forceinline__ bf16x8 ld8(const bf16_t* p) { return *reinterpret_cast<const bf16x8*>(p); }
__device__ __forceinline__ float bf2f(short v) { return __uint_as_float(((unsigned)(unsigned short)v) << 16); }

constexpr float THR2 = THR * 1.4426950408889634f;
template <int DK>
__device__ __forceinline__ void partialSM(f32x16& p0, f32x16& p1, float& m_reg, float& mn, float& alpha, const float cb) {
  float pmax = p0[0];
#pragma unroll
  for (int r = 1; r < 16; ++r) pmax = fmaxf(pmax, p0[r]);
#pragma unroll
  for (int r = 0; r < 16; ++r) pmax = fmaxf(pmax, p1[r]);
  { auto rr = __builtin_amdgcn_permlane32_swap(__float_as_uint(pmax), __float_as_uint(pmax), false, false);
    pmax = fmaxf(__uint_as_float(rr[0]), __uint_as_float(rr[1])); }
  pmax += cb;
  if (__builtin_expect(__all(pmax - m_reg <= THR2), 1)) { mn = m_reg; alpha = 1.f; }
  else { mn = fmaxf(m_reg, pmax); alpha = __builtin_amdgcn_exp2f(m_reg - mn); m_reg = mn; }
  const float mnC = cb - mn;
#pragma unroll
  for (int r = 0; r < 16; ++r) p0[r] += mnC;
#pragma unroll
  for (int r = 0; r < 16; ++r) p1[r] += mnC;
#pragma unroll
  for (int r = 0; r < 16; ++r) p0[r] = __builtin_amdgcn_exp2f(p0[r]);
}
template <bool NOEXP>
__device__ __forceinline__ void finishSM(f32x16& p0, f32x16& p1, float alpha, float& l_reg, bf16x8& pa0, bf16x8& pa1, bf16x8& pa2, bf16x8& pa3) {
  if constexpr (!NOEXP) {
#pragma unroll
  for (int r = 0; r < 16; ++r) p1[r] = __builtin_amdgcn_exp2f(p1[r]); }
  float ps = 0;
#pragma unroll
  for (int r = 0; r < 16; ++r) ps += p0[r];
#pragma unroll
  for (int r = 0; r < 16; ++r) ps += p1[r];
  { auto rr = __builtin_amdgcn_permlane32_swap(__float_as_uint(ps), __float_as_uint(ps), false, false);
    ps = __uint_as_float(rr[0]) + __uint_as_float(rr[1]); }
  l_reg = l_reg * alpha + ps;
#define PK4(P, BASE, OUT) do { unsigned a0 = cvtpk(P[BASE + 0], P[BASE + 1]), a1 = cvtpk(P[BASE + 2], P[BASE + 3]);   \
    unsigned b0 = cvtpk(P[BASE + 4], P[BASE + 5]), b1 = cvtpk(P[BASE + 6], P[BASE + 7]);                              \
    auto r0 = __builtin_amdgcn_permlane32_swap(a0, b0, false, false); auto r1 = __builtin_amdgcn_permlane32_swap(a1, b1, false, false); \
    u32x4 w = {r0[0], r1[0], r0[1], r1[1]}; OUT = *reinterpret_cast<bf16x8*>(&w); } while (0)
  PK4(p0, 0, pa0); PK4(p0, 8, pa1); PK4(p1, 0, pa2); PK4(p1, 8, pa3);
#undef PK4
}
__device__ __forceinline__ void add_bias(f32x16& p0, f32x16& p1, const float* tb, int relb, int hi) {
  const float* t = tb + relb + 4 * hi;
#pragma unroll
  for (int r = 0; r < 16; ++r) { p0[r] += t[(r & 3) + 8 * (r >> 2)]; p1[r] += t[32 + (r & 3) + 8 * (r >> 2)]; }
}
template <int DK>
__device__ __forceinline__ void qkt(f32x16& p0, f32x16& p1, const char* Ks, const bf16x8* qr, int r32, int hi) {
  p0 = f32x16{}; p1 = f32x16{};
#pragma unroll
  for (int d0 = 0; d0 < DK / 16; ++d0) { const int cb = (d0 * 16 + hi * 8) * 2;
    bf16x8 b0, b1;
    if constexpr (DK == 128) { b0 = *reinterpret_cast<const bf16x8*>(Ks + KSWZ128(r32, cb)); b1 = *reinterpret_cast<const bf16x8*>(Ks + KSWZ128(32 + r32, cb)); }
    else { b0 = *reinterpret_cast<const bf16x8*>(Ks + KSWZ64(r32, cb)); b1 = *reinterpret_cast<const bf16x8*>(Ks + KSWZ64(32 + r32, cb)); }
    p0 = __builtin_amdgcn_mfma_f32_32x32x16_bf16(b0, qr[d0], p0, 0, 0, 0);
    p1 = __builtin_amdgcn_mfma_f32_32x32x16_bf16(b1, qr[d0], p1, 0, 0, 0); }
}
__device__ __forceinline__ int v_st(int k, int c) { const int kk = (k & ~0xC) | ((k & 4) << 1) | ((k & 8) >> 1); return ((kk >> 3) * 4 + (c >> 5)) * 512 + ((kk & 7) * 32 + (c & 31)) * 2; }
__device__ __forceinline__ int v_rd_base(int lane) { return ((lane & 3) << 3) | (((lane >> 2) & 3) << 6) | (((lane >> 4) & 1) << 5) | (((lane >> 5) & 1) << 8); }
constexpr int v_rd_off(int d0, int ks, int half) { return d0 * 512 + ks * 4096 + half * 2048; }
template <int OFF> __device__ __forceinline__ s16x4 tr_read(int vb) {
  s16x4 r; asm volatile("ds_read_b64_tr_b16 %0, %1 offset:%2" : "=&v"(r) : "v"(vb), "i"(OFF) : "memory"); return r;
}
template <int D0> __device__ __forceinline__ void pv_one(f32x16& od, int vb, bf16x8 pa0, bf16x8 pa1, bf16x8 pa2, bf16x8 pa3) {
  const s16x4 l0 = tr_read<v_rd_off(D0, 0, 0)>(vb), h0 = tr_read<v_rd_off(D0, 0, 1)>(vb), l1 = tr_read<v_rd_off(D0, 1, 0)>(vb), h1 = tr_read<v_rd_off(D0, 1, 1)>(vb);
  const s16x4 l2 = tr_read<v_rd_off(D0, 2, 0)>(vb), h2 = tr_read<v_rd_off(D0, 2, 1)>(vb), l3 = tr_read<v_rd_off(D0, 3, 0)>(vb), h3 = tr_read<v_rd_off(D0, 3, 1)>(vb);
  asm volatile("s_waitcnt lgkmcnt(0)" ::: "memory"); SBAR();
#define PK(L, H) (bf16x8){L[0], L[1], L[2], L[3], H[0], H[1], H[2], H[3]}
  od = __builtin_amdgcn_mfma_f32_32x32x16_bf16(pa0, PK(l0, h0), od, 0, 0, 0);
  od = __builtin_amdgcn_mfma_f32_32x32x16_bf16(pa1, PK(l1, h1), od, 0, 0, 0);
  od = __builtin_amdgcn_mfma_f32_32x32x16_bf16(pa2, PK(l2, h2), od, 0, 0, 0);
  od = __builtin_amdgcn_mfma_f32_32x32x16_bf16(pa3, PK(l3, h3), od, 0, 0, 0);
#undef PK
}
__device__ __forceinline__ void pv_d0(f32x16* o, int vb, bf16x8 pa0, bf16x8 pa1, bf16x8 pa2, bf16x8 pa3) {
  pv_one<0>(o[0], vb, pa0, pa1, pa2, pa3); pv_one<1>(o[1], vb, pa0, pa1, pa2, pa3); pv_one<2>(o[2], vb, pa0, pa1, pa2, pa3); pv_one<3>(o[3], vb, pa0, pa1, pa2, pa3);
}

typedef __attribute__((address_space(3))) const char* lds_cptr;
typedef short v4i16_t __attribute__((ext_vector_type(4)));
__device__ __forceinline__ s16x4 vtr(lds_cptr p) { return __builtin_bit_cast(s16x4, __builtin_amdgcn_ds_read_tr16_b64_v4i16((__attribute__((address_space(3))) v4i16_t*)p)); }
__device__ __forceinline__ float max3f(float a, float b, float c) { return fmaxf(fmaxf(a, b), c); }
#define PIN(x) asm volatile("" : "+v"(x))
#define PK4R(P, BASE, OUT) do { unsigned a0 = cvtpk(P[BASE + 0], P[BASE + 1]), a1 = cvtpk(P[BASE + 2], P[BASE + 3]);   \
    unsigned b0 = cvtpk(P[BASE + 4], P[BASE + 5]), b1 = cvtpk(P[BASE + 6], P[BASE + 7]);                              \
    auto r0 = __builtin_amdgcn_permlane32_swap(a0, b0, false, false); auto r1 = __builtin_amdgcn_permlane32_swap(a1, b1, false, false); \
    u32x4 w = {r0[0], r1[0], r0[1], r1[1]}; OUT = *reinterpret_cast<bf16x8*>(&w); } while (0)
template <int DK, bool NOMAX>
__device__ __forceinline__ void qk_fs(f32x16& c0, f32x16& c1, const char* Ks, const bf16x8* qr, const int r32, const int hi,
                                      f32x16& p0, f32x16& p1, const float alpha, float& l_reg, bf16x8* pa,
                                      bf16x8 (&kf)[2][2], const lds_cptr vp, s16x4 (&vl)[3], s16x4 (&vh)[3]) {
  constexpr int NS = DK / 16, RPS = 16 / NS;
#define KRD_(S, D0) do { const int cb_ = ((D0) * 16 + hi * 8) * 2; \
    if constexpr (DK == 128) { kf[S][0] = *reinterpret_cast<const bf16x8*>(Ks + KSWZ128(r32, cb_)); kf[S][1] = *reinterpret_cast<const bf16x8*>(Ks + KSWZ128(32 + r32, cb_)); } \
    else { kf[S][0] = *reinterpret_cast<const bf16x8*>(Ks + KSWZ64(r32, cb_)); kf[S][1] = *reinterpret_cast<const bf16x8*>(Ks + KSWZ64(32 + r32, cb_)); } } while (0)
  float psa = 0.f, psb = 0.f;
  SBAR();
#pragma unroll
  for (int d0 = 0; d0 < NS; ++d0) {
    if (d0 == 0) { c0 = __builtin_amdgcn_mfma_f32_32x32x16_bf16(kf[0][0], qr[0], f32x16{}, 0, 0, 0); c1 = __builtin_amdgcn_mfma_f32_32x32x16_bf16(kf[0][1], qr[0], f32x16{}, 0, 0, 0); }
    else { c0 = __builtin_amdgcn_mfma_f32_32x32x16_bf16(kf[d0 & 1][0], qr[d0], c0, 0, 0, 0); c1 = __builtin_amdgcn_mfma_f32_32x32x16_bf16(kf[d0 & 1][1], qr[d0], c1, 0, 0, 0); }
    if (d0 + 2 < NS) KRD_(d0 & 1, d0 + 2);
    if constexpr (NOMAX) { }
    else {
#pragma unroll
    for (int r = d0 * RPS; r < (d0 + 1) * RPS; ++r) { p1[r] = __builtin_amdgcn_exp2f(p1[r]); psa += p0[r]; }
    if (d0 > 0) {
#pragma unroll
      for (int r = (d0 - 1) * RPS; r < d0 * RPS; ++r) psb += p1[r]; } }
    if constexpr (NOMAX) {
      if (d0 == NS / 4 - 1) { PK4R(p0, 0, pa[0]); PIN(pa[0]); }
      if (d0 == NS / 2 - 1) { PK4R(p0, 8, pa[1]); PIN(pa[1]); }
      if (d0 == 3 * NS / 4 - 1) { PK4R(p1, 0, pa[2]); PIN(pa[2]); }
      if (d0 == NS - 1) { PK4R(p1, 8, pa[3]); PIN(pa[3]); }
    } else {
    if (d0 == NS / 2 - 1) { PK4R(p0, 0, pa[0]); PIN(pa[0]); }
    if (d0 == NS / 2) { PK4R(p0, 8, pa[1]); PIN(pa[1]); }
    if (d0 == NS - 1) { PK4R(p1, 0, pa[2]); PIN(pa[2]); }
    }
    if (d0 == NS - 1) {
      vl[0] = vtr(vp + v_rd_off(0, 0, 0)); vh[0] = vtr(vp + v_rd_off(0, 0, 1)); vl[1] = vtr(vp + v_rd_off(1, 0, 0)); vh[1] = vtr(vp + v_rd_off(1, 0, 1)); }
    PIN(p1); PIN(psa); PIN(psb);
    SBAR();
  }
#undef KRD_
  if constexpr (!NOMAX) {
#pragma unroll
  for (int r = (NS - 1) * RPS; r < 16; ++r) psb += p1[r];
  float ps = psa + psb;
  { auto rr = __builtin_amdgcn_permlane32_swap(__float_as_uint(ps), __float_as_uint(ps), false, false);
    ps = __uint_as_float(rr[0]) + __uint_as_float(rr[1]); }
  l_reg = l_reg * alpha + ps;
  PK4R(p1, 8, pa[3]); }
}
template <int DK, bool NOMAX>
__device__ __forceinline__ void pv_psm(f32x16* o, const lds_cptr vp, const bf16x8* pa, f32x16& c0, f32x16& c1, float& m_reg, float& alpha, const float cb,
                                       s16x4 (&vl)[3], s16x4 (&vh)[3], bf16x8 (&kf)[2][2], const char* Kn, const int r32, const int hi, float& l_reg,
                                       const bool dk, const bool dv, const bf16_t* gk0, const bf16_t* gk1, const bf16_t* gv0, const bf16_t* gv1,
                                       __attribute__((address_space(3))) unsigned* lk, __attribute__((address_space(3))) unsigned* lv) {
  typedef __attribute__((address_space(3))) unsigned* lds_up; typedef __attribute__((address_space(3))) char* lds_cp;
  float psa = 0.f, psb = 0.f;
#define VRD_(S, I) do { vl[S] = vtr(vp + v_rd_off((I) & 3, (I) >> 2, 0)); vh[S] = vtr(vp + v_rd_off((I) & 3, (I) >> 2, 1)); } while (0)
#define VFR_(S) (bf16x8){vl[S][0], vl[S][1], vl[S][2], vl[S][3], vh[S][0], vh[S][1], vh[S][2], vh[S][3]}
  float ma = 0.f, mb = 0.f, mnC = 0.f;
  SBAR();
#pragma unroll
  for (int i = 0; i < 16; ++i) {
    if (i + 2 < 16) VRD_((i + 2) % 3, i + 2);
    if (i == 1) { if (dk) __builtin_amdgcn_global_load_lds((const unsigned*)gk0, lk, 16, 0, 0); }
    if (i == 3) { if constexpr (DK == 128) { if (dk) __builtin_amdgcn_global_load_lds((const unsigned*)gk1, (lds_up)((lds_cp)lk + 8192), 16, 0, 0); } }
    if (i == 5) { if (dv) __builtin_amdgcn_global_load_lds((const unsigned*)gv0, lv, 16, 0, 0); }
    if (i == 7) { if (dv) __builtin_amdgcn_global_load_lds((const unsigned*)gv1, (lds_up)((lds_cp)lv + 8192), 16, 0, 0); }
    if (i == 12 || i == 13) { const int cb_ = ((i - 12) * 16 + hi * 8) * 2;
      if constexpr (DK == 128) { kf[i - 12][0] = *reinterpret_cast<const bf16x8*>(Kn + KSWZ128(r32, cb_)); kf[i - 12][1] = *reinterpret_cast<const bf16x8*>(Kn + KSWZ128(32 + r32, cb_)); }
      else { kf[i - 12][0] = *reinterpret_cast<const bf16x8*>(Kn + KSWZ64(r32, cb_)); kf[i - 12][1] = *reinterpret_cast<const bf16x8*>(Kn + KSWZ64(32 + r32, cb_)); } }
    SBAR();
    o[i & 3] = __builtin_amdgcn_mfma_f32_32x32x16_bf16(pa[i >> 2], VFR_(i % 3), o[i & 3], 0, 0, 0);
    if constexpr (NOMAX) { c0[i] = __builtin_amdgcn_exp2f(c0[i]); c1[i] = __builtin_amdgcn_exp2f(c1[i]); if (i > 0) { psa += c0[i - 1]; psb += c1[i - 1]; } PIN(c0); PIN(c1); PIN(psa); PIN(psb); }
    else {
    if (i == 0) { ma = max3f(c0[0], c0[1], c1[0]); mb = max3f(c0[2], c0[3], c1[1]); ma = max3f(ma, c1[2], c1[3]); }
    if (i >= 1 && i <= 3) { const int r = 4 * i; ma = max3f(ma, c0[r], c0[r + 1]); mb = max3f(mb, c0[r + 2], c0[r + 3]); ma = max3f(ma, c1[r], c1[r + 1]); mb = max3f(mb, c1[r + 2], c1[r + 3]); }
    if (i == 4) { float pmax = fmaxf(ma, mb);
      { auto rr = __builtin_amdgcn_permlane32_swap(__float_as_uint(pmax), __float_as_uint(pmax), false, false);
        pmax = fmaxf(__uint_as_float(rr[0]), __uint_as_float(rr[1])); }
      pmax += cb;
      const bool keep = __all(pmax - m_reg <= THR2);
      const float mn = keep ? m_reg : fmaxf(m_reg, pmax);
      alpha = __builtin_amdgcn_exp2f(m_reg - mn); m_reg = mn; mnC = cb - mn; }
    if (i >= 5 && i <= 8) { const int r = 4 * (i - 5);
#pragma unroll
      for (int q = 0; q < 4; ++q) { c0[r + q] += mnC; c1[r + q] += mnC; } }
    if (i >= 9) { const int r0 = (i - 9) * 2 + (i > 14 ? 1 : 0), n = i >= 14 ? 3 : 2;
#pragma unroll
      for (int q = 0; q < n; ++q) c0[r0 + q] = __builtin_amdgcn_exp2f(c0[r0 + q]); }
    if (i <= 3) { PIN(ma); PIN(mb); }
    if (i == 4) { PIN(mnC); PIN(alpha); PIN(m_reg); }
    if (i >= 5 && i <= 8) { PIN(c0); PIN(c1); }
    if (i >= 9) PIN(c0);
    }
    SBAR();
  }
#undef VRD_
#undef VFR_
  if constexpr (NOMAX) { float ps = (psa + c0[15]) + (psb + c1[15]);
    { auto rr = __builtin_amdgcn_permlane32_swap(__float_as_uint(ps), __float_as_uint(ps), false, false);
      ps = __uint_as_float(rr[0]) + __uint_as_float(rr[1]); }
    l_reg = l_reg * alpha + ps; }
}

constexpr int RING_K = 0, RING_V = 4 * SHM_K;
template <int DK, int LDK, bool BIAS, bool NOMAX>
__device__ __forceinline__ void flash_pass(const bf16x8* qr, const bf16_t* __restrict__ Kh, const bf16_t* __restrict__ Vh, const int seq, char* lds,
                                           f32x16* o, float& l_out, const int qlo, const float b_neg, const float b_pos) {
  int tid_ = threadIdx.x; asm volatile("" : "+v"(tid_));
  const int tid = tid_, lane = tid & 63, r32 = lane & 31, hi = lane >> 5; const int wid = __builtin_amdgcn_readfirstlane(tid >> 6);
  typedef __attribute__((address_space(3))) unsigned* lds_uptr;
  char* K_lds = lds + RING_K; char* V_lds = lds + RING_V;
  float* ws = (float*)(lds + LDS_WSOFF) + wid * 64; float* al_l = ws + 32;
  const float* tb = (const float*)(lds + LDS_TB);
  float m_reg = -1e30f, l_reg = 0.f;
  o[0] = f32x16{}; o[1] = f32x16{}; o[2] = f32x16{}; o[3] = f32x16{};
  int koff0, koff1 = 0, voff0, voff1;
  if constexpr (DK == 128) { { const int r = 4 * wid + (lane >> 4), c = (lane & 15) ^ (r & 7); koff0 = r * LDK + c * 8; }
                             { const int r = 4 * (wid + 8) + (lane >> 4), c = (lane & 15) ^ (r & 7); koff1 = r * LDK + c * 8; } }
  else { const int r = 8 * wid + (lane >> 3), c = (lane & 7) ^ ((r >> 1) & 7); koff0 = r * LDK + c * 8; }
  { const int st = 2 * wid + (lane >> 5), kk = (st >> 2) * 8 + ((lane & 31) >> 2), k = (kk & ~0xC) | ((kk & 4) << 1) | ((kk & 8) >> 1); voff0 = k * LDK + (st & 3) * 32 + (lane & 3) * 8; }
  { const int st = 2 * (wid + 8) + (lane >> 5), kk = (st >> 2) * 8 + ((lane & 31) >> 2), k = (kk & ~0xC) | ((kk & 4) << 1) | ((kk & 8) >> 1); voff1 = k * LDK + (st & 3) * 32 + (lane & 3) * 8; }
  const bf16_t* ks0 = Kh + koff0; const bf16_t* ks1 = Kh + koff1; const bf16_t* vs0 = Vh + voff0; const bf16_t* vs1 = Vh + voff1;
  const lds_uptr kdst = (lds_uptr)(K_lds + wid * 1024), vdst = (lds_uptr)(V_lds + wid * 1024);
#define GLDS(G, L) __builtin_amdgcn_global_load_lds((const unsigned*)(G), (L), 16, 0, 0)
#define DMA_K(T, SL) do { const long t_ = (long)(T) * (KVBLK * LDK); GLDS(ks0 + t_, (lds_uptr)((__attribute__((address_space(3))) char*)kdst + (SL))); \
    if constexpr (DK == 128) GLDS(ks1 + t_, (lds_uptr)((__attribute__((address_space(3))) char*)kdst + (SL) + 8192)); } while (0)
#define DMA_V(T, SL) do { const long t_ = (long)(T) * (KVBLK * LDK); GLDS(vs0 + t_, (lds_uptr)((__attribute__((address_space(3))) char*)vdst + (SL))); \
    GLDS(vs1 + t_, (lds_uptr)((__attribute__((address_space(3))) char*)vdst + (SL) + 8192)); } while (0)
#define WBAR(N) asm volatile("s_waitcnt vmcnt(" #N ") lgkmcnt(0)\n\ts_barrier" ::: "memory")
#define RESC(a) do { if (__any((a) != 1.f)) { if (hi == 0) al_l[r32] = (a); asm volatile("s_waitcnt lgkmcnt(0)" ::: "memory"); \
    _Pragma("unroll") for (int d = 0; d < 4; ++d) _Pragma("unroll") for (int r = 0; r < 16; ++r) o[d][r] *= al_l[crow(r, hi)]; } } while (0)
#define PSM(P0, P1, T, MN, AL) do { float cb_ = 0.f; \
    if constexpr (BIAS) { const int k0_ = (T) * KVBLK; const int rmin_ = k0_ - (qlo + 31), rmax_ = k0_ + 63 - qlo; \
      if (rmin_ >= 91) cb_ = b_pos; else if (rmax_ <= -91) cb_ = b_neg; \
      else add_bias(P0, P1, tb, k0_ - (qlo + r32) + 256, hi); } \
    partialSM<DK>(P0, P1, m_reg, MN, AL, cb_); } while (0)
#define TBIAS(P0, P1, T) float cb_ = 0.f; \
    if constexpr (BIAS) { const int k0_ = (T) * KVBLK; const int rmin_ = k0_ - (qlo + 31), rmax_ = k0_ + 63 - qlo; \
      if (rmin_ >= 91) cb_ = b_pos; else if (rmax_ <= -91) cb_ = b_neg; \
      else add_bias(P0, P1, tb, k0_ - (qlo + r32) + 256, hi); }
  float curb = 0.f;
  f32x16 pA0, pA1, pB0, pB1; float mnA, alA, alB; bf16x8 pa[4]; const int NT = seq / KVBLK;
  const lds_cptr vp0 = (lds_cptr)V_lds + v_rd_base(lane);
  const int vb0 = (int)(uintptr_t)V_lds + v_rd_base(lane);
  WBAR(0);
  DMA_K(0, 0); DMA_V(0, 0); DMA_K(1, SHM_K); DMA_K(2, 2 * SHM_K);
  if constexpr (DK == 128) WBAR(6); else WBAR(4);
  qkt<DK>(pA0, pA1, K_lds, qr, r32, hi);
  if constexpr (NOMAX) { TBIAS(pA0, pA1, 0); curb = cb_; alA = 1.f;
#pragma unroll
    for (int r = 0; r < 16; ++r) { pA0[r] = __builtin_amdgcn_exp2f(pA0[r]); pA1[r] = __builtin_amdgcn_exp2f(pA1[r]); }
    float ps0 = 0.f;
#pragma unroll
    for (int r = 0; r < 16; ++r) ps0 += pA0[r] + pA1[r];
    { auto rr = __builtin_amdgcn_permlane32_swap(__float_as_uint(ps0), __float_as_uint(ps0), false, false);
      ps0 = __uint_as_float(rr[0]) + __uint_as_float(rr[1]); }
    l_reg = ps0; }
  else PSM(pA0, pA1, 0, mnA, alA);
  DMA_K(3, 3 * SHM_K); DMA_V(1, SHM_V);
  if constexpr (DK == 128) WBAR(4); else WBAR(3);
  bf16x8 kf[2][2]; s16x4 vl[3], vh[3];
#pragma unroll
  for (int q = 0; q < 2; ++q) { const int cbq = (q * 16 + hi * 8) * 2;
    if constexpr (DK == 128) { kf[q][0] = *reinterpret_cast<const bf16x8*>(K_lds + SHM_K + KSWZ128(r32, cbq)); kf[q][1] = *reinterpret_cast<const bf16x8*>(K_lds + SHM_K + KSWZ128(32 + r32, cbq)); }
    else { kf[q][0] = *reinterpret_cast<const bf16x8*>(K_lds + SHM_K + KSWZ64(r32, cbq)); kf[q][1] = *reinterpret_cast<const bf16x8*>(K_lds + SHM_K + KSWZ64(32 + r32, cbq)); } }
  int sp = 0, sj = SHM_V, sn = 2 * SHM_V;
#define STEPT(C0, C1, P0, P1, ALP, ALC, J) do { \
    qk_fs<DK, NOMAX>(C0, C1, K_lds + ((J) & 3) * SHM_K, qr, r32, hi, P0, P1, ALP, l_reg, pa, kf, vp0 + sp, vl, vh); \
    SBAR(); \
    { TBIAS(C0, C1, J); if constexpr (NOMAX) { ALC = __builtin_amdgcn_exp2f(curb - cb_); curb = cb_; } \
      const long tk_ = (long)((J) + 3) * (KVBLK * LDK), tv_ = (long)((J) + 1) * (KVBLK * LDK); \
      pv_psm<DK, NOMAX>(o, vp0 + sp, pa, C0, C1, m_reg, ALC, cb_, vl, vh, kf, K_lds + (((J) + 1) & 3) * SHM_K, r32, hi, l_reg, \
                        (J) + 3 < NT, (J) + 1 < NT, ks0 + tk_, ks1 + tk_, vs0 + tv_, vs1 + tv_, \
                        (lds_uptr)((__attribute__((address_space(3))) char*)kdst + (((J) + 3) & 3) * SHM_K), (lds_uptr)((__attribute__((address_space(3))) char*)vdst + sn)); } \
    RESC(ALC); \
    if ((J) + 3 < NT) { if constexpr (DK == 128) WBAR(4); else WBAR(3); } else WBAR(0); \
    { const int t_ = sp; sp = sj; sj = sn; sn = t_; } } while (0)
  for (int j = 1; j + 1 < NT; j += 2) {
    STEPT(pB0, pB1, pA0, pA1, alA, alB, j);
    STEPT(pA0, pA1, pB0, pB1, alB, alA, j + 1);
  }
  STEPT(pB0, pB1, pA0, pA1, alA, alB, NT - 1);
  if constexpr (NOMAX) { PK4R(pB0, 0, pa[0]); PK4R(pB0, 8, pa[1]); PK4R(pB1, 0, pa[2]); PK4R(pB1, 8, pa[3]); }
  else finishSM<false>(pB0, pB1, alB, l_reg, pa[0], pa[1], pa[2], pa[3]);
  SBAR();
  pv_d0(o, vb0 + sp, pa[0], pa[1], pa[2], pa[3]);
  l_out = l_reg;
#undef GLDS
#undef DMA_K
#undef DMA_V
#undef WBAR
#undef RESC
#undef PSM
#undef TBIAS
#undef STEPT
}
__device__ __forceinline__ void row_rcp(float l_reg, float* ws, int r32, int hi, float* rli) {
  if (hi == 0) ws[r32] = l_reg; asm volatile("s_waitcnt lgkmcnt(0)" ::: "memory");
#pragma unroll
  for (int r = 0; r < 16; ++r) rli[r] = __builtin_amdgcn_rcpf(ws[crow(r, hi)]);
  asm volatile("s_waitcnt lgkmcnt(0)" ::: "memory");
}
__device__ __forceinline__ float silu(float z) { return z * __builtin_amdgcn_rcpf(1.0f + __builtin_amdgcn_exp2f(-1.4426950408889634f * z)); }
constexpr int STG_LD = 132;
constexpr int STG_WAVE = 32 * STG_LD * 4;
template <bool NORM>
__device__ __forceinline__ void out_rows(const f32x16* o, const float* rli_or_null, char* lds, const float* gain, const float gscale,
                                         const bf16_t* Z, bf16_t* O, const size_t obase  ) {
  int tid_ = threadIdx.x; asm volatile("" : "+v"(tid_));
  const int tid = tid_, wid = tid >> 6, lane = tid & 63, r32 = lane & 31, hi = lane >> 5;
  float* stg = (float*)(lds + wid * STG_WAVE);
  const int c8 = (lane & 15) * 8, rsub = lane >> 4;
  u32x4 zq[8];
#pragma unroll
  for (int it = 0; it < 8; ++it) zq[it] = *(const u32x4*)(Z + obase + (size_t)(it * 4 + rsub) * 1024 + c8);
#pragma unroll
  for (int d0 = 0; d0 < 4; ++d0)
#pragma unroll
    for (int r = 0; r < 16; ++r) stg[crow(r, hi) * STG_LD + d0 * 32 + r32] = rli_or_null ? o[d0][r] * rli_or_null[r] : o[d0][r];
  asm volatile("s_waitcnt lgkmcnt(0)" ::: "memory");
  f32x4 g0 = {1.f, 1.f, 1.f, 1.f}, g1 = {1.f, 1.f, 1.f, 1.f};
  if constexpr (NORM) { g0 = *(const f32x4*)(gain + c8) * gscale; g1 = *(const f32x4*)(gain + c8 + 4) * gscale; }
#pragma unroll
  for (int it = 0; it < 8; ++it) { const int row = it * 4 + rsub;
    f32x4 v0 = *(const f32x4*)(stg + row * STG_LD + c8), v1 = *(const f32x4*)(stg + row * STG_LD + c8 + 4);
    const size_t off = obase + (size_t)row * 1024 + c8;
    const u32x4 zv = zq[it];
    if constexpr (NORM) {
      float ssq = (v0[0] * v0[0] + v0[1] * v0[1]) + (v0[2] * v0[2] + v0[3] * v0[3]) + (v1[0] * v1[0] + v1[1] * v1[1]) + (v1[2] * v1[2] + v1[3] * v1[3]);
      ssq += __shfl_xor(ssq, 1); ssq += __shfl_xor(ssq, 2); ssq += __shfl_xor(ssq, 4); ssq += __shfl_xor(ssq, 8);
      const float rstd = __builtin_amdgcn_rsqf(ssq * (1.0f / 128.0f) + 1e-6f);
      v0 = v0 * rstd * g0; v1 = v1 * rstd * g1; }
    v0[0] *= silu(__uint_as_float(zv.x << 16)); v0[1] *= silu(__uint_as_float(zv.x & 0xffff0000u));
    v0[2] *= silu(__uint_as_float(zv.y << 16)); v0[3] *= silu(__uint_as_float(zv.y & 0xffff0000u));
    v1[0] *= silu(__uint_as_float(zv.z << 16)); v1[1] *= silu(__uint_as_float(zv.z & 0xffff0000u));
    v1[2] *= silu(__uint_as_float(zv.w << 16)); v1[3] *= silu(__uint_as_float(zv.w & 0xffff0000u));
    u32x4 w = {cvtpk(v0[0], v0[1]), cvtpk(v0[2], v0[3]), cvtpk(v1[0], v1[1]), cvtpk(v1[2], v1[3])};
    *(u32x4*)(O + off) = w; }
}

__device__ __forceinline__ void item_a(bf16_t* OUT, const bf16_t* QA, const bf16_t* KA, const bf16_t* VA, const bf16_t* ZA, const float* tabA, const float* subln, const float lam,
                                       float* scr, const int rowbase, const int q0, const int h, const int S, char* lds) {
  int tid_ = threadIdx.x; asm volatile("" : "+v"(tid_));
  const int tid = tid_, wid = tid >> 6, lane = tid & 63, r32 = lane & 31, hi = lane >> 5;
  float* tb = (float*)(lds + LDS_TB); float* ws = (float*)(lds + LDS_WSOFF) + wid * 64;
  tb[tid] = tabA[h * 512 + tid];
  const float b_neg = tabA[h * 512], b_pos = tabA[h * 512 + 511];
  const int qlo = q0 + wid * 32;
  const bf16_t* Kh = KA + (size_t)rowbase * 1024 + h * 128; const bf16_t* Vh = VA + (size_t)rowbase * 1024 + h * 128;
  const bf16_t* Qrow = QA + (size_t)(rowbase + qlo + r32) * 1024 + h * 128 + hi * 8;
  f32x16 o[4]; float l; bf16x8 qr[4];
#pragma unroll 1
  for (int mp = 0; mp < 2; ++mp) {
#pragma unroll
    for (int d0 = 0; d0 < 4; ++d0) qr[d0] = ld8(Qrow + mp * 64 + d0 * 16);
    volatile unsigned* badf = (volatile unsigned*)(lds + LDS_TB + 2048);
    if (tid == 0) *badf = 0u;
    flash_pass<64, 1024, true, true>(qr, Kh + mp * 64, Vh, S, lds, o, l, qlo, b_neg, b_pos);
    if (!(l > 1e-30f && l < 1e30f)) *badf = 1u;
    __syncthreads(); const unsigned redo = (PROBE == 20) ? 1u : *badf; __syncthreads();
    if (redo != 0u) flash_pass<64, 1024, true, false>(qr, Kh + mp * 64, Vh, S, lds, o, l, qlo, b_neg, b_pos);
    float rli[16]; row_rcp(l, ws, r32, hi, rli);
    if (mp == 0) {
#pragma unroll
      for (int d0 = 0; d0 < 4; ++d0)
#pragma unroll
        for (int r = 0; r < 16; r += 8) { u32x4 w;
          w.x = cvtpk(o[d0][r] * rli[r], o[d0][r + 1] * rli[r + 1]);         w.y = cvtpk(o[d0][r + 2] * rli[r + 2], o[d0][r + 3] * rli[r + 3]);
          w.z = cvtpk(o[d0][r + 4] * rli[r + 4], o[d0][r + 5] * rli[r + 5]); w.w = cvtpk(o[d0][r + 6] * rli[r + 6], o[d0][r + 7] * rli[r + 7]);
          ((u32x4*)(scr + tid * 32))[d0 * 2 + (r >> 3)] = w; }
    } else {
#pragma unroll
      for (int d0 = 0; d0 < 4; ++d0)
#pragma unroll
        for (int r = 0; r < 16; r += 8) { const u32x4 w = ((const u32x4*)(scr + tid * 32))[d0 * 2 + (r >> 3)];
          const unsigned ww[4] = {w.x, w.y, w.z, w.w};
#pragma unroll
          for (int q = 0; q < 4; ++q) { o[d0][r + 2 * q] = __uint_as_float(ww[q] << 16) - lam * (o[d0][r + 2 * q] * rli[r + 2 * q]);
            o[d0][r + 2 * q + 1] = __uint_as_float(ww[q] & 0xffff0000u) - lam * (o[d0][r + 2 * q + 1] * rli[r + 2 * q + 1]); } }
    }
  }
  __syncthreads();
  out_rows<true>(o, nullptr, lds, subln, 0.8f, ZA, OUT, (size_t)(rowbase + qlo) * 1024 + h * 128);
  __syncthreads();
}

__device__ __forceinline__ void item_b(bf16_t* OUT, const bf16_t* QB, const bf16_t* KB, const bf16_t* VB, const bf16_t* ZB, const float* qg, const f32x2* rt,
                                       const int rowbase, const int q0, const int h, const int S, char* lds) {
  int tid_ = threadIdx.x; asm volatile("" : "+v"(tid_));
  const int tid = tid_, wid = tid >> 6, lane = tid & 63, r32 = lane & 31, hi = lane >> 5;
  float* ws = (float*)(lds + LDS_WSOFF) + wid * 64;
  const int qlo = q0 + wid * 32, t = qlo + r32, kvh = h >> 2;
  const bf16_t* Kh = KB + (size_t)rowbase * 256 + kvh * 128; const bf16_t* Vh = VB + (size_t)rowbase * 256 + kvh * 128;
  const bf16_t* Qrow = QB + (size_t)(rowbase + t) * 1024 + h * 128 + hi * 8;
  bf16x8 qr[8];
  { float f[8][8]; float ssq = 0.f;
#pragma unroll
    for (int d0 = 0; d0 < 8; ++d0) { const bf16x8 raw = ld8(Qrow + d0 * 16);
#pragma unroll
      for (int j = 0; j < 8; ++j) { f[d0][j] = bf2f(raw[j]); ssq += f[d0][j] * f[d0][j]; } }
    { auto rr = __builtin_amdgcn_permlane32_swap(__float_as_uint(ssq), __float_as_uint(ssq), false, false);
      ssq = __uint_as_float(rr[0]) + __uint_as_float(rr[1]); }
    const float rstd = __builtin_amdgcn_rsqf(ssq * (1.0f / 128.0f) + 1e-6f) * (0.08838834764831845f * 1.4426950408889634f);
#pragma unroll
    for (int d0 = 0; d0 < 8; ++d0) { const f32x4 g0 = *(const f32x4*)(qg + d0 * 16 + hi * 8), g1 = *(const f32x4*)(qg + d0 * 16 + hi * 8 + 4);
#pragma unroll
      for (int j = 0; j < 4; ++j) { f[d0][j] *= rstd * g0[j]; f[d0][4 + j] *= rstd * g1[j]; } }
#pragma unroll
    for (int hf = 0; hf < 2; ++hf) { const int idx = hf == 0 ? (t >> 6) : (t & 63);
#pragma unroll
      for (int dp = 0; dp < 2; ++dp)
#pragma unroll
        for (int j = 0; j < 8; ++j) { const f32x2 cs = rt[idx * 32 + dp * 16 + hi * 8 + j];
          const float u1 = f[hf * 4 + dp][j], u2 = f[hf * 4 + dp + 2][j];
          f[hf * 4 + dp][j] = u1 * cs.x - u2 * cs.y; f[hf * 4 + dp + 2][j] = u1 * cs.y + u2 * cs.x; } }
#pragma unroll
    for (int d0 = 0; d0 < 8; ++d0) { u32x4 w = {cvtpk(f[d0][0], f[d0][1]), cvtpk(f[d0][2], f[d0][3]), cvtpk(f[d0][4], f[d0][5]), cvtpk(f[d0][6], f[d0][7])};
      qr[d0] = *reinterpret_cast<bf16x8*>(&w); }
  }
  f32x16 o[4]; float l; float rli[16];
  volatile unsigned* badf = (volatile unsigned*)(lds + LDS_TB + 2048);
  if (tid == 0) *badf = 0u;
  flash_pass<128, 256, false, true>(qr, Kh, Vh, S, lds, o, l, qlo, 0.f, 0.f);
  if (!(l > 1e-30f && l < 1e30f)) *badf = 1u;
  __syncthreads(); const unsigned redo = (PROBE == 20) ? 1u : *badf; __syncthreads();
  if (redo != 0u) flash_pass<128, 256, false, false>(qr, Kh, Vh, S, lds, o, l, qlo, 0.f, 0.f);
  row_rcp(l, ws, r32, hi, rli);
  __syncthreads();
  out_rows<false>(o, rli, lds, nullptr, 1.f, ZB, OUT, (size_t)(rowbase + qlo) * 1024 + h * 128);
  __syncthreads();
}
#undef SBAR
}
#define LAS __attribute__((address_space(3)))
typedef unsigned short bf16;
typedef unsigned v4u __attribute__((ext_vector_type(4)));
typedef float f32x4 __attribute__((ext_vector_type(4)));
typedef float f32x2 __attribute__((ext_vector_type(2)));
constexpr size_t MiB = 1u << 20;
constexpr size_t WS_WIN = 2 * MiB, WS_WPA = 20 * MiB, WS_WPB = 22 * MiB, WS_WOUT = 24 * MiB, WS_TAB = 26 * MiB;
constexpr size_t WS_XN = 32 * MiB;
constexpr size_t WS_BIG = 192 * MiB;
constexpr size_t WS_KB = 960 * MiB, WS_VB = 984 * MiB;
constexpr size_t WS_SCR = 1008 * MiB;
constexpr size_t WS_END = 1040 * MiB;
constexpr size_t TAB_BIAS = 0, TAB_ROPE = 16384, TAB_LAM = 16384 + 32768;
constexpr int LDS_BYTES = 147456;
constexpr int NWAVES = 8;

__device__ __forceinline__ unsigned f2bf(float f) { unsigned u = __builtin_bit_cast(unsigned, f); return (u + 0x7fffu + ((u >> 16) & 1u)) >> 16; }
__device__ __forceinline__ unsigned pk2(float lo, float hi) { return f2bf(lo) | (f2bf(hi) << 16); }
__device__ __forceinline__ float wave_sum(float v) {
#pragma unroll
    for (int o = 1; o < 64; o <<= 1) v += __shfl_xor(v, o);
    return v;
}
#define LDS_WAIT() asm volatile("s_waitcnt lgkmcnt(0)" ::: "memory")
__device__ __forceinline__ void p0_transpose_item(const float* W, int K, int N, bf16* WT, LAS float* scr, int item, int lane) {
    const int nblk = N / 32, kb = item / nblk, nb = item % nblk, k0 = 64 * kb, n0 = 32 * nb;
#pragma unroll 8
    for (int i = 0; i < 32; ++i) { const int kk = 2 * i + (lane >> 5); scr[kk * 33 + (lane & 31)] = W[(size_t)(k0 + kk) * N + n0 + (lane & 31)]; }
    LDS_WAIT(); asm volatile("" ::: "memory");
    const int c = lane & 7;
#pragma unroll
    for (int j = 0; j < 4; ++j) { const int n = (lane >> 3) + 8 * j; const LAS float* s = scr + (8 * c) * 33 + n;
        v4u o; o.x = pk2(s[0 * 33], s[1 * 33]); o.y = pk2(s[2 * 33], s[3 * 33]); o.z = pk2(s[4 * 33], s[5 * 33]); o.w = pk2(s[6 * 33], s[7 * 33]);
        *(v4u*)(WT + (size_t)(n0 + n) * K + k0 + 8 * c) = o; }
    LDS_WAIT(); asm volatile("" ::: "memory");
}

typedef __attribute__((address_space(1))) unsigned gu32;
#define XB_TMO      128
#define XB_XCNT(j)  (256  + 64 * (j))
#define XB_XSUB(j)  (1280 + 64 * (j))
#define XB_XGEN(j)  (2304 + 64 * (j))
#define XB_TOP      3328
#define XB_TOPGEN   3392
#define XCD_BAR_WORDS 3456
#define XB_SPIN_CAP (1u << 18)

__device__ __forceinline__ unsigned xb_ld(unsigned* p)              { return __hip_atomic_load(p, __ATOMIC_RELAXED, __HIP_MEMORY_SCOPE_AGENT); }
__device__ __forceinline__ unsigned xb_add(unsigned* p, unsigned v) { return __hip_atomic_fetch_add(p, v, __ATOMIC_RELAXED, __HIP_MEMORY_SCOPE_AGENT); }
__device__ __forceinline__ unsigned xb_xcc_id() { return (unsigned)__builtin_amdgcn_s_getreg((3 << 11) | 20) & 0xFu; }
#define XB_SPIN(cond, bar) do { unsigned _sp = 0; while (cond) { __builtin_amdgcn_s_sleep(1); \
    if ((++_sp & 255u) == 0u) { if (xb_ld(&(bar)[XB_TMO])) break; if (_sp > XB_SPIN_CAP) { atomicAdd(&(bar)[XB_TMO], 1u); break; } } } } while (0)

struct XcdBarrier {
    unsigned* bar; unsigned x;
    volatile LAS unsigned* st;
};

__device__ __forceinline__ XcdBarrier xcd_barrier_post(unsigned* bar, volatile LAS unsigned* st) {
    XcdBarrier b; b.bar = bar; b.x = xb_xcc_id(); b.st = st;
    if (threadIdx.x == 0) (void)xb_add(&bar[XB_XCNT(b.x)], 1u);
    return b;
}
__device__ __forceinline__ void xcd_barrier_complete(unsigned* bar, unsigned x, unsigned& nloc, unsigned& nx) {
    const unsigned G = gridDim.x * gridDim.y * gridDim.z;
    unsigned sum, cnt, mine, sp = 0u;
    for (;;) {
        sum = 0u; cnt = 0u; mine = 0u;
#pragma unroll
        for (unsigned j = 0; j < 16; ++j) { const unsigned c = xb_ld(&bar[XB_XCNT(j)]); sum += c; cnt += (c > 0u) ? 1u : 0u; mine = (j == x) ? c : mine; }
        if (sum == G) break;
        __builtin_amdgcn_s_sleep(1);
        if ((++sp & 255u) == 0u) { if (xb_ld(&bar[XB_TMO])) break; if (sp > XB_SPIN_CAP) { atomicAdd(&bar[XB_TMO], 1u); break; } }
    }
    nloc = mine > 0u ? mine : 1u; nx = cnt > 0u ? cnt : 1u;
}

__device__ __forceinline__ void xcd_barrier(const XcdBarrier& b) {
    asm volatile("s_waitcnt vmcnt(0)" ::: "memory");
    __syncthreads();
    if (threadIdx.x == 0) {
        unsigned* bar = b.bar;
        __builtin_amdgcn_s_waitcnt(0);
        unsigned nloc = b.st[0], nx = b.st[1];
        if (nloc == 0u) { xcd_barrier_complete(bar, b.x, nloc, nx); b.st[0] = nloc; b.st[1] = nx; }
        const unsigned old = xb_add(&bar[XB_XSUB(b.x)], 1u);
        const unsigned gen = old / nloc;
        if (old + 1u == (gen + 1u) * nloc) {
            __builtin_amdgcn_fence(__ATOMIC_RELEASE, "agent");
            asm volatile("s_waitcnt vmcnt(0)" ::: "memory");
            const unsigned og = xb_add(&bar[XB_TOP], 1u);
            const unsigned tg = og / nx;
            if (og + 1u == (tg + 1u) * nx) xb_add(&bar[XB_TOPGEN], 1u);
            else XB_SPIN(xb_ld(&bar[XB_TOPGEN]) == tg, bar);
            __builtin_amdgcn_fence(__ATOMIC_ACQUIRE, "agent");
            xb_add(&bar[XB_XGEN(b.x)], 1u);
            asm volatile("s_waitcnt vmcnt(0)" ::: "memory");
        } else {
            XB_SPIN(xb_ld(&bar[XB_XGEN(b.x)]) == gen, bar);
            __builtin_amdgcn_fence(__ATOMIC_ACQUIRE, "agent");
            asm volatile("s_waitcnt vmcnt(0)" ::: "memory");
        }
    }
    __syncthreads();
}

struct Args { const float* in[16]; float* out; unsigned char* ws; };

__global__ void __launch_bounds__(NWAVES * 64, 2) fwd_mega(Args a) {
    extern __shared__ __attribute__((aligned(16))) unsigned char lds[];
    cg::grid_group grid = cg::this_grid();
    const int tid = threadIdx.x, lane = tid & 63, wave = __builtin_amdgcn_readfirstlane(tid >> 6);
    const int G = gridDim.x, bx = blockIdx.x;
    const int vcu = (G % 8 == 0) ? (bx % 8) * (G / 8) + bx / 8 : bx;
    unsigned char* ws = a.ws;
    volatile LAS unsigned* bar_st = (volatile LAS unsigned*)((LAS unsigned char*)lds + (LDS_BYTES - 64));
    if (tid < 2) bar_st[tid] = 0u;
    __syncthreads();
    const XcdBarrier xbar = xcd_barrier_post((unsigned*)ws, bar_st);
#define GRID_BAR() xcd_barrier(xbar)
    const float* xp = a.in[0]; const float* xs = a.in[1]; const float* g_norm = a.in[2]; const float* w_in = a.in[3];
    const float* lq1 = a.in[4]; const float* lk1 = a.in[5]; const float* lq2 = a.in[6]; const float* lk2 = a.in[7];
    const float* subln = a.in[8]; const float* qnb = a.in[9]; const float* knb = a.in[10];
    const float* w_pa = a.in[11]; const float* w_pb = a.in[12]; const float* w_out = a.in[13]; const float* rel_bias = a.in[14]; const float* g_final = a.in[15];
    bf16* WinT = (bf16*)(ws + WS_WIN); bf16* WpaT = (bf16*)(ws + WS_WPA); bf16* WpbT = (bf16*)(ws + WS_WPB); bf16* WoutT = (bf16*)(ws + WS_WOUT);
    float* tabA = (float*)(ws + WS_TAB + TAB_BIAS); f32x2* rt = (f32x2*)(ws + WS_TAB + TAB_ROPE); float* lamp = (float*)(ws + WS_TAB + TAB_LAM);
    bf16* XN = (bf16*)(ws + WS_XN);
    bf16* BIG = (bf16*)(ws + WS_BIG);
    bf16 *QA = BIG, *KA = BIG + pg8::BUFE, *VA = BIG + 2 * pg8::BUFE, *ZA = BIG + 3 * pg8::BUFE, *QB = BIG + 4 * pg8::BUFE, *ZB = BIG + 5 * pg8::BUFE, *GA = BIG + 6 * pg8::BUFE, *GB = BIG + 7 * pg8::BUFE;
    bf16* KB = (bf16*)(ws + WS_KB); bf16* VB = (bf16*)(ws + WS_VB);
    float* scr = (float*)(ws + WS_SCR) + (size_t)bx * 32768;
    const int gw = vcu * NWAVES + wave, NGW = G * NWAVES;

    for (int rep_ = 0; rep_ < (PROBE == 4 ? 2 : 1); ++rep_) {
        LAS float* tscr = (LAS float*)((LAS unsigned char*)lds + wave * 16384);
        constexpr int I_IN = (1024 / 64) * (NIN / 32), I_SQ = (1024 / 64) * (1024 / 32);
        for (int it = gw; it < I_IN + 3 * I_SQ; it += NGW) {
            int r = it;
            if (r < I_IN) { p0_transpose_item(w_in, 1024, NIN, WinT, tscr, r, lane); continue; } r -= I_IN;
            if (r < I_SQ) { p0_transpose_item(w_pa, 1024, 1024, WpaT, tscr, r, lane); continue; } r -= I_SQ;
            if (r < I_SQ) { p0_transpose_item(w_pb, 1024, 1024, WpbT, tscr, r, lane); continue; } r -= I_SQ;
            p0_transpose_item(w_out, 1024, 1024, WoutT, tscr, r, lane);
        }
        f32x4 gv[4];
#pragma unroll
        for (int j = 0; j < 4; ++j) gv[j] = ((const f32x4*)g_norm)[lane + 64 * j];
        for (int m0 = gw; m0 < NTOK; m0 += 4 * NGW) {
            f32x4 v[4][4]; float ssq[4];
#pragma unroll
            for (int q = 0; q < 4; ++q) { const int m = m0 + q * NGW; ssq[q] = 0.f; if (m >= NTOK) continue;
                const f32x4* xr = (const f32x4*)(m < NPTOK ? xp + (size_t)m * 1024 : xs + (size_t)(m - NPTOK) * 1024) + lane;
#pragma unroll
                for (int j = 0; j < 4; ++j) { v[q][j] = xr[64 * j]; ssq[q] += (v[q][j].x * v[q][j].x + v[q][j].y * v[q][j].y) + (v[q][j].z * v[q][j].z + v[q][j].w * v[q][j].w); } }
#pragma unroll
            for (int q = 0; q < 4; ++q) { const int m = m0 + q * NGW; if (m >= NTOK) continue;
                const float rstd = 1.0f / sqrtf(wave_sum(ssq[q]) * (1.f / 1024.f) + EPS);
                unsigned long long* o8 = (unsigned long long*)(XN + (size_t)m * 1024) + lane;
#pragma unroll
                for (int j = 0; j < 4; ++j) { const f32x4 w = v[q][j] * rstd * gv[j];
                    o8[64 * j] = (unsigned long long)pk2(w.x, w.y) | ((unsigned long long)pk2(w.z, w.w) << 32); } }
        }
        if (bx == G - 1) {
            for (int i = tid; i < 8 * 512; i += NWAVES * 64) { const int h = i >> 9, rel = (i & 511) - 256, n = rel < 0 ? -rel : rel;
                const int lg = n < 8 ? n : (n < 12 ? 8 : n < 16 ? 9 : n < 23 ? 10 : n < 32 ? 11 : n < 46 ? 12 : n < 64 ? 13 : n < 91 ? 14 : 15);
                tabA[i] = rel_bias[((rel > 0 ? 16 : 0) + lg) * 8 + h] * 1.4426950408889634f; }
            for (int i = tid; i < 128 * 32; i += NWAVES * 64) { const int idx = i >> 5, fi = i & 31;
                const float inv = __builtin_amdgcn_exp2f(-(float)fi * (13.287712379549449f / 32.0f));
                float rev = (float)idx * inv * 0.15915494309189535f; rev -= rintf(rev);
                rt[i] = (f32x2){__builtin_amdgcn_cosf(rev), __builtin_amdgcn_sinf(rev)}; }
            if (tid == 0) { float s1 = 0.f, s2 = 0.f; for (int i = 0; i < 64; ++i) { s1 += lq1[i] * lk1[i]; s2 += lq2[i] * lk2[i]; }
                lamp[0] = __expf(s1) - __expf(s2) + 0.2f; }
        }
    }
    grid.sync();
#if PROBE == 5
    for (int q_ = 0; q_ < 11; ++q_) GRID_BAR();
#endif
    const float lam = lamp[0];

    for (int g = 0; g < NGRP; ++g) {
        const int GM = g == 0 ? GMAX : G1ROWS, gbase = g == 0 ? 0 : G1BASE;
        bf16* MERGED = XN + (size_t)gbase * 1024;
        {
            pg8::Gemm gm{XN + (size_t)gbase * 1024, WinT, GM, NIN, 1024, nullptr, nullptr}; pg8::StaticOrder S; S.init(GM, NIN, G, bx);
            pg8::EpiProj E{BIG, KB, VB};
            pg8::gemm_phase<pg8::EpiProj, pg8::StaticOrder, true, true>((LAS unsigned char*)lds, gm, S, E);
#if PROBE == 3
            pg8::gemm_phase<pg8::EpiProj, pg8::StaticOrder, true, true>((LAS unsigned char*)lds, gm, S, E);
#endif
        }
        GRID_BAR();
        { int lane_k = threadIdx.x & 63; asm volatile("" : "+v"(lane_k));
          const int c = lane_k & 15, sub = lane_k >> 4;
          const f32x4 kg0 = *(const f32x4*)(knb + c * 8), kg1 = *(const f32x4*)(knb + c * 8 + 4);
          v4u rawn = {0u, 0u, 0u, 0u};
          if (gw * 4 < GM * 2) { const int u = gw * 4 + sub; rawn = *(const v4u*)(KB + (size_t)(u >> 1) * 256 + (u & 1) * 128 + c * 8); }
          for (int u0 = gw * 4; u0 < GM * 2; u0 += NGW * 4) {
            const int u = u0 + sub, lr = u >> 1, kvh = u & 1;
            bf16* kp = KB + (size_t)lr * 256 + kvh * 128 + c * 8;
            const v4u raw = rawn;
            if (u0 + NGW * 4 < GM * 2) { const int un = u0 + NGW * 4 + sub; rawn = *(const v4u*)(KB + (size_t)(un >> 1) * 256 + (un & 1) * 128 + c * 8); }
            float f[8];
            f[0] = __uint_as_float(raw.x << 16); f[1] = __uint_as_float(raw.x & 0xffff0000u); f[2] = __uint_as_float(raw.y << 16); f[3] = __uint_as_float(raw.y & 0xffff0000u);
            f[4] = __uint_as_float(raw.z << 16); f[5] = __uint_as_float(raw.z & 0xffff0000u); f[6] = __uint_as_float(raw.w << 16); f[7] = __uint_as_float(raw.w & 0xffff0000u);
            float ssq = 0.f;
#pragma unroll
            for (int j = 0; j < 8; ++j) ssq += f[j] * f[j];
            ssq += __shfl_xor(ssq, 1); ssq += __shfl_xor(ssq, 2); ssq += __shfl_xor(ssq, 4); ssq += __shfl_xor(ssq, 8);
            const float rstd = 1.0f / sqrtf(ssq * (1.f / 128.f) + EPS);
#pragma unroll
            for (int j = 0; j < 4; ++j) { f[j] *= rstd * kg0[j]; f[4 + j] *= rstd * kg1[j]; }
            const int t = (g == 0 || lr < G1SAMPLE) ? (lr & 4095) : ((lr - G1SAMPLE) & 8191);
            const int idx = c < 8 ? (t >> 6) : (t & 63);
            const f32x4* rp = (const f32x4*)(rt + idx * 32 + (c & 3) * 8);
            const bool second = (c & 4) != 0;
            float o8[8];
#pragma unroll
            for (int j2 = 0; j2 < 4; ++j2) { const f32x4 cs = rp[j2];
              const float pa = __shfl_xor(f[2 * j2], 4), pb = __shfl_xor(f[2 * j2 + 1], 4);
              o8[2 * j2]     = second ? (pa * cs[1] + f[2 * j2] * cs[0])     : (f[2 * j2] * cs[0] - pa * cs[1]);
              o8[2 * j2 + 1] = second ? (pb * cs[3] + f[2 * j2 + 1] * cs[2]) : (f[2 * j2 + 1] * cs[2] - pb * cs[3]); }
            v4u w; w.x = pk2(o8[0], o8[1]); w.y = pk2(o8[2], o8[3]); w.z = pk2(o8[4], o8[5]); w.w = pk2(o8[6], o8[7]);
            *(v4u*)kp = w;
          }
        }
        GRID_BAR();
        {
            char* al = (char*)lds;
            const int nS = g == 0 ? 0 : 512, nP = g == 0 ? 1536 : 512;
            for (int i = vcu; i < nS; i += G) att::item_a(QA, QA, KA, VA, ZA, tabA, subln, lam, scr, G1SAMPLE + (i >> 8) * 8192, (i & 31) * 256, (i >> 5) & 7, 8192, al);
            for (int i = vcu; i < nP; i += G) att::item_a(QA, QA, KA, VA, ZA, tabA, subln, lam, scr, (i >> 7) * 4096, (i & 15) * 256, (i >> 4) & 7, 4096, al);
            for (int i = vcu; i < nS; i += G) att::item_b(QB, QB, KB, VB, ZB, qnb, (const att::f32x2*)rt, G1SAMPLE + (i >> 8) * 8192, (i & 31) * 256, (i >> 5) & 7, 8192, al);
            for (int i = vcu; i < nP; i += G) att::item_b(QB, QB, KB, VB, ZB, qnb, (const att::f32x2*)rt, (i >> 7) * 4096, (i & 15) * 256, (i >> 4) & 7, 4096, al);
        }
        GRID_BAR();
        for (int rep_ = 0; rep_ < (PROBE == 6 ? 2 : 1); ++rep_) {
            pg8::PairOrder S; S.init(GM, 1024, G, bx);
            pg8::Gemm gm{QA, WpaT, GM, 1024, 1024, QB, WpbT}; pg8::EpiPair E{GA, GB, MERGED};
            pg8::gemm_phase<pg8::EpiPair, pg8::PairOrder, true, true>((LAS unsigned char*)lds, gm, S, E);
        }
        GRID_BAR();
        for (int rep_ = 0; rep_ < (PROBE == 6 ? 2 : 1); ++rep_) {
            pg8::StaticOrder S; S.init(GM, 1024, G, bx);
            pg8::Gemm gm{MERGED, WoutT, GM, 1024, 1024, nullptr, nullptr}; pg8::EpiOut E{a.out, gbase};
            pg8::gemm_phase<pg8::EpiOut, pg8::StaticOrder, true, true>((LAS unsigned char*)lds, gm, S, E);
        }
        if (g == NGRP - 1) GRID_BAR();
    }
    {
        int lane5 = threadIdx.x & 63; asm volatile("" : "+v"(lane5)); const int lane = lane5;
        f32x4 gv[4];
#pragma unroll
        for (int j = 0; j < 4; ++j) gv[j] = ((const f32x4*)g_final)[lane + 64 * j];
        for (int m0 = gw; m0 < NTOK; m0 += 2 * NGW) {
            f32x4 v[2][4]; float ssq[2];
#pragma unroll
            for (int q = 0; q < 2; ++q) { const int m = m0 + q * NGW; ssq[q] = 0.f; if (m >= NTOK) continue;
                const f32x4* xr = (const f32x4*)(m < NPTOK ? xp + (size_t)m * 1024 : xs + (size_t)(m - NPTOK) * 1024) + lane;
                const unsigned long long* dr = (const unsigned long long*)(a.out + (size_t)m * 1024) + lane;
#pragma unroll
                for (int j = 0; j < 4; ++j) { const unsigned long long d = dr[64 * j]; const unsigned dlo = (unsigned)d, dhi = (unsigned)(d >> 32);
                    f32x4 h = xr[64 * j];
                    h.x += __uint_as_float(dlo << 16); h.y += __uint_as_float(dlo & 0xffff0000u); h.z += __uint_as_float(dhi << 16); h.w += __uint_as_float(dhi & 0xffff0000u);
                    v[q][j] = h; ssq[q] += (h.x * h.x + h.y * h.y) + (h.z * h.z + h.w * h.w); } }
#pragma unroll
            for (int q = 0; q < 2; ++q) { const int m = m0 + q * NGW; if (m >= NTOK) continue;
                const float rstd = 1.0f / sqrtf(wave_sum(ssq[q]) * (1.f / 1024.f) + EPS);
                f32x4* yr = (f32x4*)(a.out + (size_t)m * 1024) + lane;
#pragma unroll
                for (int j = 0; j < 4; ++j) yr[64 * j] = v[q][j] * rstd * gv[j]; }
        }
    }
}

extern "C" void kernel_launch(void* const* d_in, const int* in_sizes, int n_in, void* d_out, int out_size, void* d_ws, size_t ws_size, hipStream_t stream) {
    static int grid = 0;
    if (grid == 0) {
        if (n_in != 16 || out_size != NTOK * 1024 || ws_size < WS_END) { fprintf(stderr, "kernel_launch: unexpected shapes: n_in %d out %d ws %zu (need %zu)\n", n_in, out_size, ws_size, (size_t)WS_END); grid = -1; return; }
        int dev = 0, cus = 0, per_cu = 0;
        if (hipGetDevice(&dev) != hipSuccess || hipDeviceGetAttribute(&cus, hipDeviceAttributeMultiprocessorCount, dev) != hipSuccess) { grid = -1; return; }
        if (hipFuncSetAttribute((const void*)fwd_mega, hipFuncAttributeMaxDynamicSharedMemorySize, LDS_BYTES) != hipSuccess) { fprintf(stderr, "kernel_launch: hipFuncSetAttribute failed\n"); grid = -1; return; }
        if (hipOccupancyMaxActiveBlocksPerMultiprocessor(&per_cu, (const void*)fwd_mega, NWAVES * 64, LDS_BYTES) != hipSuccess || per_cu < 1) { fprintf(stderr, "kernel_launch: occupancy query gave %d\n", per_cu); per_cu = 1; }
        (void)hipGetLastError();
        grid = cus * (per_cu > 1 ? 1 : per_cu);
    }
    if (grid < 0) return;
    Args a{};
    for (int i = 0; i < 16; ++i) a.in[i] = (const float*)d_in[i];
    a.out = (float*)d_out; a.ws = (unsigned char*)d_ws;
    if (hipMemsetAsync(d_ws, 0, 16384, stream) != hipSuccess) { fprintf(stderr, "kernel_launch: memset failed\n"); return; }
    void* args[] = {&a};
    hipError_t e = hipLaunchCooperativeKernel((const void*)fwd_mega, dim3(grid), dim3(NWAVES * 64), args, LDS_BYTES, stream);
    if (e != hipSuccess) fprintf(stderr, "kernel_launch: cooperative launch failed: %s (grid %d)\n", hipGetErrorString(e), grid);
}
```

```cpp
#include <hip/hip_runtime.h>
#include <hip/hip_cooperative_groups.h>
#include <cstdio>
#include <cstdint>
namespace cg = cooperative_groups;

constexpr int DM = 1024;
constexpr int NTOK = 81920, NPTOK = 65536;
constexpr int GMAX = 49152, G1BASE = 49152, G1ROWS = 32768, G1SAMPLE = 16384;
constexpr int NGRP = 2;
constexpr int NIN = 8704;
constexpr float EPS = 1e-6f;
#ifndef PROBE
#define PROBE 0
#endif
namespace pg8 {
#define PG8_LAS __attribute__((address_space(3)))
typedef unsigned short bf16_t;
typedef short bf16x8 __attribute__((ext_vector_type(8)));
typedef float f32x4 __attribute__((ext_vector_type(4)));
typedef unsigned u32x4 __attribute__((ext_vector_type(4)));
constexpr int BM = 256, BK = 64, HALF = 128, HTB = HALF * BK * 2  , STAGE_BYTES = 8 * HTB, NXCD = 8, WGM = 8;

__host__ __device__ __forceinline__ int lds_byte(int r, int c) { const int st = (r >> 4) * 2 + (c >> 5), rr = r & 15, cc = c & 31, ob = rr * 64 + cc * 2; return st * 1024 + (ob ^ (((ob >> 9) & 1) << 5)); }
__host__ __device__ __forceinline__ void stage_rc(int b, int& R, int& C) { const int st = b / 1024, sb = b % 1024, swz = sb ^ (((sb >> 9) & 1) << 5); R = (st >> 1) * 16 + swz / 64; C = (st & 1) * 32 + (swz % 64) / 2; }
__host__ __device__ __forceinline__ int perm32(int rho) { const int n = rho >> 4, i = rho & 15; return 8 * (i >> 2) + 4 * n + (i & 3); }

struct Unit { int pm, pn, sec; };
struct Gemm { const bf16_t* A; const bf16_t* Bt; int M, N, K; const bf16_t* A2; const bf16_t* Bt2; };

struct StaticOrder {
    int nM, nN, nwg, G, c;
    __host__ __device__ void init(int M, int N, int G_, int c_) { nM = M / BM; nN = N / BM; nwg = nM * nN; G = G_; c = c_; }
    __host__ __device__ bool next(int i, Unit& u) const {
        const long L = (long)i * G + c; if (L >= nwg) return false;
        int wgid = (int)L; { const int q = nwg / NXCD, r = nwg % NXCD, xcd = wgid % NXCD, off = wgid / NXCD; wgid = (xcd < r ? xcd * (q + 1) : r * (q + 1) + (xcd - r) * q) + off; }
        const int nig = WGM * nN, gid = wgid / nig, fm = gid * WGM, gsz = (nM - fm) < WGM ? (nM - fm) : WGM;
        u.pm = fm + ((wgid % nig) % gsz); u.pn = (wgid % nig) / gsz; u.sec = 0; return true;
    }
    __device__ __forceinline__ void a_ready(const Unit&) const {}
    __device__ __forceinline__ void done(const Unit&) const {}
};
struct PairOrder {
    StaticOrder S;
    __host__ __device__ void init(int M, int N, int G_, int c_) { S.init(M, N, G_, c_); }
    __host__ __device__ bool next(int i, Unit& u) const { if (!S.next(i >> 1, u)) return false; u.sec = i & 1; return true; }
    __device__ __forceinline__ void a_ready(const Unit&) const {}
    __device__ __forceinline__ void done(const Unit&) const {}
};
__device__ __forceinline__ unsigned cvt_pk_bf16(float lo, float hi) { unsigned r; asm volatile("v_cvt_pk_bf16_f32 %0, %1, %2" : "=v"(r) : "v"(lo), "v"(hi)); return r; }
typedef float f32x2 __attribute__((ext_vector_type(2)));
typedef unsigned u32x4e __attribute__((ext_vector_type(4)));
constexpr size_t BUFE = (size_t)49152 * 1024;
__device__ __forceinline__ float bf2f(unsigned short v) { return __uint_as_float(((unsigned)v) << 16); }
__device__ __forceinline__ float sigm(float x) { return __builtin_amdgcn_rcpf(1.0f + __builtin_amdgcn_exp2f(-1.4426950408889634f * x)); }

struct EpiProj { static constexpr bool PERM = true, AFTER_DRAIN = false;
    bf16_t* big; bf16_t* kb; bf16_t* vb;
    __device__ __forceinline__ void operator()(const f32x4 (&acc)[2][2][4][2], const Unit& u, int wr, int wc, int fr, int fq) const {
        const int pn = u.pn; bf16_t* base; int ldc, colt;
        if (pn < 20) { base = big + (size_t)(pn >> 2) * BUFE; ldc = 1024; colt = (pn & 3) * 256; }
        else if (pn == 20) { base = kb; ldc = 256; colt = 0; }
        else if (pn == 21) { base = vb; ldc = 256; colt = 0; }
        else { const int q = pn - 22; base = big + (size_t)(5 + (q >> 2)) * BUFE; ldc = 1024; colt = (q & 3) * 256; }
        const int row0 = u.pm * BM + wr * 64 + fr, col0 = colt + wc * 32 + 8 * fq;
        const float sc = pn < 4 ? 0.125f * 1.4426950408889634f : 1.0f;
#pragma unroll
        for (int ai = 0; ai < 2; ++ai)
#pragma unroll
            for (int m = 0; m < 4; ++m) { bf16_t* rowp = base + (size_t)(row0 + ai * HALF + m * 16) * ldc + col0;
#pragma unroll
                for (int bj = 0; bj < 2; ++bj) { const f32x4 v0 = acc[ai][bj][m][0] * sc, v1 = acc[ai][bj][m][1] * sc;
                    u32x4 w; w.x = cvt_pk_bf16(v0[0], v0[1]); w.y = cvt_pk_bf16(v0[2], v0[3]); w.z = cvt_pk_bf16(v1[0], v1[1]); w.w = cvt_pk_bf16(v1[2], v1[3]);
                    *(u32x4*)(rowp + bj * HALF) = w; } }
    }
};
__device__ __forceinline__ float en2(unsigned hbits) { return __builtin_amdgcn_exp2f(-1.4426950408889634f * __uint_as_float(hbits)); }
struct EpiPair { static constexpr bool PERM = true, AFTER_DRAIN = false;
    const bf16_t* ga; const bf16_t* gb; bf16_t* merged;
    __device__ __forceinline__ void operator()(f32x4 (&acc)[2][2][4][2], const Unit& u, int wr, int wc, int fr, int fq) const {
        const int row0 = u.pm * BM + wr * 64 + fr, col0 = u.pn * BM + wc * 32 + 8 * fq;
        if (u.sec == 0) {
#pragma unroll
            for (int ai = 0; ai < 2; ++ai)
#pragma unroll
                for (int m = 0; m < 4; ++m) { const size_t off = (size_t)(row0 + ai * HALF + m * 16) * 1024 + col0;
#pragma unroll
                    for (int bj = 0; bj < 2; ++bj) { const u32x4 av = *(const u32x4*)(ga + off + bj * HALF), bv = *(const u32x4*)(gb + off + bj * HALF);
                        const unsigned aw[4] = {av.x, av.y, av.z, av.w}, bw[4] = {bv.x, bv.y, bv.z, bv.w};
#pragma unroll
                        for (int q = 0; q < 4; ++q) { const int n = q >> 1, e = (q & 1) * 2;
                            const float r0 = (1.0f + en2(bw[q] << 16)) * __builtin_amdgcn_rcpf(1.0f + en2(aw[q] << 16));
                            const float r1 = (1.0f + en2(bw[q] & 0xffff0000u)) * __builtin_amdgcn_rcpf(1.0f + en2(aw[q] & 0xffff0000u));
                            acc[ai][bj][m][n][e] *= r0; acc[ai][bj][m][n][e + 1] *= r1; } } }
        } else {
#pragma unroll
            for (int ai = 0; ai < 2; ++ai)
#pragma unroll
                for (int m = 0; m < 4; ++m) { const size_t off = (size_t)(row0 + ai * HALF + m * 16) * 1024 + col0;
#pragma unroll
                    for (int bj = 0; bj < 2; ++bj) { const u32x4 gv = *(const u32x4*)(gb + off + bj * HALF);
                        const f32x4 v0 = acc[ai][bj][m][0], v1 = acc[ai][bj][m][1];
                        u32x4 w; w.x = cvt_pk_bf16(v0[0] * sigm(__uint_as_float(gv.x << 16)), v0[1] * sigm(__uint_as_float(gv.x & 0xffff0000u)));
                        w.y = cvt_pk_bf16(v0[2] * sigm(__uint_as_float(gv.y << 16)), v0[3] * sigm(__uint_as_float(gv.y & 0xffff0000u)));
                        w.z = cvt_pk_bf16(v1[0] * sigm(__uint_as_float(gv.z << 16)), v1[1] * sigm(__uint_as_float(gv.z & 0xffff0000u)));
                        w.w = cvt_pk_bf16(v1[2] * sigm(__uint_as_float(gv.w << 16)), v1[3] * sigm(__uint_as_float(gv.w & 0xffff0000u)));
                        *(u32x4*)(merged + off + bj * HALF) = w; } }
        }
    }
};
struct EpiOut { static constexpr bool PERM = true, AFTER_DRAIN = false;
    float* out; int base;
    __device__ __forceinline__ void operator()(const f32x4 (&acc)[2][2][4][2], const Unit& u, int wr, int wc, int fr, int fq) const {
        bf16_t* ob = (bf16_t*)(out + ((size_t)base + (size_t)u.pm * BM) * 1024);
        const int row0 = wr * 64 + fr, col0 = u.pn * BM + wc * 32 + 8 * fq;
#pragma unroll
        for (int ai = 0; ai < 2; ++ai)
#pragma unroll
            for (int m = 0; m < 4; ++m) { bf16_t* rowp = ob + (size_t)(row0 + ai * HALF + m * 16) * 2048 + col0;
#pragma unroll
                for (int bj = 0; bj < 2; ++bj) { const f32x4 v0 = acc[ai][bj][m][0], v1 = acc[ai][bj][m][1];
                    u32x4 w; w.x = cvt_pk_bf16(v0[0], v0[1]); w.y = cvt_pk_bf16(v0[2], v0[3]); w.z = cvt_pk_bf16(v1[0], v1[1]); w.w = cvt_pk_bf16(v1[2], v1[3]);
                    *(u32x4*)(rowp + bj * HALF) = w; } }
    }
};
template <class Epi, class Sched, bool ALIGN_EPI = false, bool SP2 = false>
__device__ __forceinline__ void gemm_phase(PG8_LAS unsigned char* lds, const Gemm g, const Sched& S, const Epi& E) {
    int tid_ = threadIdx.x; asm volatile("" : "+v"(tid_));
    const int tid = tid_, wid = __builtin_amdgcn_readfirstlane(tid >> 6), lane = tid & 63, wr = wid >> 2, wc = wid & 3, fr = lane & 15, fq = lane >> 4;
    const int K = g.K, nt = K / BK;
    unsigned voffA[2], voffB[2];
#pragma unroll
    for (int i = 0; i < 2; ++i) { int R, C; stage_rc(tid * 16 + i * 8192, R, C); const int Rb = Epi::PERM ? ((R & ~31) + perm32(R & 31)) : R;
        voffA[i] = (unsigned)(R * K + C) * 2u; voffB[i] = (unsigned)(Rb * K + C) * 2u; }
    const size_t kstep = (size_t)(BK * 2);
    const size_t hstep = (size_t)HALF * K * 2;
    const size_t tstep = 2 * hstep;
    const unsigned ldsw = (unsigned)wid * 1024u;
    const int aoff = lds_byte(wr * 64 + fr, fq * 8), boff = lds_byte(wc * 32 + fr, fq * 8);
#define PG8_SA(b, h) (((b) * 2 + (h)) * HTB)
#define PG8_SB(b, h) ((4 + (b) * 2 + (h)) * HTB)
#define PG8_STAGE(bufoff, gbase, voff) do { _Pragma("unroll") for (int _i = 0; _i < 2; ++_i) \
        __builtin_amdgcn_global_load_lds((const unsigned*)((const char*)(gbase) + (voff)[_i]), (PG8_LAS unsigned*)(lds + (bufoff) + ldsw + _i * 8192), 16, 0, 0); } while (0)
#define PG8_LDA(dst, b, h) do { _Pragma("unroll") for (int m = 0; m < 4; ++m) _Pragma("unroll") for (int k = 0; k < 2; ++k) dst[m][k] = *(const PG8_LAS bf16x8*)(lds + PG8_SA(b, h) + aoff + m * 2048 + k * 1024); } while (0)
#define PG8_LDB(dst, b, h) do { _Pragma("unroll") for (int n = 0; n < 2; ++n) _Pragma("unroll") for (int k = 0; k < 2; ++k) dst[n][k] = *(const PG8_LAS bf16x8*)(lds + PG8_SB(b, h) + boff + n * 2048 + k * 1024); } while (0)
#define PG8_MMA(ai, bj, At, Bt) do { __builtin_amdgcn_s_setprio(1); _Pragma("unroll") for (int m = 0; m < 4; ++m) _Pragma("unroll") for (int n = 0; n < 2; ++n) _Pragma("unroll") for (int k = 0; k < 2; ++k) \
        acc[ai][bj][m][n] = __builtin_amdgcn_mfma_f32_16x16x32_bf16(Bt[n][k], At[m][k], acc[ai][bj][m][n], 0, 0, 0); __builtin_amdgcn_s_setprio(0); } while (0)
#define PG8_WAIT_V(n) asm volatile("s_waitcnt vmcnt(" #n ")" ::: "memory")
#define PG8_WAIT_L(n) asm volatile("s_waitcnt lgkmcnt(" #n ")" ::: "memory")
#define PG8_BAR __builtin_amdgcn_s_barrier()
#define PG8_SCHED __builtin_amdgcn_sched_barrier(0)
    Unit cur, nxt; int ui = 0;
    if (!S.next(0, cur)) return;
    f32x4 acc[2][2][4][2];
#pragma unroll
    for (int a = 0; a < 2; ++a)
#pragma unroll
        for (int b = 0; b < 2; ++b)
#pragma unroll
            for (int m = 0; m < 4; ++m)
#pragma unroll
                for (int n = 0; n < 2; ++n) acc[a][b][m][n] = (f32x4){0.f, 0.f, 0.f, 0.f};
    bf16x8 At[4][2], B0[2][2], B1[2][2];
    const char* cA = (const char*)(cur.sec ? g.A2 : g.A) + (size_t)cur.pm * tstep; const char* cB = (const char*)(cur.sec ? g.Bt2 : g.Bt) + (size_t)cur.pn * tstep;
    S.a_ready(cur);
    if constexpr (SP2) {
        PG8_STAGE(PG8_SB(0, 0), cB, voffB); PG8_STAGE(PG8_SB(0, 1), cB + hstep, voffB); PG8_STAGE(PG8_SA(0, 0), cA, voffA); PG8_STAGE(PG8_SA(0, 1), cA + hstep, voffA);
        if (wr == 1) PG8_BAR;
        PG8_WAIT_V(2); PG8_BAR;
        PG8_STAGE(PG8_SB(1, 0), cB + kstep, voffB); PG8_STAGE(PG8_SA(1, 0), cA + kstep, voffA); PG8_STAGE(PG8_SB(1, 1), cB + hstep + kstep, voffB);
        PG8_WAIT_V(6); PG8_BAR;
    } else {
        PG8_STAGE(PG8_SB(0, 0), cB, voffB); PG8_STAGE(PG8_SA(0, 0), cA, voffA); PG8_STAGE(PG8_SB(0, 1), cB + hstep, voffB); PG8_STAGE(PG8_SA(0, 1), cA + hstep, voffA);
        if (wr == 1) PG8_BAR;
        PG8_WAIT_V(4); PG8_BAR;
        PG8_STAGE(PG8_SB(1, 0), cB + kstep, voffB); PG8_STAGE(PG8_SA(1, 0), cA + kstep, voffA); PG8_STAGE(PG8_SB(1, 1), cB + hstep + kstep, voffB);
        PG8_WAIT_V(6); PG8_BAR;
    }
    for (;;) {
        const bool has_next = S.next(ui + 1, nxt);
        const char* nA = has_next ? (const char*)(nxt.sec ? g.A2 : g.A) + (size_t)nxt.pm * tstep : cA; const char* nB = has_next ? (const char*)(nxt.sec ? g.Bt2 : g.Bt) + (size_t)nxt.pn * tstep : cB;
        for (int t = 0; t < nt; t += 2) {
            const bool last = (t == nt - 2);
            const char* a1 = cA + (size_t)(t + 1) * kstep;
            const char* a2 = last ? nA : cA + (size_t)(t + 2) * kstep; const char* b2 = last ? nB : cB + (size_t)(t + 2) * kstep;
            const char* a3 = a2 + kstep; const char* b3 = b2 + kstep;
            if (last && has_next) S.a_ready(nxt);
            if constexpr (SP2) {
            PG8_LDB(B0, 0, 0); PG8_LDB(B1, 0, 1); PG8_SCHED; PG8_LDA(At, 0, 0); PG8_STAGE(PG8_SA(1, 1), a1 + hstep, voffA);
            PG8_WAIT_V(8); PG8_WAIT_L(0); PG8_BAR; PG8_MMA(0, 0, At, B0); PG8_MMA(0, 1, At, B1); PG8_BAR; PG8_SCHED;
            PG8_LDA(At, 0, 1); PG8_STAGE(PG8_SB(0, 0), b2, voffB); PG8_STAGE(PG8_SB(0, 1), b2 + hstep, voffB); PG8_STAGE(PG8_SA(0, 0), a2, voffA);
            PG8_WAIT_V(8); PG8_WAIT_L(0); PG8_BAR; PG8_MMA(1, 0, At, B0); PG8_MMA(1, 1, At, B1); PG8_BAR; PG8_SCHED;
            PG8_LDB(B0, 1, 0); PG8_LDB(B1, 1, 1); PG8_SCHED; PG8_LDA(At, 1, 0); PG8_STAGE(PG8_SA(0, 1), a2 + hstep, voffA);
            PG8_WAIT_V(8); PG8_WAIT_L(0); PG8_BAR; PG8_MMA(0, 0, At, B0); PG8_MMA(0, 1, At, B1); PG8_BAR; PG8_SCHED;
            PG8_LDA(At, 1, 1); PG8_STAGE(PG8_SB(1, 0), b3, voffB); PG8_STAGE(PG8_SB(1, 1), b3 + hstep, voffB); PG8_STAGE(PG8_SA(1, 0), a3, voffA);
            PG8_WAIT_V(8); PG8_WAIT_L(0); PG8_BAR; PG8_MMA(1, 0, At, B0); PG8_MMA(1, 1, At, B1); PG8_BAR; PG8_SCHED;
            } else {
            PG8_LDB(B0, 0, 0); PG8_SCHED; PG8_LDA(At, 0, 0); PG8_STAGE(PG8_SA(1, 1), a1 + hstep, voffA);
            PG8_WAIT_L(8); PG8_BAR; PG8_WAIT_L(0); PG8_MMA(0, 0, At, B0); PG8_BAR; PG8_SCHED;
            PG8_LDB(B1, 0, 1); PG8_STAGE(PG8_SB(0, 0), b2, voffB);
            PG8_BAR; PG8_WAIT_L(0); PG8_MMA(0, 1, At, B1); PG8_BAR;
            PG8_LDA(At, 0, 1); PG8_STAGE(PG8_SA(0, 0), a2, voffA);
            PG8_BAR; PG8_WAIT_L(0); PG8_MMA(1, 0, At, B0); PG8_BAR; PG8_SCHED;
            PG8_STAGE(PG8_SB(0, 1), b2 + hstep, voffB);
            PG8_WAIT_V(6); PG8_BAR; PG8_MMA(1, 1, At, B1); PG8_BAR;
            PG8_LDB(B0, 1, 0); PG8_SCHED; PG8_LDA(At, 1, 0); PG8_STAGE(PG8_SA(0, 1), a2 + hstep, voffA);
            PG8_WAIT_L(8); PG8_BAR; PG8_WAIT_L(0); PG8_MMA(0, 0, At, B0); PG8_BAR; PG8_SCHED;
            PG8_LDB(B1, 1, 1); PG8_STAGE(PG8_SB(1, 0), b3, voffB);
            PG8_BAR; PG8_WAIT_L(0); PG8_MMA(0, 1, At, B1); PG8_BAR;
            PG8_LDA(At, 1, 1); PG8_STAGE(PG8_SA(1, 0), a3, voffA);
            PG8_BAR; PG8_WAIT_L(0); PG8_MMA(1, 0, At, B0); PG8_BAR; PG8_SCHED;
            PG8_STAGE(PG8_SB(1, 1), b3 + hstep, voffB);
            PG8_WAIT_V(6); PG8_BAR; PG8_MMA(1, 1, At, B1); PG8_BAR;
            }
        }
        if constexpr (ALIGN_EPI) { if (wr == 0) PG8_BAR; }
        if constexpr (!Epi::AFTER_DRAIN) { E(acc, cur, wr, wc, fr, fq); S.done(cur); }
        if (!has_next) break;
        if (!nxt.sec)
#pragma unroll
        for (int a = 0; a < 2; ++a)
#pragma unroll
            for (int b = 0; b < 2; ++b)
#pragma unroll
                for (int m = 0; m < 4; ++m)
#pragma unroll
                    for (int n = 0; n < 2; ++n) acc[a][b][m][n] = (f32x4){0.f, 0.f, 0.f, 0.f};
        cur = nxt; cA = nA; cB = nB; ++ui;
        if constexpr (ALIGN_EPI) { if (wr == 1) PG8_BAR; }
    }
    PG8_WAIT_V(0);
    if constexpr (!ALIGN_EPI) { if (wr == 0) PG8_BAR; }
    PG8_BAR;
    if constexpr (Epi::AFTER_DRAIN) { E.fused(acc, cur, wr, wc, fr, fq, lds, wid, lane); S.done(cur); }
#undef PG8_SA
#undef PG8_SB
#undef PG8_STAGE
#undef PG8_LDA
#undef PG8_LDB
#undef PG8_MMA
#undef PG8_WAIT_V
#undef PG8_WAIT_L
#undef PG8_BAR
#undef PG8_SCHED
}
}
namespace att {
typedef unsigned short bf16_t;
using bf16x8 = __attribute__((ext_vector_type(8))) short;
using s16x4  = __attribute__((ext_vector_type(4))) short;
using f32x16 = __attribute__((ext_vector_type(16))) float;
using f32x4  = __attribute__((ext_vector_type(4))) float;
using f32x2  = __attribute__((ext_vector_type(2))) float;
using u32x4  = __attribute__((ext_vector_type(4))) unsigned;
constexpr int NW = 8, QBLK = 32, KVBLK = 64;
constexpr int SHM_V = 16384, SHM_K = 16384;
constexpr int LDS_WSOFF = 3 * SHM_V + 4 * SHM_K;
constexpr int LDS_TB = LDS_WSOFF + NW * 64 * 4;
constexpr int ATT_LDS = LDS_TB + 2048;
constexpr float THR = 8.f;
#define KSWZ128(row, colB) ((row) * 256 + ((colB) ^ (((row) & 7) << 4)))
#define KSWZ64(row, colB)  ((row) * 128 + ((colB) ^ ((((row) >> 1) & 7) << 4)))
#define SBAR() __builtin_amdgcn_sched_barrier(0)
__device__ __forceinline__ int crow(int r, int hi) { return (r & 3) + 8 * (r >> 2) + 4 * hi; }
__device__ __forceinline__ unsigned cvtpk(float lo, float hi) { unsigned r; asm volatile("v_cvt_pk_bf16_f32 %0, %1, %2" : "=v"(r) : "v"(lo), "v"(hi)); return r; }
__device__ __forceinline__ bf16x8 ld8(const bf16_t* p) { return *reinterpret_cast<const bf16x8*>(p); }
__device__ __forceinline__ float bf2f(short v) { return __uint_as_float(((unsigned)(unsigned short)v) << 16); }

constexpr float THR2 = THR * 1.4426950408889634f;
template <int DK>
__device__ __forceinline__ void partialSM(f32x16& p0, f32x16& p1, float& m_reg, float& mn, float& alpha, const float cb) {
  float pmax = p0[0];
#pragma unroll
  for (int r = 1; r < 16; ++r) pmax = fmaxf(pmax, p0[r]);
#pragma unroll
  for (int r = 0; r < 16; ++r) pmax = fmaxf(pmax, p1[r]);
  { auto rr = __builtin_amdgcn_permlane32_swap(__float_as_uint(pmax), __float_as_uint(pmax), false, false);
    pmax = fmaxf(__uint_as_float(rr[0]), __uint_as_float(rr[1])); }
  pmax += cb;
  if (__builtin_expect(__all(pmax - m_reg <= THR2), 1)) { mn = m_reg; alpha = 1.f; }
  else { mn = fmaxf(m_reg, pmax); alpha = __builtin_amdgcn_exp2f(m_reg - mn); m_reg = mn; }
  const float mnC = cb - mn;
#pragma unroll
  for (int r = 0; r < 16; ++r) p0[r] += mnC;
#pragma unroll
  for (int r = 0; r < 16; ++r) p1[r] += mnC;
#pragma unroll
  for (int r = 0; r < 16; ++r) p0[r] = __builtin_amdgcn_exp2f(p0[r]);
}
template <bool NOEXP>
__device__ __forceinline__ void finishSM(f32x16& p0, f32x16& p1, float alpha, float& l_reg, bf16x8& pa0, bf16x8& pa1, bf16x8& pa2, bf16x8& pa3) {
  if constexpr (!NOEXP) {
#pragma unroll
  for (int r = 0; r < 16; ++r) p1[r] = __builtin_amdgcn_exp2f(p1[r]); }
  float ps = 0;
#pragma unroll
  for (int r = 0; r < 16; ++r) ps += p0[r];
#pragma unroll
  for (int r = 0; r < 16; ++r) ps += p1[r];
  { auto rr = __builtin_amdgcn_permlane32_swap(__float_as_uint(ps), __float_as_uint(ps), false, false);
    ps = __uint_as_float(rr[0]) + __uint_as_float(rr[1]); }
  l_reg = l_reg * alpha + ps;
#define PK4(P, BASE, OUT) do { unsigned a0 = cvtpk(P[BASE + 0], P[BASE + 1]), a1 = cvtpk(P[BASE + 2], P[BASE + 3]);   \
    unsigned b0 = cvtpk(P[BASE + 4], P[BASE + 5]), b1 = cvtpk(P[BASE + 6], P[BASE + 7]);                              \
    auto r0 = __builtin_amdgcn_permlane32_swap(a0, b0, false, false); auto r1 = __builtin_amdgcn_permlane32_swap(a1, b1, false, false); \
    u32x4 w = {r0[0], r1[0], r0[1], r1[1]}; OUT = *reinterpret_cast<bf16x8*>(&w); } while (0)
  PK4(p0, 0, pa0); PK4(p0, 8, pa1); PK4(p1, 0, pa2); PK4(p1, 8, pa3);
#undef PK4
}
__device__ __forceinline__ void add_bias(f32x16& p0, f32x16& p1, const float* tb, int relb, int hi) {
  const float* t = tb + relb + 4 * hi;
#pragma unroll
  for (int r = 0; r < 16; ++r) { p0[r] += t[(r & 3) + 8 * (r >> 2)]; p1[r] += t[32 + (r & 3) + 8 * (r >> 2)]; }
}
template <int DK>
__device__ __forceinline__ void qkt(f32x16& p0, f32x16& p1, const char* Ks, const bf16x8* qr, int r32, int hi) {
  p0 = f32x16{}; p1 = f32x16{};
#pragma unroll
  for (int d0 = 0; d0 < DK / 16; ++d0) { const int cb = (d0 * 16 + hi * 8) * 2;
    bf16x8 b0, b1;
    if constexpr (DK == 128) { b0 = *reinterpret_cast<const bf16x8*>(Ks + KSWZ128(r32, cb)); b1 = *reinterpret_cast<const bf16x8*>(Ks + KSWZ128(32 + r32, cb)); }
    else { b0 = *reinterpret_cast<const bf16x8*>(Ks + KSWZ64(r32, cb)); b1 = *reinterpret_cast<const bf16x8*>(Ks + KSWZ64(32 + r32, cb)); }
    p0 = __builtin_amdgcn_mfma_f32_32x32x16_bf16(b0, qr[d0], p0, 0, 0, 0);
    p1 = __builtin_amdgcn_mfma_f32_32x32x16_bf16(b1, qr[d0], p1, 0, 0, 0); }
}
__device__ __forceinline__ int v_st(int k, int c) { const int kk = (k & ~0xC) | ((k & 4) << 1) | ((k & 8) >> 1); return ((kk >> 3) * 4 + (c >> 5)) * 512 + ((kk & 7) * 32 + (c & 31)) * 2; }
__device__ __forceinline__ int v_rd_base(int lane) { return ((lane & 3) << 3) | (((lane >> 2) & 3) << 6) | (((lane >> 4) & 1) << 5) | (((lane >> 5) & 1) << 8); }
constexpr int v_rd_off(int d0, int ks, int half) { return d0 * 512 + ks * 4096 + half * 2048; }
template <int OFF> __device__ __forceinline__ s16x4 tr_read(int vb) {
  s16x4 r; asm volatile("ds_read_b64_tr_b16 %0, %1 offset:%2" : "=&v"(r) : "v"(vb), "i"(OFF) : "memory"); return r;
}
template <int D0> __device__ __forceinline__ void pv_one(f32x16& od, int vb, bf16x8 pa0, bf16x8 pa1, bf16x8 pa2, bf16x8 pa3) {
  const s16x4 l0 = tr_read<v_rd_off(D0, 0, 0)>(vb), h0 = tr_read<v_rd_off(D0, 0, 1)>(vb), l1 = tr_read<v_rd_off(D0, 1, 0)>(vb), h1 = tr_read<v_rd_off(D0, 1, 1)>(vb);
  const s16x4 l2 = tr_read<v_rd_off(D0, 2, 0)>(vb), h2 = tr_read<v_rd_off(D0, 2, 1)>(vb), l3 = tr_read<v_rd_off(D0, 3, 0)>(vb), h3 = tr_read<v_rd_off(D0, 3, 1)>(vb);
  asm volatile("s_waitcnt lgkmcnt(0)" ::: "memory"); SBAR();
#define PK(L, H) (bf16x8){L[0], L[1], L[2], L[3], H[0], H[1], H[2], H[3]}
  od = __builtin_amdgcn_mfma_f32_32x32x16_bf16(pa0, PK(l0, h0), od, 0, 0, 0);
  od = __builtin_amdgcn_mfma_f32_32x32x16_bf16(pa1, PK(l1, h1), od, 0, 0, 0);
  od = __builtin_amdgcn_mfma_f32_32x32x16_bf16(pa2, PK(l2, h2), od, 0, 0, 0);
  od = __builtin_amdgcn_mfma_f32_32x32x16_bf16(pa3, PK(l3, h3), od, 0, 0, 0);
#undef PK
}
__device__ __forceinline__ void pv_d0(f32x16* o, int vb, bf16x8 pa0, bf16x8 pa1, bf16x8 pa2, bf16x8 pa3) {
  pv_one<0>(o[0], vb, pa0, pa1, pa2, pa3); pv_one<1>(o[1], vb, pa0, pa1, pa2, pa3); pv_one<2>(o[2], vb, pa0, pa1, pa2, pa3); pv_one<3>(o[3], vb, pa0, pa1, pa2, pa3);
}

typedef __attribute__((address_space(3))) const char* lds_cptr;
typedef short v4i16_t __attribute__((ext_vector_type(4)));
__device__ __forceinline__ s16x4 vtr(lds_cptr p) { return __builtin_bit_cast(s16x4, __builtin_amdgcn_ds_read_tr16_b64_v4i16((__attribute__((address_space(3))) v4i16_t*)p)); }
__device__ __forceinline__ float max3f(float a, float b, float c) { return fmaxf(fmaxf(a, b), c); }
#define PIN(x) asm volatile("" : "+v"(x))
#define PK4R(P, BASE, OUT) do { unsigned a0 = cvtpk(P[BASE + 0], P[BASE + 1]), a1 = cvtpk(P[BASE + 2], P[BASE + 3]);   \
    unsigned b0 = cvtpk(P[BASE + 4], P[BASE + 5]), b1 = cvtpk(P[BASE + 6], P[BASE + 7]);                              \
    auto r0 = __builtin_amdgcn_permlane32_swap(a0, b0, false, false); auto r1 = __builtin_amdgcn_permlane32_swap(a1, b1, false, false); \
    u32x4 w = {r0[0], r1[0], r0[1], r1[1]}; OUT = *reinterpret_cast<bf16x8*>(&w); } while (0)
template <int DK, bool NOMAX>
__device__ __forceinline__ void qk_fs(f32x16& c0, f32x16& c1, const char* Ks, const bf16x8* qr, const int r32, const int hi,
                                      f32x16& p0, f32x16& p1, const float alpha, float& l_reg, bf16x8* pa,
                                      bf16x8 (&kf)[2][2], const lds_cptr vp, s16x4 (&vl)[3], s16x4 (&vh)[3]) {
  constexpr int NS = DK / 16, RPS = 16 / NS;
#define KRD_(S, D0) do { const int cb_ = ((D0) * 16 + hi * 8) * 2; \
    if constexpr (DK == 128) { kf[S][0] = *reinterpret_cast<const bf16x8*>(Ks + KSWZ128(r32, cb_)); kf[S][1] = *reinterpret_cast<const bf16x8*>(Ks + KSWZ128(32 + r32, cb_)); } \
    else { kf[S][0] = *reinterpret_cast<const bf16x8*>(Ks + KSWZ64(r32, cb_)); kf[S][1] = *reinterpret_cast<const bf16x8*>(Ks + KSWZ64(32 + r32, cb_)); } } while (0)
  float psa = 0.f, psb = 0.f;
  SBAR();
#pragma unroll
  for (int d0 = 0; d0 < NS; ++d0) {
    if (d0 == 0) { c0 = __builtin_amdgcn_mfma_f32_32x32x16_bf16(kf[0][0], qr[0], f32x16{}, 0, 0, 0); c1 = __builtin_amdgcn_mfma_f32_32x32x16_bf16(kf[0][1], qr[0], f32x16{}, 0, 0, 0); }
    else { c0 = __builtin_amdgcn_mfma_f32_32x32x16_bf16(kf[d0 & 1][0], qr[d0], c0, 0, 0, 0); c1 = __builtin_amdgcn_mfma_f32_32x32x16_bf16(kf[d0 & 1][1], qr[d0], c1, 0, 0, 0); }
    if (d0 + 2 < NS) KRD_(d0 & 1, d0 + 2);
    if constexpr (NOMAX) { }
    else {
#pragma unroll
    for (int r = d0 * RPS; r < (d0 + 1) * RPS; ++r) { p1[r] = __builtin_amdgcn_exp2f(p1[r]); psa += p0[r]; }
    if (d0 > 0) {
#pragma unroll
      for (int r = (d0 - 1) * RPS; r < d0 * RPS; ++r) psb += p1[r]; } }
    if constexpr (NOMAX) {
      if (d0 == NS / 4 - 1) { PK4R(p0, 0, pa[0]); PIN(pa[0]); }
      if (d0 == NS / 2 - 1) { PK4R(p0, 8, pa[1]); PIN(pa[1]); }
      if (d0 == 3 * NS / 4 - 1) { PK4R(p1, 0, pa[2]); PIN(pa[2]); }
      if (d0 == NS - 1) { PK4R(p1, 8, pa[3]); PIN(pa[3]); }
    } else {
    if (d0 == NS / 2 - 1) { PK4R(p0, 0, pa[0]); PIN(pa[0]); }
    if (d0 == NS / 2) { PK4R(p0, 8, pa[1]); PIN(pa[1]); }
    if (d0 == NS - 1) { PK4R(p1, 0, pa[2]); PIN(pa[2]); }
    }
    if (d0 == NS - 1) {
      vl[0] = vtr(vp + v_rd_off(0, 0, 0)); vh[0] = vtr(vp + v_rd_off(0, 0, 1)); vl[1] = vtr(vp + v_rd_off(1, 0, 0)); vh[1] = vtr(vp + v_rd_off(1, 0, 1)); }
    PIN(p1); PIN(psa); PIN(psb);
    SBAR();
  }
#undef KRD_
  if constexpr (!NOMAX) {
#pragma unroll
  for (int r = (NS - 1) * RPS; r < 16; ++r) psb += p1[r];
  float ps = psa + psb;
  { auto rr = __builtin_amdgcn_permlane32_swap(__float_as_uint(ps), __float_as_uint(ps), false, false);
    ps = __uint_as_float(rr[0]) + __uint_as_float(rr[1]); }
  l_reg = l_reg * alpha + ps;
  PK4R(p1, 8, pa[3]); }
}
template <int DK, bool NOMAX>
__device__ __forceinline__ void pv_psm(f32x16* o, const lds_cptr vp, const bf16x8* pa, f32x16& c0, f32x16& c1, float& m_reg, float& alpha, const float cb,
                                       s16x4 (&vl)[3], s16x4 (&vh)[3], bf16x8 (&kf)[2][2], const char* Kn, const int r32, const int hi, float& l_reg,
                                       const bool dk, const bool dv, const bf16_t* gk0, const bf16_t* gk1, const bf16_t* gv0, const bf16_t* gv1,
                                       __attribute__((address_space(3))) unsigned* lk, __attribute__((address_space(3))) unsigned* lv) {
  typedef __attribute__((address_space(3))) unsigned* lds_up; typedef __attribute__((address_space(3))) char* lds_cp;
  float psa = 0.f, psb = 0.f;
#define VRD_(S, I) do { vl[S] = vtr(vp + v_rd_off((I) & 3, (I) >> 2, 0)); vh[S] = vtr(vp + v_rd_off((I) & 3, (I) >> 2, 1)); } while (0)
#define VFR_(S) (bf16x8){vl[S][0], vl[S][1], vl[S][2], vl[S][3], vh[S][0], vh[S][1], vh[S][2], vh[S][3]}
  float ma = 0.f, mb = 0.f, mnC = 0.f;
  SBAR();
#pragma unroll
  for (int i = 0; i < 16; ++i) {
    if (i + 2 < 16) VRD_((i + 2) % 3, i + 2);
    if (i == 1) { if (dk) __builtin_amdgcn_global_load_lds((const unsigned*)gk0, lk, 16, 0, 0); }
    if (i == 3) { if constexpr (DK == 128) { if (dk) __builtin_amdgcn_global_load_lds((const unsigned*)gk1, (lds_up)((lds_cp)lk + 8192), 16, 0, 0); } }
    if (i == 5) { if (dv) __builtin_amdgcn_global_load_lds((const unsigned*)gv0, lv, 16, 0, 0); }
    if (i == 7) { if (dv) __builtin_amdgcn_global_load_lds((const unsigned*)gv1, (lds_up)((lds_cp)lv + 8192), 16, 0, 0); }
    if (i == 12 || i == 13) { const int cb_ = ((i - 12) * 16 + hi * 8) * 2;
      if constexpr (DK == 128) { kf[i - 12][0] = *reinterpret_cast<const bf16x8*>(Kn + KSWZ128(r32, cb_)); kf[i - 12][1] = *reinterpret_cast<const bf16x8*>(Kn + KSWZ128(32 + r32, cb_)); }
      else { kf[i - 12][0] = *reinterpret_cast<const bf16x8*>(Kn + KSWZ64(r32, cb_)); kf[i - 12][1] = *reinterpret_cast<const bf16x8*>(Kn + KSWZ64(32 + r32, cb_)); } }
    SBAR();
    o[i & 3] = __builtin_amdgcn_mfma_f32_32x32x16_bf16(pa[i >> 2], VFR_(i % 3), o[i & 3], 0, 0, 0);
    if constexpr (NOMAX) { c0[i] = __builtin_amdgcn_exp2f(c0[i]); c1[i] = __builtin_amdgcn_exp2f(c1[i]); if (i > 0) { psa += c0[i - 1]; psb += c1[i - 1]; } PIN(c0); PIN(c1); PIN(psa); PIN(psb); }
    else {
    if (i == 0) { ma = max3f(c0[0], c0[1], c1[0]); mb = max3f(c0[2], c0[3], c1[1]); ma = max3f(ma, c1[2], c1[3]); }
    if (i >= 1 && i <= 3) { const int r = 4 * i; ma = max3f(ma, c0[r], c0[r + 1]); mb = max3f(mb, c0[r + 2], c0[r + 3]); ma = max3f(ma, c1[r], c1[r + 1]); mb = max3f(mb, c1[r + 2], c1[r + 3]); }
    if (i == 4) { float pmax = fmaxf(ma, mb);
      { auto rr = __builtin_amdgcn_permlane32_swap(__float_as_uint(pmax), __float_as_uint(pmax), false, false);
        pmax = fmaxf(__uint_as_float(rr[0]), __uint_as_float(rr[1])); }
      pmax += cb;
      const bool keep = __all(pmax - m_reg <= THR2);
      const float mn = keep ? m_reg : fmaxf(m_reg, pmax);
      alpha = __builtin_amdgcn_exp2f(m_reg - mn); m_reg = mn; mnC = cb - mn; }
    if (i >= 5 && i <= 8) { const int r = 4 * (i - 5);
#pragma unroll
      for (int q = 0; q < 4; ++q) { c0[r + q] += mnC; c1[r + q] += mnC; } }
    if (i >= 9) { const int r0 = (i - 9) * 2 + (i > 14 ? 1 : 0), n = i >= 14 ? 3 : 2;
#pragma unroll
      for (int q = 0; q < n; ++q) c0[r0 + q] = __builtin_amdgcn_exp2f(c0[r0 + q]); }
    if (i <= 3) { PIN(ma); PIN(mb); }
    if (i == 4) { PIN(mnC); PIN(alpha); PIN(m_reg); }
    if (i >= 5 && i <= 8) { PIN(c0); PIN(c1); }
    if (i >= 9) PIN(c0);
    }
    SBAR();
  }
#undef VRD_
#undef VFR_
  if constexpr (NOMAX) { float ps = (psa + c0[15]) + (psb + c1[15]);
    { auto rr = __builtin_amdgcn_permlane32_swap(__float_as_uint(ps), __float_as_uint(ps), false, false);
      ps = __uint_as_float(rr[0]) + __uint_as_float(rr[1]); }
    l_reg = l_reg * alpha + ps; }
}

constexpr int RING_K = 0, RING_V = 4 * SHM_K;
template <int DK, int LDK, bool BIAS, bool NOMAX>
__device__ __forceinline__ void flash_pass(const bf16x8* qr, const bf16_t* __restrict__ Kh, const bf16_t* __restrict__ Vh, const int seq, char* lds,
                                           f32x16* o, float& l_out, const int qlo, const float b_neg, const float b_pos) {
  int tid_ = threadIdx.x; asm volatile("" : "+v"(tid_));
  const int tid = tid_, lane = tid & 63, r32 = lane & 31, hi = lane >> 5; const int wid = __builtin_amdgcn_readfirstlane(tid >> 6);
  typedef __attribute__((address_space(3))) unsigned* lds_uptr;
  char* K_lds = lds + RING_K; char* V_lds = lds + RING_V;
  float* ws = (float*)(lds + LDS_WSOFF) + wid * 64; float* al_l = ws + 32;
  const float* tb = (const float*)(lds + LDS_TB);
  float m_reg = -1e30f, l_reg = 0.f;
  o[0] = f32x16{}; o[1] = f32x16{}; o[2] = f32x16{}; o[3] = f32x16{};
  int koff0, koff1 = 0, voff0, voff1;
  if constexpr (DK == 128) { { const int r = 4 * wid + (lane >> 4), c = (lane & 15) ^ (r & 7); koff0 = r * LDK + c * 8; }
                             { const int r = 4 * (wid + 8) + (lane >> 4), c = (lane & 15) ^ (r & 7); koff1 = r * LDK + c * 8; } }
  else { const int r = 8 * wid + (lane >> 3), c = (lane & 7) ^ ((r >> 1) & 7); koff0 = r * LDK + c * 8; }
  { const int st = 2 * wid + (lane >> 5), kk = (st >> 2) * 8 + ((lane & 31) >> 2), k = (kk & ~0xC) | ((kk & 4) << 1) | ((kk & 8) >> 1); voff0 = k * LDK + (st & 3) * 32 + (lane & 3) * 8; }
  { const int st = 2 * (wid + 8) + (lane >> 5), kk = (st >> 2) * 8 + ((lane & 31) >> 2), k = (kk & ~0xC) | ((kk & 4) << 1) | ((kk & 8) >> 1); voff1 = k * LDK + (st & 3) * 32 + (lane & 3) * 8; }
  const bf16_t* ks0 = Kh + koff0; const bf16_t* ks1 = Kh + koff1; const bf16_t* vs0 = Vh + voff0; const bf16_t* vs1 = Vh + voff1;
  const lds_uptr kdst = (lds_uptr)(K_lds + wid * 1024), vdst = (lds_uptr)(V_lds + wid * 1024);
#define GLDS(G, L) __builtin_amdgcn_global_load_lds((const unsigned*)(G), (L), 16, 0, 0)
#define DMA_K(T, SL) do { const long t_ = (long)(T) * (KVBLK * LDK); GLDS(ks0 + t_, (lds_uptr)((__attribute__((address_space(3))) char*)kdst + (SL))); \
    if constexpr (DK == 128) GLDS(ks1 + t_, (lds_uptr)((__attribute__((address_space(3))) char*)kdst + (SL) + 8192)); } while (0)
#define DMA_V(T, SL) do { const long t_ = (long)(T) * (KVBLK * LDK); GLDS(vs0 + t_, (lds_uptr)((__attribute__((address_space(3))) char*)vdst + (SL))); \
    GLDS(vs1 + t_, (lds_uptr)((__attribute__((address_space(3))) char*)vdst + (SL) + 8192)); } while (0)
#define WBAR(N) asm volatile("s_waitcnt vmcnt(" #N ") lgkmcnt(0)\n\ts_barrier" ::: "memory")
#define RESC(a) do { if (__any((a) != 1.f)) { if (hi == 0) al_l[r32] = (a); asm volatile("s_waitcnt lgkmcnt(0)" ::: "memory"); \
    _Pragma("unroll") for (int d = 0; d < 4; ++d) _Pragma("unroll") for (int r = 0; r < 16; ++r) o[d][r] *= al_l[crow(r, hi)]; } } while (0)
#define PSM(P0, P1, T, MN, AL) do { float cb_ = 0.f; \
    if constexpr (BIAS) { const int k0_ = (T) * KVBLK; const int rmin_ = k0_ - (qlo + 31), rmax_ = k0_ + 63 - qlo; \
      if (rmin_ >= 91) cb_ = b_pos; else if (rmax_ <= -91) cb_ = b_neg; \
      else add_bias(P0, P1, tb, k0_ - (qlo + r32) + 256, hi); } \
    partialSM<DK>(P0, P1, m_reg, MN, AL, cb_); } while (0)
#define TBIAS(P0, P1, T) float cb_ = 0.f; \
    if constexpr (BIAS) { const int k0_ = (T) * KVBLK; const int rmin_ = k0_ - (qlo + 31), rmax_ = k0_ + 63 - qlo; \
      if (rmin_ >= 91) cb_ = b_pos; else if (rmax_ <= -91) cb_ = b_neg; \
      else add_bias(P0, P1, tb, k0_ - (qlo + r32) + 256, hi); }
  float curb = 0.f;
  f32x16 pA0, pA1, pB0, pB1; float mnA, alA, alB; bf16x8 pa[4]; const int NT = seq / KVBLK;
  const lds_cptr vp0 = (lds_cptr)V_lds + v_rd_base(lane);
  const int vb0 = (int)(uintptr_t)V_lds + v_rd_base(lane);
  WBAR(0);
  DMA_K(0, 0); DMA_V(0, 0); DMA_K(1, SHM_K); DMA_K(2, 2 * SHM_K);
  if constexpr (DK == 128) WBAR(6); else WBAR(4);
  qkt<DK>(pA0, pA1, K_lds, qr, r32, hi);
  if constexpr (NOMAX) { TBIAS(pA0, pA1, 0); curb = cb_; alA = 1.f;
#pragma unroll
    for (int r = 0; r < 16; ++r) { pA0[r] = __builtin_amdgcn_exp2f(pA0[r]); pA1[r] = __builtin_amdgcn_exp2f(pA1[r]); }
    float ps0 = 0.f;
#pragma unroll
    for (int r = 0; r < 16; ++r) ps0 += pA0[r] + pA1[r];
    { auto rr = __builtin_amdgcn_permlane32_swap(__float_as_uint(ps0), __float_as_uint(ps0), false, false);
      ps0 = __uint_as_float(rr[0]) + __uint_as_float(rr[1]); }
    l_reg = ps0; }
  else PSM(pA0, pA1, 0, mnA, alA);
  DMA_K(3, 3 * SHM_K); DMA_V(1, SHM_V);
  if constexpr (DK == 128) WBAR(4); else WBAR(3);
  bf16x8 kf[2][2]; s16x4 vl[3], vh[3];
#pragma unroll
  for (int q = 0; q < 2; ++q) { const int cbq = (q * 16 + hi * 8) * 2;
    if constexpr (DK == 128) { kf[q][0] = *reinterpret_cast<const bf16x8*>(K_lds + SHM_K + KSWZ128(r32, cbq)); kf[q][1] = *reinterpret_cast<const bf16x8*>(K_lds + SHM_K + KSWZ128(32 + r32, cbq)); }
    else { kf[q][0] = *reinterpret_cast<const bf16x8*>(K_lds + SHM_K + KSWZ64(r32, cbq)); kf[q][1] = *reinterpret_cast<const bf16x8*>(K_lds + SHM_K + KSWZ64(32 + r32, cbq)); } }
  int sp = 0, sj = SHM_V, sn = 2 * SHM_V;
#define STEPT(C0, C1, P0, P1, ALP, ALC, J) do { \
    qk_fs<DK, NOMAX>(C0, C1, K_lds + ((J) & 3) * SHM_K, qr, r32, hi, P0, P1, ALP, l_reg, pa, kf, vp0 + sp, vl, vh); \
    SBAR(); \
    { TBIAS(C0, C1, J); if constexpr (NOMAX) { ALC = __builtin_amdgcn_exp2f(curb - cb_); curb = cb_; } \
      const long tk_ = (long)((J) + 3) * (KVBLK * LDK), tv_ = (long)((J) + 1) * (KVBLK * LDK); \
      pv_psm<DK, NOMAX>(o, vp0 + sp, pa, C0, C1, m_reg, ALC, cb_, vl, vh, kf, K_lds + (((J) + 1) & 3) * SHM_K, r32, hi, l_reg, \
                        (J) + 3 < NT, (J) + 1 < NT, ks0 + tk_, ks1 + tk_, vs0 + tv_, vs1 + tv_, \
                        (lds_uptr)((__attribute__((address_space(3))) char*)kdst + (((J) + 3) & 3) * SHM_K), (lds_uptr)((__attribute__((address_space(3))) char*)vdst + sn)); } \
    RESC(ALC); \
    if ((J) + 3 < NT) { if constexpr (DK == 128) WBAR(4); else WBAR(3); } else WBAR(0); \
    { const int t_ = sp; sp = sj; sj = sn; sn = t_; } } while (0)
  for (int j = 1; j + 1 < NT; j += 2) {
    STEPT(pB0, pB1, pA0, pA1, alA, alB, j);
    STEPT(pA0, pA1, pB0, pB1, alB, alA, j + 1);
  }
  STEPT(pB0, pB1, pA0, pA1, alA, alB, NT - 1);
  if constexpr (NOMAX) { PK4R(pB0, 0, pa[0]); PK4R(pB0, 8, pa[1]); PK4R(pB1, 0, pa[2]); PK4R(pB1, 8, pa[3]); }
  else finishSM<false>(pB0, pB1, alB, l_reg, pa[0], pa[1], pa[2], pa[3]);
  SBAR();
  pv_d0(o, vb0 + sp, pa[0], pa[1], pa[2], pa[3]);
  l_out = l_reg;
#undef GLDS
#undef DMA_K
#undef DMA_V
#undef WBAR
#undef RESC
#undef PSM
#undef TBIAS
#undef STEPT
}
__device__ __forceinline__ void row_rcp(float l_reg, float* ws, int r32, int hi, float* rli) {
  if (hi == 0) ws[r32] = l_reg; asm volatile("s_waitcnt lgkmcnt(0)" ::: "memory");
#pragma unroll
  for (int r = 0; r < 16; ++r) rli[r] = __builtin_amdgcn_rcpf(ws[crow(r, hi)]);
  asm volatile("s_waitcnt lgkmcnt(0)" ::: "memory");
}
__device__ __forceinline__ float silu(float z) { return z * __builtin_amdgcn_rcpf(1.0f + __builtin_amdgcn_exp2f(-1.4426950408889634f * z)); }
constexpr int STG_LD = 132;
constexpr int STG_WAVE = 32 * STG_LD * 4;
template <bool NORM>
__device__ __forceinline__ void out_rows(const f32x16* o, const float* rli_or_null, char* lds, const float* gain, const float gscale,
                                         const bf16_t* Z, bf16_t* O, const size_t obase  ) {
  int tid_ = threadIdx.x; asm volatile("" : "+v"(tid_));
  const int tid = tid_, wid = tid >> 6, lane = tid & 63, r32 = lane & 31, hi = lane >> 5;
  float* stg = (float*)(lds + wid * STG_WAVE);
  const int c8 = (lane & 15) * 8, rsub = lane >> 4;
  u32x4 zq[8];
#pragma unroll
  for (int it = 0; it < 8; ++it) zq[it] = *(const u32x4*)(Z + obase + (size_t)(it * 4 + rsub) * 1024 + c8);
#pragma unroll
  for (int d0 = 0; d0 < 4; ++d0)
#pragma unroll
    for (int r = 0; r < 16; ++r) stg[crow(r, hi) * STG_LD + d0 * 32 + r32] = rli_or_null ? o[d0][r] * rli_or_null[r] : o[d0][r];
  asm volatile("s_waitcnt lgkmcnt(0)" ::: "memory");
  f32x4 g0 = {1.f, 1.f, 1.f, 1.f}, g1 = {1.f, 1.f, 1.f, 1.f};
  if constexpr (NORM) { g0 = *(const f32x4*)(gain + c8) * gscale; g1 = *(const f32x4*)(gain + c8 + 4) * gscale; }
#pragma unroll
  for (int it = 0; it < 8; ++it) { const int row = it * 4 + rsub;
    f32x4 v0 = *(const f32x4*)(stg + row * STG_LD + c8), v1 = *(const f32x4*)(stg + row * STG_LD + c8 + 4);
    const size_t off = obase + (size_t)row * 1024 + c8;
    const u32x4 zv = zq[it];
    if constexpr (NORM) {
      float ssq = (v0[0] * v0[0] + v0[1] * v0[1]) + (v0[2] * v0[2] + v0[3] * v0[3]) + (v1[0] * v1[0] + v1[1] * v1[1]) + (v1[2] * v1[2] + v1[3] * v1[3]);
      ssq += __shfl_xor(ssq, 1); ssq += __shfl_xor(ssq, 2); ssq += __shfl_xor(ssq, 4); ssq += __shfl_xor(ssq, 8);
      const float rstd = __builtin_amdgcn_rsqf(ssq * (1.0f / 128.0f) + 1e-6f);
      v0 = v0 * rstd * g0; v1 = v1 * rstd * g1; }
    v0[0] *= silu(__uint_as_float(zv.x << 16)); v0[1] *= silu(__uint_as_float(zv.x & 0xffff0000u));
    v0[2] *= silu(__uint_as_float(zv.y << 16)); v0[3] *= silu(__uint_as_float(zv.y & 0xffff0000u));
    v1[0] *= silu(__uint_as_float(zv.z << 16)); v1[1] *= silu(__uint_as_float(zv.z & 0xffff0000u));
    v1[2] *= silu(__uint_as_float(zv.w << 16)); v1[3] *= silu(__uint_as_float(zv.w & 0xffff0000u));
    u32x4 w = {cvtpk(v0[0], v0[1]), cvtpk(v0[2], v0[3]), cvtpk(v1[0], v1[1]), cvtpk(v1[2], v1[3])};
    __builtin_nontemporal_store(w, (u32x4*)(O + off)); }
}

__device__ __forceinline__ void item_a(bf16_t* OUT, const bf16_t* QA, const bf16_t* KA, const bf16_t* VA, const bf16_t* ZA, const float* tabA, const float* subln, const float lam,
                                       float* scr, const int rowbase, const int q0, const int h, const int S, char* lds) {
  int tid_ = threadIdx.x; asm volatile("" : "+v"(tid_));
  const int tid = tid_, wid = tid >> 6, lane = tid & 63, r32 = lane & 31, hi = lane >> 5;
  float* tb = (float*)(lds + LDS_TB); float* ws = (float*)(lds + LDS_WSOFF) + wid * 64;
  tb[tid] = tabA[h * 512 + tid];
  const float b_neg = tabA[h * 512], b_pos = tabA[h * 512 + 511];
  const int qlo = q0 + wid * 32;
  const bf16_t* Kh = KA + (size_t)rowbase * 1024 + h * 128; const bf16_t* Vh = VA + (size_t)rowbase * 1024 + h * 128;
  const bf16_t* Qrow = QA + (size_t)(rowbase + qlo + r32) * 1024 + h * 128 + hi * 8;
  f32x16 o[4]; float l; bf16x8 qr[4];
#pragma unroll 1
  for (int mp = 0; mp < 2; ++mp) {
#pragma unroll
    for (int d0 = 0; d0 < 4; ++d0) qr[d0] = ld8(Qrow + mp * 64 + d0 * 16);
    volatile unsigned* badf = (volatile unsigned*)(lds + LDS_TB + 2048);
    if (tid == 0) *badf = 0u;
    flash_pass<64, 1024, true, true>(qr, Kh + mp * 64, Vh, S, lds, o, l, qlo, b_neg, b_pos);
    if (!(l > 1e-30f && l < 1e30f)) *badf = 1u;
    __syncthreads(); const unsigned redo = (PROBE == 20) ? 1u : *badf; __syncthreads();
    if (redo != 0u) flash_pass<64, 1024, true, false>(qr, Kh + mp * 64, Vh, S, lds, o, l, qlo, b_neg, b_pos);
    float rli[16]; row_rcp(l, ws, r32, hi, rli);
    if (mp == 0) {
#pragma unroll
      for (int d0 = 0; d0 < 4; ++d0)
#pragma unroll
        for (int r = 0; r < 16; r += 8) { u32x4 w;
          w.x = cvtpk(o[d0][r] * rli[r], o[d0][r + 1] * rli[r + 1]);         w.y = cvtpk(o[d0][r + 2] * rli[r + 2], o[d0][r + 3] * rli[r + 3]);
          w.z = cvtpk(o[d0][r + 4] * rli[r + 4], o[d0][r + 5] * rli[r + 5]); w.w = cvtpk(o[d0][r + 6] * rli[r + 6], o[d0][r + 7] * rli[r + 7]);
          ((u32x4*)(scr + tid * 32))[d0 * 2 + (r >> 3)] = w; }
    } else {
#pragma unroll
      for (int d0 = 0; d0 < 4; ++d0)
#pragma unroll
        for (int r = 0; r < 16; r += 8) { const u32x4 w = ((const u32x4*)(scr + tid * 32))[d0 * 2 + (r >> 3)];
          const unsigned ww[4] = {w.x, w.y, w.z, w.w};
#pragma unroll
          for (int q = 0; q < 4; ++q) { o[d0][r + 2 * q] = __uint_as_float(ww[q] << 16) - lam * (o[d0][r + 2 * q] * rli[r + 2 * q]);
            o[d0][r + 2 * q + 1] = __uint_as_float(ww[q] & 0xffff0000u) - lam * (o[d0][r + 2 * q + 1] * rli[r + 2 * q + 1]); } }
    }
  }
  __syncthreads();
  out_rows<true>(o, nullptr, lds, subln, 0.8f, ZA, OUT, (size_t)(rowbase + qlo) * 1024 + h * 128);
  __syncthreads();
}

__device__ __forceinline__ void item_b(bf16_t* OUT, const bf16_t* QB, const bf16_t* KB, const bf16_t* VB, const bf16_t* ZB, const float* qg, const f32x2* rt,
                                       const int rowbase, const int q0, const int h, const int S, char* lds) {
  int tid_ = threadIdx.x; asm volatile("" : "+v"(tid_));
  const int tid = tid_, wid = tid >> 6, lane = tid & 63, r32 = lane & 31, hi = lane >> 5;
  float* ws = (float*)(lds + LDS_WSOFF) + wid * 64;
  const int qlo = q0 + wid * 32, t = qlo + r32, kvh = h >> 2;
  const bf16_t* Kh = KB + (size_t)rowbase * 256 + kvh * 128; const bf16_t* Vh = VB + (size_t)rowbase * 256 + kvh * 128;
  const bf16_t* Qrow = QB + (size_t)(rowbase + t) * 1024 + h * 128 + hi * 8;
  bf16x8 qr[8];
  { float f[8][8]; float ssq = 0.f;
#pragma unroll
    for (int d0 = 0; d0 < 8; ++d0) { const bf16x8 raw = ld8(Qrow + d0 * 16);
#pragma unroll
      for (int j = 0; j < 8; ++j) { f[d0][j] = bf2f(raw[j]); ssq += f[d0][j] * f[d0][j]; } }
    { auto rr = __builtin_amdgcn_permlane32_swap(__float_as_uint(ssq), __float_as_uint(ssq), false, false);
      ssq = __uint_as_float(rr[0]) + __uint_as_float(rr[1]); }
    const float rstd = __builtin_amdgcn_rsqf(ssq * (1.0f / 128.0f) + 1e-6f) * (0.08838834764831845f * 1.4426950408889634f);
#pragma unroll
    for (int d0 = 0; d0 < 8; ++d0) { const f32x4 g0 = *(const f32x4*)(qg + d0 * 16 + hi * 8), g1 = *(const f32x4*)(qg + d0 * 16 + hi * 8 + 4);
#pragma unroll
      for (int j = 0; j < 4; ++j) { f[d0][j] *= rstd * g0[j]; f[d0][4 + j] *= rstd * g1[j]; } }
#pragma unroll
    for (int hf = 0; hf < 2; ++hf) { const int idx = hf == 0 ? (t >> 6) : (t & 63);
#pragma unroll
      for (int dp = 0; dp < 2; ++dp)
#pragma unroll
        for (int j = 0; j < 8; ++j) { const f32x2 cs = rt[idx * 32 + dp * 16 + hi * 8 + j];
          const float u1 = f[hf * 4 + dp][j], u2 = f[hf * 4 + dp + 2][j];
          f[hf * 4 + dp][j] = u1 * cs.x - u2 * cs.y; f[hf * 4 + dp + 2][j] = u1 * cs.y + u2 * cs.x; } }
#pragma unroll
    for (int d0 = 0; d0 < 8; ++d0) { u32x4 w = {cvtpk(f[d0][0], f[d0][1]), cvtpk(f[d0][2], f[d0][3]), cvtpk(f[d0][4], f[d0][5]), cvtpk(f[d0][6], f[d0][7])};
      qr[d0] = *reinterpret_cast<bf16x8*>(&w); }
  }
  f32x16 o[4]; float l; float rli[16];
  volatile unsigned* badf = (volatile unsigned*)(lds + LDS_TB + 2048);
  if (tid == 0) *badf = 0u;
  flash_pass<128, 256, false, true>(qr, Kh, Vh, S, lds, o, l, qlo, 0.f, 0.f);
  if (!(l > 1e-30f && l < 1e30f)) *badf = 1u;
  __syncthreads(); const unsigned redo = (PROBE == 20) ? 1u : *badf; __syncthreads();
  if (redo != 0u) flash_pass<128, 256, false, false>(qr, Kh, Vh, S, lds, o, l, qlo, 0.f, 0.f);
  row_rcp(l, ws, r32, hi, rli);
  __syncthreads();
  out_rows<false>(o, rli, lds, nullptr, 1.f, ZB, OUT, (size_t)(rowbase + qlo) * 1024 + h * 128);
  __syncthreads();
}
#undef SBAR
}
#define LAS __attribute__((address_space(3)))
typedef unsigned short bf16;
typedef unsigned v4u __attribute__((ext_vector_type(4)));
typedef float f32x4 __attribute__((ext_vector_type(4)));
typedef float f32x2 __attribute__((ext_vector_type(2)));
constexpr size_t MiB = 1u << 20;
constexpr size_t WS_WIN = 2 * MiB, WS_WPA = 20 * MiB, WS_WPB = 22 * MiB, WS_WOUT = 24 * MiB, WS_TAB = 26 * MiB;
constexpr size_t WS_XN = 32 * MiB;
constexpr size_t WS_BIG = 192 * MiB;
constexpr size_t WS_KB = 960 * MiB, WS_VB = 984 * MiB;
constexpr size_t WS_SCR = 1008 * MiB;
constexpr size_t WS_END = 1040 * MiB;
constexpr size_t TAB_BIAS = 0, TAB_ROPE = 16384, TAB_LAM = 16384 + 32768;
constexpr int LDS_BYTES = 147456;
constexpr int NWAVES = 8;

__device__ __forceinline__ unsigned f2bf(float f) { unsigned u = __builtin_bit_cast(unsigned, f); return (u + 0x7fffu + ((u >> 16) & 1u)) >> 16; }
__device__ __forceinline__ unsigned pk2(float lo, float hi) { return f2bf(lo) | (f2bf(hi) << 16); }
__device__ __forceinline__ float wave_sum(float v) {
#pragma unroll
    for (int o = 1; o < 64; o <<= 1) v += __shfl_xor(v, o);
    return v;
}
#define LDS_WAIT() asm volatile("s_waitcnt lgkmcnt(0)" ::: "memory")
__device__ __forceinline__ void p0_transpose_item(const float* W, int K, int N, bf16* WT, LAS float* scr, int item, int lane) {
    const int nblk = N / 32, kb = item / nblk, nb = item % nblk, k0 = 64 * kb, n0 = 32 * nb;
#pragma unroll 8
    for (int i = 0; i < 32; ++i) { const int kk = 2 * i + (lane >> 5); scr[kk * 33 + (lane & 31)] = W[(size_t)(k0 + kk) * N + n0 + (lane & 31)]; }
    LDS_WAIT(); asm volatile("" ::: "memory");
    const int c = lane & 7;
#pragma unroll
    for (int j = 0; j < 4; ++j) { const int n = (lane >> 3) + 8 * j; const LAS float* s = scr + (8 * c) * 33 + n;
        v4u o; o.x = pk2(s[0 * 33], s[1 * 33]); o.y = pk2(s[2 * 33], s[3 * 33]); o.z = pk2(s[4 * 33], s[5 * 33]); o.w = pk2(s[6 * 33], s[7 * 33]);
        *(v4u*)(WT + (size_t)(n0 + n) * K + k0 + 8 * c) = o; }
    LDS_WAIT(); asm volatile("" ::: "memory");
}

typedef __attribute__((address_space(1))) unsigned gu32;
#define XB_TMO      128
#define XB_XCNT(j)  (256  + 64 * (j))
#define XB_XSUB(j)  (1280 + 64 * (j))
#define XB_XGEN(j)  (2304 + 64 * (j))
#define XB_TOP      3328
#define XB_TOPGEN   3392
#define XCD_BAR_WORDS 3456
#define XB_SPIN_CAP (1u << 18)

__device__ __forceinline__ unsigned xb_ld(unsigned* p)              { return __hip_atomic_load(p, __ATOMIC_RELAXED, __HIP_MEMORY_SCOPE_AGENT); }
__device__ __forceinline__ unsigned xb_add(unsigned* p, unsigned v) { return __hip_atomic_fetch_add(p, v, __ATOMIC_RELAXED, __HIP_MEMORY_SCOPE_AGENT); }
__device__ __forceinline__ unsigned xb_xcc_id() { return (unsigned)__builtin_amdgcn_s_getreg((3 << 11) | 20) & 0xFu; }
#define XB_SPIN(cond, bar) do { unsigned _sp = 0; while (cond) { __builtin_amdgcn_s_sleep(1); \
    if ((++_sp & 255u) == 0u) { if (xb_ld(&(bar)[XB_TMO])) break; if (_sp > XB_SPIN_CAP) { atomicAdd(&(bar)[XB_TMO], 1u); break; } } } } while (0)

struct XcdBarrier {
    unsigned* bar; unsigned x;
    volatile LAS unsigned* st;
};

__device__ __forceinline__ XcdBarrier xcd_barrier_post(unsigned* bar, volatile LAS unsigned* st) {
    XcdBarrier b; b.bar = bar; b.x = xb_xcc_id(); b.st = st;
    if (threadIdx.x == 0) (void)xb_add(&bar[XB_XCNT(b.x)], 1u);
    return b;
}
__device__ __forceinline__ void xcd_barrier_complete(unsigned* bar, unsigned x, unsigned& nloc, unsigned& nx) {
    const unsigned G = gridDim.x * gridDim.y * gridDim.z;
    unsigned sum, cnt, mine, sp = 0u;
    for (;;) {
        sum = 0u; cnt = 0u; mine = 0u;
#pragma unroll
        for (unsigned j = 0; j < 16; ++j) { const unsigned c = xb_ld(&bar[XB_XCNT(j)]); sum += c; cnt += (c > 0u) ? 1u : 0u; mine = (j == x) ? c : mine; }
        if (sum == G) break;
        __builtin_amdgcn_s_sleep(1);
        if ((++sp & 255u) == 0u) { if (xb_ld(&bar[XB_TMO])) break; if (sp > XB_SPIN_CAP) { atomicAdd(&bar[XB_TMO], 1u); break; } }
    }
    nloc = mine > 0u ? mine : 1u; nx = cnt > 0u ? cnt : 1u;
}

__device__ __forceinline__ void xcd_barrier(const XcdBarrier& b) {
    asm volatile("s_waitcnt vmcnt(0)" ::: "memory");
    __syncthreads();
    if (threadIdx.x == 0) {
        unsigned* bar = b.bar;
        __builtin_amdgcn_s_waitcnt(0);
        unsigned nloc = b.st[0], nx = b.st[1];
        if (nloc == 0u) { xcd_barrier_complete(bar, b.x, nloc, nx); b.st[0] = nloc; b.st[1] = nx; }
        const unsigned old = xb_add(&bar[XB_XSUB(b.x)], 1u);
        const unsigned gen = old / nloc;
        if (old + 1u == (gen + 1u) * nloc) {
            __builtin_amdgcn_fence(__ATOMIC_RELEASE, "agent");
            asm volatile("s_waitcnt vmcnt(0)" ::: "memory");
            const unsigned og = xb_add(&bar[XB_TOP], 1u);
            const unsigned tg = og / nx;
            if (og + 1u == (tg + 1u) * nx) xb_add(&bar[XB_TOPGEN], 1u);
            else XB_SPIN(xb_ld(&bar[XB_TOPGEN]) == tg, bar);
            __builtin_amdgcn_fence(__ATOMIC_ACQUIRE, "agent");
            xb_add(&bar[XB_XGEN(b.x)], 1u);
            asm volatile("s_waitcnt vmcnt(0)" ::: "memory");
        } else {
            XB_SPIN(xb_ld(&bar[XB_XGEN(b.x)]) == gen, bar);
            __builtin_amdgcn_fence(__ATOMIC_ACQUIRE, "agent");
            asm volatile("s_waitcnt vmcnt(0)" ::: "memory");
        }
    }
    __syncthreads();
}

struct Args { const float* in[16]; float* out; unsigned char* ws; };

__global__ void __launch_bounds__(NWAVES * 64, 2) fwd_mega(Args a) {
    extern __shared__ __attribute__((aligned(16))) unsigned char lds[];
    cg::grid_group grid = cg::this_grid();
    const int tid = threadIdx.x, lane = tid & 63, wave = __builtin_amdgcn_readfirstlane(tid >> 6);
    const int G = gridDim.x, bx = blockIdx.x;
    const int vcu = (G % 8 == 0) ? (bx % 8) * (G / 8) + bx / 8 : bx;
    unsigned char* ws = a.ws;
    volatile LAS unsigned* bar_st = (volatile LAS unsigned*)((LAS unsigned char*)lds + (LDS_BYTES - 64));
    if (tid < 2) bar_st[tid] = 0u;
    __syncthreads();
    const XcdBarrier xbar = xcd_barrier_post((unsigned*)ws, bar_st);
#define GRID_BAR() xcd_barrier(xbar)
    const float* xp = a.in[0]; const float* xs = a.in[1]; const float* g_norm = a.in[2]; const float* w_in = a.in[3];
    const float* lq1 = a.in[4]; const float* lk1 = a.in[5]; const float* lq2 = a.in[6]; const float* lk2 = a.in[7];
    const float* subln = a.in[8]; const float* qnb = a.in[9]; const float* knb = a.in[10];
    const float* w_pa = a.in[11]; const float* w_pb = a.in[12]; const float* w_out = a.in[13]; const float* rel_bias = a.in[14]; const float* g_final = a.in[15];
    bf16* WinT = (bf16*)(ws + WS_WIN); bf16* WpaT = (bf16*)(ws + WS_WPA); bf16* WpbT = (bf16*)(ws + WS_WPB); bf16* WoutT = (bf16*)(ws + WS_WOUT);
    float* tabA = (float*)(ws + WS_TAB + TAB_BIAS); f32x2* rt = (f32x2*)(ws + WS_TAB + TAB_ROPE); float* lamp = (float*)(ws + WS_TAB + TAB_LAM);
    bf16* XN = (bf16*)(ws + WS_XN);
    bf16* BIG = (bf16*)(ws + WS_BIG);
    bf16 *QA = BIG, *KA = BIG + pg8::BUFE, *VA = BIG + 2 * pg8::BUFE, *ZA = BIG + 3 * pg8::BUFE, *QB = BIG + 4 * pg8::BUFE, *ZB = BIG + 5 * pg8::BUFE, *GA = BIG + 6 * pg8::BUFE, *GB = BIG + 7 * pg8::BUFE;
    bf16* KB = (bf16*)(ws + WS_KB); bf16* VB = (bf16*)(ws + WS_VB);
    float* scr = (float*)(ws + WS_SCR) + (size_t)bx * 32768;
    const int gw = vcu * NWAVES + wave, NGW = G * NWAVES;

    for (int rep_ = 0; rep_ < (PROBE == 4 ? 2 : 1); ++rep_) {
        LAS float* tscr = (LAS float*)((LAS unsigned char*)lds + wave * 16384);
        constexpr int I_IN = (1024 / 64) * (NIN / 32), I_SQ = (1024 / 64) * (1024 / 32);
        for (int it = gw; it < I_IN + 3 * I_SQ; it += NGW) {
            int r = it;
            if (r < I_IN) { p0_transpose_item(w_in, 1024, NIN, WinT, tscr, r, lane); continue; } r -= I_IN;
            if (r < I_SQ) { p0_transpose_item(w_pa, 1024, 1024, WpaT, tscr, r, lane); continue; } r -= I_SQ;
            if (r < I_SQ) { p0_transpose_item(w_pb, 1024, 1024, WpbT, tscr, r, lane); continue; } r -= I_SQ;
            p0_transpose_item(w_out, 1024, 1024, WoutT, tscr, r, lane);
        }
        f32x4 gv[4];
#pragma unroll
        for (int j = 0; j < 4; ++j) gv[j] = ((const f32x4*)g_norm)[lane + 64 * j];
        for (int m0 = gw; m0 < NTOK; m0 += 4 * NGW) {
            f32x4 v[4][4]; float ssq[4];
#pragma unroll
            for (int q = 0; q < 4; ++q) { const int m = m0 + q * NGW; ssq[q] = 0.f; if (m >= NTOK) continue;
                const f32x4* xr = (const f32x4*)(m < NPTOK ? xp + (size_t)m * 1024 : xs + (size_t)(m - NPTOK) * 1024) + lane;
#pragma unroll
                for (int j = 0; j < 4; ++j) { v[q][j] = xr[64 * j]; ssq[q] += (v[q][j].x * v[q][j].x + v[q][j].y * v[q][j].y) + (v[q][j].z * v[q][j].z + v[q][j].w * v[q][j].w); } }
#pragma unroll
            for (int q = 0; q < 4; ++q) { const int m = m0 + q * NGW; if (m >= NTOK) continue;
                const float rstd = 1.0f / sqrtf(wave_sum(ssq[q]) * (1.f / 1024.f) + EPS);
                unsigned long long* o8 = (unsigned long long*)(XN + (size_t)m * 1024) + lane;
#pragma unroll
                for (int j = 0; j < 4; ++j) { const f32x4 w = v[q][j] * rstd * gv[j];
                    o8[64 * j] = (unsigned long long)pk2(w.x, w.y) | ((unsigned long long)pk2(w.z, w.w) << 32); } }
        }
        if (bx == G - 1) {
            for (int i = tid; i < 8 * 512; i += NWAVES * 64) { const int h = i >> 9, rel = (i & 511) - 256, n = rel < 0 ? -rel : rel;
                const int lg = n < 8 ? n : (n < 12 ? 8 : n < 16 ? 9 : n < 23 ? 10 : n < 32 ? 11 : n < 46 ? 12 : n < 64 ? 13 : n < 91 ? 14 : 15);
                tabA[i] = rel_bias[((rel > 0 ? 16 : 0) + lg) * 8 + h] * 1.4426950408889634f; }
            for (int i = tid; i < 128 * 32; i += NWAVES * 64) { const int idx = i >> 5, fi = i & 31;
                const float inv = __builtin_amdgcn_exp2f(-(float)fi * (13.287712379549449f / 32.0f));
                float rev = (float)idx * inv * 0.15915494309189535f; rev -= rintf(rev);
                rt[i] = (f32x2){__builtin_amdgcn_cosf(rev), __builtin_amdgcn_sinf(rev)}; }
            if (tid == 0) { float s1 = 0.f, s2 = 0.f; for (int i = 0; i < 64; ++i) { s1 += lq1[i] * lk1[i]; s2 += lq2[i] * lk2[i]; }
                lamp[0] = __expf(s1) - __expf(s2) + 0.2f; }
        }
    }
    grid.sync();
#if PROBE == 5
    for (int q_ = 0; q_ < 11; ++q_) GRID_BAR();
#endif
    const float lam = lamp[0];

    for (int g = 0; g < NGRP; ++g) {
        const int GM = g == 0 ? GMAX : G1ROWS, gbase = g == 0 ? 0 : G1BASE;
        bf16* MERGED = XN + (size_t)gbase * 1024;
        {
            pg8::Gemm gm{XN + (size_t)gbase * 1024, WinT, GM, NIN, 1024, nullptr, nullptr}; pg8::StaticOrder S; S.init(GM, NIN, G, bx);
            pg8::EpiProj E{BIG, KB, VB};
            pg8::gemm_phase<pg8::EpiProj, pg8::StaticOrder, true, true>((LAS unsigned char*)lds, gm, S, E);
#if PROBE == 3
            pg8::gemm_phase<pg8::EpiProj, pg8::StaticOrder, true, true>((LAS unsigned char*)lds, gm, S, E);
#endif
        }
        GRID_BAR();
        { int lane_k = threadIdx.x & 63; asm volatile("" : "+v"(lane_k));
          const int c = lane_k & 15, sub = lane_k >> 4;
          const f32x4 kg0 = *(const f32x4*)(knb + c * 8), kg1 = *(const f32x4*)(knb + c * 8 + 4);
          v4u rawn = {0u, 0u, 0u, 0u};
          if (gw * 4 < GM * 2) { const int u = gw * 4 + sub; rawn = *(const v4u*)(KB + (size_t)(u >> 1) * 256 + (u & 1) * 128 + c * 8); }
          for (int u0 = gw * 4; u0 < GM * 2; u0 += NGW * 4) {
            const int u = u0 + sub, lr = u >> 1, kvh = u & 1;
            bf16* kp = KB + (size_t)lr * 256 + kvh * 128 + c * 8;
            const v4u raw = rawn;
            if (u0 + NGW * 4 < GM * 2) { const int un = u0 + NGW * 4 + sub; rawn = *(const v4u*)(KB + (size_t)(un >> 1) * 256 + (un & 1) * 128 + c * 8); }
            float f[8];
            f[0] = __uint_as_float(raw.x << 16); f[1] = __uint_as_float(raw.x & 0xffff0000u); f[2] = __uint_as_float(raw.y << 16); f[3] = __uint_as_float(raw.y & 0xffff0000u);
            f[4] = __uint_as_float(raw.z << 16); f[5] = __uint_as_float(raw.z & 0xffff0000u); f[6] = __uint_as_float(raw.w << 16); f[7] = __uint_as_float(raw.w & 0xffff0000u);
            float ssq = 0.f;
#pragma unroll
            for (int j = 0; j < 8; ++j) ssq += f[j] * f[j];
            ssq += __shfl_xor(ssq, 1); ssq += __shfl_xor(ssq, 2); ssq += __shfl_xor(ssq, 4); ssq += __shfl_xor(ssq, 8);
            const float rstd = 1.0f / sqrtf(ssq * (1.f / 128.f) + EPS);
#pragma unroll
            for (int j = 0; j < 4; ++j) { f[j] *= rstd * kg0[j]; f[4 + j] *= rstd * kg1[j]; }
            const int t = (g == 0 || lr < G1SAMPLE) ? (lr & 4095) : ((lr - G1SAMPLE) & 8191);
            const int idx = c < 8 ? (t >> 6) : (t & 63);
            const f32x4* rp = (const f32x4*)(rt + idx * 32 + (c & 3) * 8);
            const bool second = (c & 4) != 0;
            float o8[8];
#pragma unroll
            for (int j2 = 0; j2 < 4; ++j2) { const f32x4 cs = rp[j2];
              const float pa = __shfl_xor(f[2 * j2], 4), pb = __shfl_xor(f[2 * j2 + 1], 4);
              o8[2 * j2]     = second ? (pa * cs[1] + f[2 * j2] * cs[0])     : (f[2 * j2] * cs[0] - pa * cs[1]);
              o8[2 * j2 + 1] = second ? (pb * cs[3] + f[2 * j2 + 1] * cs[2]) : (f[2 * j2 + 1] * cs[2] - pb * cs[3]); }
            v4u w; w.x = pk2(o8[0], o8[1]); w.y = pk2(o8[2], o8[3]); w.z = pk2(o8[4], o8[5]); w.w = pk2(o8[6], o8[7]);
            *(v4u*)kp = w;
          }
        }
        GRID_BAR();
        {
            char* al = (char*)lds;
            const int nS = g == 0 ? 0 : 512, nP = g == 0 ? 1536 : 512;
            for (int i = vcu; i < nS; i += G) att::item_a(QA, QA, KA, VA, ZA, tabA, subln, lam, scr, G1SAMPLE + (i >> 8) * 8192, (i & 31) * 256, (i >> 5) & 7, 8192, al);
            for (int i = vcu; i < nP; i += G) att::item_a(QA, QA, KA, VA, ZA, tabA, subln, lam, scr, (i >> 7) * 4096, (i & 15) * 256, (i >> 4) & 7, 4096, al);
            for (int i = vcu; i < nS; i += G) att::item_b(QB, QB, KB, VB, ZB, qnb, (const att::f32x2*)rt, G1SAMPLE + (i >> 8) * 8192, (i & 31) * 256, (i >> 5) & 7, 8192, al);
            for (int i = vcu; i < nP; i += G) att::item_b(QB, QB, KB, VB, ZB, qnb, (const att::f32x2*)rt, (i >> 7) * 4096, (i & 15) * 256, (i >> 4) & 7, 4096, al);
        }
        GRID_BAR();
        for (int rep_ = 0; rep_ < (PROBE == 6 ? 2 : 1); ++rep_) {
            pg8::PairOrder S; S.init(GM, 1024, G, bx);
            pg8::Gemm gm{QA, WpaT, GM, 1024, 1024, QB, WpbT}; pg8::EpiPair E{GA, GB, MERGED};
            pg8::gemm_phase<pg8::EpiPair, pg8::PairOrder, true, true>((LAS unsigned char*)lds, gm, S, E);
        }
        GRID_BAR();
        for (int rep_ = 0; rep_ < (PROBE == 6 ? 2 : 1); ++rep_) {
            pg8::StaticOrder S; S.init(GM, 1024, G, bx);
            pg8::Gemm gm{MERGED, WoutT, GM, 1024, 1024, nullptr, nullptr}; pg8::EpiOut E{a.out, gbase};
            pg8::gemm_phase<pg8::EpiOut, pg8::StaticOrder, true, true>((LAS unsigned char*)lds, gm, S, E);
        }
        if (g == NGRP - 1) GRID_BAR();
    }
    {
        int lane5 = threadIdx.x & 63; asm volatile("" : "+v"(lane5)); const int lane = lane5;
        f32x4 gv[4];
#pragma unroll
        for (int j = 0; j < 4; ++j) gv[j] = ((const f32x4*)g_final)[lane + 64 * j];
        for (int m0 = gw; m0 < NTOK; m0 += 2 * NGW) {
            f32x4 v[2][4]; float ssq[2];
#pragma unroll
            for (int q = 0; q < 2; ++q) { const int m = m0 + q * NGW; ssq[q] = 0.f; if (m >= NTOK) continue;
                const f32x4* xr = (const f32x4*)(m < NPTOK ? xp + (size_t)m * 1024 : xs + (size_t)(m - NPTOK) * 1024) + lane;
                const unsigned long long* dr = (const unsigned long long*)(a.out + (size_t)m * 1024) + lane;
#pragma unroll
                for (int j = 0; j < 4; ++j) { const unsigned long long d = dr[64 * j]; const unsigned dlo = (unsigned)d, dhi = (unsigned)(d >> 32);
                    f32x4 h = xr[64 * j];
                    h.x += __uint_as_float(dlo << 16); h.y += __uint_as_float(dlo & 0xffff0000u); h.z += __uint_as_float(dhi << 16); h.w += __uint_as_float(dhi & 0xffff0000u);
                    v[q][j] = h; ssq[q] += (h.x * h.x + h.y * h.y) + (h.z * h.z + h.w * h.w); } }
#pragma unroll
            for (int q = 0; q < 2; ++q) { const int m = m0 + q * NGW; if (m >= NTOK) continue;
                const float rstd = 1.0f / sqrtf(wave_sum(ssq[q]) * (1.f / 1024.f) + EPS);
                f32x4* yr = (f32x4*)(a.out + (size_t)m * 1024) + lane;
#pragma unroll
                for (int j = 0; j < 4; ++j) yr[64 * j] = v[q][j] * rstd * gv[j]; }
        }
    }
}

extern "C" void kernel_launch(void* const* d_in, const int* in_sizes, int n_in, void* d_out, int out_size, void* d_ws, size_t ws_size, hipStream_t stream) {
    static int grid = 0;
    if (grid == 0) {
        if (n_in != 16 || out_size != NTOK * 1024 || ws_size < WS_END) { fprintf(stderr, "kernel_launch: unexpected shapes: n_in %d out %d ws %zu (need %zu)\n", n_in, out_size, ws_size, (size_t)WS_END); grid = -1; return; }
        int dev = 0, cus = 0, per_cu = 0;
        if (hipGetDevice(&dev) != hipSuccess || hipDeviceGetAttribute(&cus, hipDeviceAttributeMultiprocessorCount, dev) != hipSuccess) { grid = -1; return; }
        if (hipFuncSetAttribute((const void*)fwd_mega, hipFuncAttributeMaxDynamicSharedMemorySize, LDS_BYTES) != hipSuccess) { fprintf(stderr, "kernel_launch: hipFuncSetAttribute failed\n"); grid = -1; return; }
        if (hipOccupancyMaxActiveBlocksPerMultiprocessor(&per_cu, (const void*)fwd_mega, NWAVES * 64, LDS_BYTES) != hipSuccess || per_cu < 1) { fprintf(stderr, "kernel_launch: occupancy query gave %d\n", per_cu); per_cu = 1; }
        (void)hipGetLastError();
        grid = cus * (per_cu > 1 ? 1 : per_cu);
    }
    if (grid < 0) return;
    Args a{};
    for (int i = 0; i < 16; ++i) a.in[i] = (const float*)d_in[i];
    a.out = (float*)d_out; a.ws = (unsigned char*)d_ws;
    if (hipMemsetAsync(d_ws, 0, 16384, stream) != hipSuccess) { fprintf(stderr, "kernel_launch: memset failed\n"); return; }
    void* args[] = {&a};
    hipError_t e = hipLaunchCooperativeKernel((const void*)fwd_mega, dim3(grid), dim3(NWAVES * 64), args, LDS_BYTES, stream);
    if (e != hipSuccess) fprintf(stderr, "kernel_launch: cooperative launch failed: %s (grid %d)\n", hipGetErrorString(e), grid);
}
```

```cpp
#include <hip/hip_runtime.h>
#include <hip/hip_cooperative_groups.h>
#include <cstdio>
#include <cstdint>
namespace cg = cooperative_groups;

constexpr int DM = 1024;
constexpr int NTOK = 81920, NPTOK = 65536;
constexpr int GMAX = 49152, G1BASE = 49152, G1ROWS = 32768, G1SAMPLE = 16384;
constexpr int NGRP = 2;
constexpr int NIN = 8704;
constexpr float EPS = 1e-6f;
#ifndef PROBE
#define PROBE 0
#endif
namespace pg8 {
#define PG8_LAS __attribute__((address_space(3)))
typedef unsigned short bf16_t;
typedef short bf16x8 __attribute__((ext_vector_type(8)));
typedef float f32x4 __attribute__((ext_vector_type(4)));
typedef unsigned u32x4 __attribute__((ext_vector_type(4)));
constexpr int BM = 256, BK = 64, HALF = 128, HTB = HALF * BK * 2  , STAGE_BYTES = 8 * HTB, NXCD = 8, WGM = 8;

__host__ __device__ __forceinline__ int lds_byte(int r, int c) { const int st = (r >> 4) * 2 + (c >> 5), rr = r & 15, cc = c & 31, ob = rr * 64 + cc * 2; return st * 1024 + (ob ^ (((ob >> 9) & 1) << 5)); }
__host__ __device__ __forceinline__ void stage_rc(int b, int& R, int& C) { const int st = b / 1024, sb = b % 1024, swz = sb ^ (((sb >> 9) & 1) << 5); R = (st >> 1) * 16 + swz / 64; C = (st & 1) * 32 + (swz % 64) / 2; }
__host__ __device__ __forceinline__ int perm32(int rho) { const int n = rho >> 4, i = rho & 15; return 8 * (i >> 2) + 4 * n + (i & 3); }

struct Unit { int pm, pn, sec; };
struct Gemm { const bf16_t* A; const bf16_t* Bt; int M, N, K; const bf16_t* A2; const bf16_t* Bt2; };

struct StaticOrder {
    int nM, nN, nwg, G, c;
    __host__ __device__ void init(int M, int N, int G_, int c_) { nM = M / BM; nN = N / BM; nwg = nM * nN; G = G_; c = c_; }
    __host__ __device__ bool next(int i, Unit& u) const {
        const long L = (long)i * G + c; if (L >= nwg) return false;
        int wgid = (int)L; { const int q = nwg / NXCD, r = nwg % NXCD, xcd = wgid % NXCD, off = wgid / NXCD; wgid = (xcd < r ? xcd * (q + 1) : r * (q + 1) + (xcd - r) * q) + off; }
        const int nig = WGM * nN, gid = wgid / nig, fm = gid * WGM, gsz = (nM - fm) < WGM ? (nM - fm) : WGM;
        u.pm = fm + ((wgid % nig) % gsz); u.pn = (wgid % nig) / gsz; u.sec = 0; return true;
    }
    __device__ __forceinline__ void a_ready(const Unit&) const {}
    __device__ __forceinline__ void done(const Unit&) const {}
};
struct PairOrder {
    StaticOrder S;
    __host__ __device__ void init(int M, int N, int G_, int c_) { S.init(M, N, G_, c_); }
    __host__ __device__ bool next(int i, Unit& u) const { if (!S.next(i >> 1, u)) return false; u.sec = i & 1; return true; }
    __device__ __forceinline__ void a_ready(const Unit&) const {}
    __device__ __forceinline__ void done(const Unit&) const {}
};
__device__ __forceinline__ unsigned cvt_pk_bf16(float lo, float hi) { unsigned r; asm volatile("v_cvt_pk_bf16_f32 %0, %1, %2" : "=v"(r) : "v"(lo), "v"(hi)); return r; }
typedef float f32x2 __attribute__((ext_vector_type(2)));
typedef unsigned u32x4e __attribute__((ext_vector_type(4)));
constexpr size_t BUFE = (size_t)49152 * 1024;
__device__ __forceinline__ float bf2f(unsigned short v) { return __uint_as_float(((unsigned)v) << 16); }
__device__ __forceinline__ float sigm(float x) { return __builtin_amdgcn_rcpf(1.0f + __builtin_amdgcn_exp2f(-1.4426950408889634f * x)); }

struct EpiProj { static constexpr bool PERM = true, AFTER_DRAIN = false;
    bf16_t* big; bf16_t* kb; bf16_t* vb;
    __device__ __forceinline__ void operator()(const f32x4 (&acc)[2][2][4][2], const Unit& u, int wr, int wc, int fr, int fq) const {
        const int pn = u.pn; bf16_t* base; int ldc, colt;
        if (pn < 20) { base = big + (size_t)(pn >> 2) * BUFE; ldc = 1024; colt = (pn & 3) * 256; }
        else if (pn == 20) { base = kb; ldc = 256; colt = 0; }
        else if (pn == 21) { base = vb; ldc = 256; colt = 0; }
        else { const int q = pn - 22; base = big + (size_t)(5 + (q >> 2)) * BUFE; ldc = 1024; colt = (q & 3) * 256; }
        const int row0 = u.pm * BM + wr * 64 + fr, col0 = colt + wc * 32 + 8 * fq;
        const float sc = pn < 4 ? 0.125f * 1.4426950408889634f : 1.0f;
#pragma unroll
        for (int ai = 0; ai < 2; ++ai)
#pragma unroll
            for (int m = 0; m < 4; ++m) { bf16_t* rowp = base + (size_t)(row0 + ai * HALF + m * 16) * ldc + col0;
#pragma unroll
                for (int bj = 0; bj < 2; ++bj) { const f32x4 v0 = acc[ai][bj][m][0] * sc, v1 = acc[ai][bj][m][1] * sc;
                    u32x4 w; w.x = cvt_pk_bf16(v0[0], v0[1]); w.y = cvt_pk_bf16(v0[2], v0[3]); w.z = cvt_pk_bf16(v1[0], v1[1]); w.w = cvt_pk_bf16(v1[2], v1[3]);
                    *(u32x4*)(rowp + bj * HALF) = w; } }
    }
};
__device__ __forceinline__ float en2(unsigned hbits) { return __builtin_amdgcn_exp2f(-1.4426950408889634f * __uint_as_float(hbits)); }
struct EpiPair { static constexpr bool PERM = true, AFTER_DRAIN = false;
    const bf16_t* ga; const bf16_t* gb; bf16_t* merged;
    __device__ __forceinline__ void operator()(f32x4 (&acc)[2][2][4][2], const Unit& u, int wr, int wc, int fr, int fq) const {
        const int row0 = u.pm * BM + wr * 64 + fr, col0 = u.pn * BM + wc * 32 + 8 * fq;
        if (u.sec == 0) {
#pragma unroll
            for (int ai = 0; ai < 2; ++ai)
#pragma unroll
                for (int m = 0; m < 4; ++m) { const size_t off = (size_t)(row0 + ai * HALF + m * 16) * 1024 + col0;
#pragma unroll
                    for (int bj = 0; bj < 2; ++bj) { const u32x4 av = *(const u32x4*)(ga + off + bj * HALF), bv = *(const u32x4*)(gb + off + bj * HALF);
                        const unsigned aw[4] = {av.x, av.y, av.z, av.w}, bw[4] = {bv.x, bv.y, bv.z, bv.w};
#pragma unroll
                        for (int q = 0; q < 4; ++q) { const int n = q >> 1, e = (q & 1) * 2;
                            const float r0 = (1.0f + en2(bw[q] << 16)) * __builtin_amdgcn_rcpf(1.0f + en2(aw[q] << 16));
                            const float r1 = (1.0f + en2(bw[q] & 0xffff0000u)) * __builtin_amdgcn_rcpf(1.0f + en2(aw[q] & 0xffff0000u));
                            acc[ai][bj][m][n][e] *= r0; acc[ai][bj][m][n][e + 1] *= r1; } } }
        } else {
#pragma unroll
            for (int ai = 0; ai < 2; ++ai)
#pragma unroll
                for (int m = 0; m < 4; ++m) { const size_t off = (size_t)(row0 + ai * HALF + m * 16) * 1024 + col0;
#pragma unroll
                    for (int bj = 0; bj < 2; ++bj) { const u32x4 gv = *(const u32x4*)(gb + off + bj * HALF);
                        const f32x4 v0 = acc[ai][bj][m][0], v1 = acc[ai][bj][m][1];
                        u32x4 w; w.x = cvt_pk_bf16(v0[0] * sigm(__uint_as_float(gv.x << 16)), v0[1] * sigm(__uint_as_float(gv.x & 0xffff0000u)));
                        w.y = cvt_pk_bf16(v0[2] * sigm(__uint_as_float(gv.y << 16)), v0[3] * sigm(__uint_as_float(gv.y & 0xffff0000u)));
                        w.z = cvt_pk_bf16(v1[0] * sigm(__uint_as_float(gv.z << 16)), v1[1] * sigm(__uint_as_float(gv.z & 0xffff0000u)));
                        w.w = cvt_pk_bf16(v1[2] * sigm(__uint_as_float(gv.w << 16)), v1[3] * sigm(__uint_as_float(gv.w & 0xffff0000u)));
                        *(u32x4*)(merged + off + bj * HALF) = w; } }
        }
    }
};
struct EpiOut { static constexpr bool PERM = true, AFTER_DRAIN = false;
    float* out; int base;
    __device__ __forceinline__ void operator()(const f32x4 (&acc)[2][2][4][2], const Unit& u, int wr, int wc, int fr, int fq) const {
        bf16_t* ob = (bf16_t*)(out + ((size_t)base + (size_t)u.pm * BM) * 1024);
        const int row0 = wr * 64 + fr, col0 = u.pn * BM + wc * 32 + 8 * fq;
#pragma unroll
        for (int ai = 0; ai < 2; ++ai)
#pragma unroll
            for (int m = 0; m < 4; ++m) { bf16_t* rowp = ob + (size_t)(row0 + ai * HALF + m * 16) * 2048 + col0;
#pragma unroll
                for (int bj = 0; bj < 2; ++bj) { const f32x4 v0 = acc[ai][bj][m][0], v1 = acc[ai][bj][m][1];
                    u32x4 w; w.x = cvt_pk_bf16(v0[0], v0[1]); w.y = cvt_pk_bf16(v0[2], v0[3]); w.z = cvt_pk_bf16(v1[0], v1[1]); w.w = cvt_pk_bf16(v1[2], v1[3]);
                    *(u32x4*)(rowp + bj * HALF) = w; } }
    }
};
template <class Epi, class Sched, bool ALIGN_EPI = false, bool SP2 = false>
__device__ __forceinline__ void gemm_phase(PG8_LAS unsigned char* lds, const Gemm g, const Sched& S, const Epi& E) {
    int tid_ = threadIdx.x; asm volatile("" : "+v"(tid_));
    const int tid = tid_, wid = __builtin_amdgcn_readfirstlane(tid >> 6), lane = tid & 63, wr = wid >> 2, wc = wid & 3, fr = lane & 15, fq = lane >> 4;
    const int K = g.K, nt = K / BK;
    unsigned voffA[2], voffB[2];
#pragma unroll
    for (int i = 0; i < 2; ++i) { int R, C; stage_rc(tid * 16 + i * 8192, R, C); const int Rb = Epi::PERM ? ((R & ~31) + perm32(R & 31)) : R;
        voffA[i] = (unsigned)(R * K + C) * 2u; voffB[i] = (unsigned)(Rb * K + C) * 2u; }
    const size_t kstep = (size_t)(BK * 2);
    const size_t hstep = (size_t)HALF * K * 2;
    const size_t tstep = 2 * hstep;
    const unsigned ldsw = (unsigned)wid * 1024u;
    const int aoff = lds_byte(wr * 64 + fr, fq * 8), boff = lds_byte(wc * 32 + fr, fq * 8);
#define PG8_SA(b, h) (((b) * 2 + (h)) * HTB)
#define PG8_SB(b, h) ((4 + (b) * 2 + (h)) * HTB)
#define PG8_STAGE(bufoff, gbase, voff) do { _Pragma("unroll") for (int _i = 0; _i < 2; ++_i) \
        __builtin_amdgcn_global_load_lds((const unsigned*)((const char*)(gbase) + (voff)[_i]), (PG8_LAS unsigned*)(lds + (bufoff) + ldsw + _i * 8192), 16, 0, 0); } while (0)
#define PG8_LDA(dst, b, h) do { _Pragma("unroll") for (int m = 0; m < 4; ++m) _Pragma("unroll") for (int k = 0; k < 2; ++k) dst[m][k] = *(const PG8_LAS bf16x8*)(lds + PG8_SA(b, h) + aoff + m * 2048 + k * 1024); } while (0)
#define PG8_LDB(dst, b, h) do { _Pragma("unroll") for (int n = 0; n < 2; ++n) _Pragma("unroll") for (int k = 0; k < 2; ++k) dst[n][k] = *(const PG8_LAS bf16x8*)(lds + PG8_SB(b, h) + boff + n * 2048 + k * 1024); } while (0)
#define PG8_MMA(ai, bj, At, Bt) do { __builtin_amdgcn_s_setprio(1); _Pragma("unroll") for (int m = 0; m < 4; ++m) _Pragma("unroll") for (int n = 0; n < 2; ++n) _Pragma("unroll") for (int k = 0; k < 2; ++k) \
        acc[ai][bj][m][n] = __builtin_amdgcn_mfma_f32_16x16x32_bf16(Bt[n][k], At[m][k], acc[ai][bj][m][n], 0, 0, 0); __builtin_amdgcn_s_setprio(0); } while (0)
#define PG8_WAIT_V(n) asm volatile("s_waitcnt vmcnt(" #n ")" ::: "memory")
#define PG8_WAIT_L(n) asm volatile("s_waitcnt lgkmcnt(" #n ")" ::: "memory")
#define PG8_BAR __builtin_amdgcn_s_barrier()
#define PG8_SCHED __builtin_amdgcn_sched_barrier(0)
    Unit cur, nxt; int ui = 0;
    if (!S.next(0, cur)) return;
    f32x4 acc[2][2][4][2];
#pragma unroll
    for (int a = 0; a < 2; ++a)
#pragma unroll
        for (int b = 0; b < 2; ++b)
#pragma unroll
            for (int m = 0; m < 4; ++m)
#pragma unroll
                for (int n = 0; n < 2; ++n) acc[a][b][m][n] = (f32x4){0.f, 0.f, 0.f, 0.f};
    bf16x8 At[4][2], B0[2][2], B1[2][2];
    const char* cA = (const char*)(cur.sec ? g.A2 : g.A) + (size_t)cur.pm * tstep; const char* cB = (const char*)(cur.sec ? g.Bt2 : g.Bt) + (size_t)cur.pn * tstep;
    S.a_ready(cur);
    if constexpr (SP2) {
        PG8_STAGE(PG8_SB(0, 0), cB, voffB); PG8_STAGE(PG8_SB(0, 1), cB + hstep, voffB); PG8_STAGE(PG8_SA(0, 0), cA, voffA); PG8_STAGE(PG8_SA(0, 1), cA + hstep, voffA);
        if (wr == 1) PG8_BAR;
        PG8_WAIT_V(2); PG8_BAR;
        PG8_STAGE(PG8_SB(1, 0), cB + kstep, voffB); PG8_STAGE(PG8_SA(1, 0), cA + kstep, voffA); PG8_STAGE(PG8_SB(1, 1), cB + hstep + kstep, voffB);
        PG8_WAIT_V(6); PG8_BAR;
    } else {
        PG8_STAGE(PG8_SB(0, 0), cB, voffB); PG8_STAGE(PG8_SA(0, 0), cA, voffA); PG8_STAGE(PG8_SB(0, 1), cB + hstep, voffB); PG8_STAGE(PG8_SA(0, 1), cA + hstep, voffA);
        if (wr == 1) PG8_BAR;
        PG8_WAIT_V(4); PG8_BAR;
        PG8_STAGE(PG8_SB(1, 0), cB + kstep, voffB); PG8_STAGE(PG8_SA(1, 0), cA + kstep, voffA); PG8_STAGE(PG8_SB(1, 1), cB + hstep + kstep, voffB);
        PG8_WAIT_V(6); PG8_BAR;
    }
    for (;;) {
        const bool has_next = S.next(ui + 1, nxt);
        const char* nA = has_next ? (const char*)(nxt.sec ? g.A2 : g.A) + (size_t)nxt.pm * tstep : cA; const char* nB = has_next ? (const char*)(nxt.sec ? g.Bt2 : g.Bt) + (size_t)nxt.pn * tstep : cB;
        for (int t = 0; t < nt; t += 2) {
            const bool last = (t == nt - 2);
            const char* a1 = cA + (size_t)(t + 1) * kstep;
            const char* a2 = last ? nA : cA + (size_t)(t + 2) * kstep; const char* b2 = last ? nB : cB + (size_t)(t + 2) * kstep;
            const char* a3 = a2 + kstep; const char* b3 = b2 + kstep;
            if (last && has_next) S.a_ready(nxt);
            if constexpr (SP2) {
            PG8_LDB(B0, 0, 0); PG8_LDB(B1, 0, 1); PG8_SCHED; PG8_LDA(At, 0, 0); PG8_STAGE(PG8_SA(1, 1), a1 + hstep, voffA);
            PG8_WAIT_V(8); PG8_WAIT_L(0); PG8_BAR; PG8_MMA(0, 0, At, B0); PG8_MMA(0, 1, At, B1); PG8_BAR; PG8_SCHED;
            PG8_LDA(At, 0, 1); PG8_STAGE(PG8_SB(0, 0), b2, voffB); PG8_STAGE(PG8_SB(0, 1), b2 + hstep, voffB); PG8_STAGE(PG8_SA(0, 0), a2, voffA);
            PG8_WAIT_V(8); PG8_WAIT_L(0); PG8_BAR; PG8_MMA(1, 0, At, B0); PG8_MMA(1, 1, At, B1); PG8_BAR; PG8_SCHED;
            PG8_LDB(B0, 1, 0); PG8_LDB(B1, 1, 1); PG8_SCHED; PG8_LDA(At, 1, 0); PG8_STAGE(PG8_SA(0, 1), a2 + hstep, voffA);
            PG8_WAIT_V(8); PG8_WAIT_L(0); PG8_BAR; PG8_MMA(0, 0, At, B0); PG8_MMA(0, 1, At, B1); PG8_BAR; PG8_SCHED;
            PG8_LDA(At, 1, 1); PG8_STAGE(PG8_SB(1, 0), b3, voffB); PG8_STAGE(PG8_SB(1, 1), b3 + hstep, voffB); PG8_STAGE(PG8_SA(1, 0), a3, voffA);
            PG8_WAIT_V(8); PG8_WAIT_L(0); PG8_BAR; PG8_MMA(1, 0, At, B0); PG8_MMA(1, 1, At, B1); PG8_BAR; PG8_SCHED;
            } else {
            PG8_LDB(B0, 0, 0); PG8_SCHED; PG8_LDA(At, 0, 0); PG8_STAGE(PG8_SA(1, 1), a1 + hstep, voffA);
            PG8_WAIT_L(8); PG8_BAR; PG8_WAIT_L(0); PG8_MMA(0, 0, At, B0); PG8_BAR; PG8_SCHED;
            PG8_LDB(B1, 0, 1); PG8_STAGE(PG8_SB(0, 0), b2, voffB);
            PG8_BAR; PG8_WAIT_L(0); PG8_MMA(0, 1, At, B1); PG8_BAR;
            PG8_LDA(At, 0, 1); PG8_STAGE(PG8_SA(0, 0), a2, voffA);
            PG8_BAR; PG8_WAIT_L(0); PG8_MMA(1, 0, At, B0); PG8_BAR; PG8_SCHED;
            PG8_STAGE(PG8_SB(0, 1), b2 + hstep, voffB);
            PG8_WAIT_V(6); PG8_BAR; PG8_MMA(1, 1, At, B1); PG8_BAR;
            PG8_LDB(B0, 1, 0); PG8_SCHED; PG8_LDA(At, 1, 0); PG8_STAGE(PG8_SA(0, 1), a2 + hstep, voffA);
            PG8_WAIT_L(8); PG8_BAR; PG8_WAIT_L(0); PG8_MMA(0, 0, At, B0); PG8_BAR; PG8_SCHED;
            PG8_LDB(B1, 1, 1); PG8_STAGE(PG8_SB(1, 0), b3, voffB);
            PG8_BAR; PG8_WAIT_L(0); PG8_MMA(0, 1, At, B1); PG8_BAR;
            PG8_LDA(At, 1, 1); PG8_STAGE(PG8_SA(1, 0), a3, voffA);
            PG8_BAR; PG8_WAIT_L(0); PG8_MMA(1, 0, At, B0); PG8_BAR; PG8_SCHED;
            PG8_STAGE(PG8_SB(1, 1), b3 + hstep, voffB);
            PG8_WAIT_V(6); PG8_BAR; PG8_MMA(1, 1, At, B1); PG8_BAR;
            }
        }
        if constexpr (ALIGN_EPI) { if (wr == 0) PG8_BAR; }
        if constexpr (!Epi::AFTER_DRAIN) { E(acc, cur, wr, wc, fr, fq); S.done(cur); }
        if (!has_next) break;
        if (!nxt.sec)
#pragma unroll
        for (int a = 0; a < 2; ++a)
#pragma unroll
            for (int b = 0; b < 2; ++b)
#pragma unroll
                for (int m = 0; m < 4; ++m)
#pragma unroll
                    for (int n = 0; n < 2; ++n) acc[a][b][m][n] = (f32x4){0.f, 0.f, 0.f, 0.f};
        cur = nxt; cA = nA; cB = nB; ++ui;
        if constexpr (ALIGN_EPI) { if (wr == 1) PG8_BAR; }
    }
    PG8_WAIT_V(0);
    if constexpr (!ALIGN_EPI) { if (wr == 0) PG8_BAR; }
    PG8_BAR;
    if constexpr (Epi::AFTER_DRAIN) { E.fused(acc, cur, wr, wc, fr, fq, lds, wid, lane); S.done(cur); }
#undef PG8_SA
#undef PG8_SB
#undef PG8_STAGE
#undef PG8_LDA
#undef PG8_LDB
#undef PG8_MMA
#undef PG8_WAIT_V
#undef PG8_WAIT_L
#undef PG8_BAR
#undef PG8_SCHED
}
}
namespace att {
typedef unsigned short bf16_t;
using bf16x8 = __attribute__((ext_vector_type(8))) short;
using s16x4  = __attribute__((ext_vector_type(4))) short;
using f32x16 = __attribute__((ext_vector_type(16))) float;
using f32x4  = __attribute__((ext_vector_type(4))) float;
using f32x2  = __attribute__((ext_vector_type(2))) float;
using u32x4  = __attribute__((ext_vector_type(4))) unsigned;
constexpr int NW = 8, QBLK = 32, KVBLK = 64;
constexpr int SHM_V = 16384, SHM_K = 16384;
constexpr int LDS_WSOFF = 3 * SHM_V + 4 * SHM_K;
constexpr int LDS_TB = LDS_WSOFF + NW * 64 * 4;
constexpr int ATT_LDS = LDS_TB + 2048;
constexpr float THR = 8.f;
#define KSWZ128(row, colB) ((row) * 256 + ((colB) ^ (((row) & 7) << 4)))
#define KSWZ64(row, colB)  ((row) * 128 + ((colB) ^ ((((row) >> 1) & 7) << 4)))
#define SBAR() __builtin_amdgcn_sched_barrier(0)
__device__ __forceinline__ int crow(int r, int hi) { return (r & 3) + 8 * (r >> 2) + 4 * hi; }
__device__ __forceinline__ unsigned cvtpk(float lo, float hi) { unsigned r; asm volatile("v_cvt_pk_bf16_f32 %0, %1, %2" : "=v"(r) : "v"(lo), "v"(hi)); return r; }
__device__ __forceinline__ bf16x8 ld8(const bf16_t* p) { return *reinterpret_cast<const bf16x8*>(p); }
__device__ __forceinline__ float bf2f(short v) { return __uint_as_float(((unsigned)(unsigned short)v) << 16); }

constexpr float THR2 = THR * 1.4426950408889634f;
template <int DK>
__device__ __forceinline__ void partialSM(f32x16& p0, f32x16& p1, float& m_reg, float& mn, float& alpha, const float cb) {
  float pmax = p0[0];
#pragma unroll
  for (int r = 1; r < 16; ++r) pmax = fmaxf(pmax, p0[r]);
#pragma unroll
  for (int r = 0; r < 16; ++r) pmax = fmaxf(pmax, p1[r]);
  { auto rr = __builtin_amdgcn_permlane32_swap(__float_as_uint(pmax), __float_as_uint(pmax), false, false);
    pmax = fmaxf(__uint_as_float(rr[0]), __uint_as_float(rr[1])); }
  pmax += cb;
  if (__builtin_expect(__all(pmax - m_reg <= THR2), 1)) { mn = m_reg; alpha = 1.f; }
  else { mn = fmaxf(m_reg, pmax); alpha = __builtin_amdgcn_exp2f(m_reg - mn); m_reg = mn; }
  const float mnC = cb - mn;
#pragma unroll
  for (int r = 0; r < 16; ++r) p0[r] += mnC;
#pragma unroll
  for (int r = 0; r < 16; ++r) p1[r] += mnC;
#pragma unroll
  for (int r = 0; r < 16; ++r) p0[r] = __builtin_amdgcn_exp2f(p0[r]);
}
template <bool NOEXP>
__device__ __forceinline__ void finishSM(f32x16& p0, f32x16& p1, float alpha, float& l_reg, bf16x8& pa0, bf16x8& pa1, bf16x8& pa2, bf16x8& pa3) {
  if constexpr (!NOEXP) {
#pragma unroll
  for (int r = 0; r < 16; ++r) p1[r] = __builtin_amdgcn_exp2f(p1[r]); }
  float ps = 0;
#pragma unroll
  for (int r = 0; r < 16; ++r) ps += p0[r];
#pragma unroll
  for (int r = 0; r < 16; ++r) ps += p1[r];
  { auto rr = __builtin_amdgcn_permlane32_swap(__float_as_uint(ps), __float_as_uint(ps), false, false);
    ps = __uint_as_float(rr[0]) + __uint_as_float(rr[1]); }
  l_reg = l_reg * alpha + ps;
#define PK4(P, BASE, OUT) do { unsigned a0 = cvtpk(P[BASE + 0], P[BASE + 1]), a1 = cvtpk(P[BASE + 2], P[BASE + 3]);   \
    unsigned b0 = cvtpk(P[BASE + 4], P[BASE + 5]), b1 = cvtpk(P[BASE + 6], P[BASE + 7]);                              \
    auto r0 = __builtin_amdgcn_permlane32_swap(a0, b0, false, false); auto r1 = __builtin_amdgcn_permlane32_swap(a1, b1, false, false); \
    u32x4 w = {r0[0], r1[0], r0[1], r1[1]}; OUT = *reinterpret_cast<bf16x8*>(&w); } while (0)
  PK4(p0, 0, pa0); PK4(p0, 8, pa1); PK4(p1, 0, pa2); PK4(p1, 8, pa3);
#undef PK4
}
__device__ __forceinline__ void add_bias(f32x16& p0, f32x16& p1, const float* tb, int relb, int hi) {
  const float* t = tb + relb + 4 * hi;
#pragma unroll
  for (int r = 0; r < 16; ++r) { p0[r] += t[(r & 3) + 8 * (r >> 2)]; p1[r] += t[32 + (r & 3) + 8 * (r >> 2)]; }
}
template <int DK>
__device__ __forceinline__ void qkt(f32x16& p0, f32x16& p1, const char* Ks, const bf16x8* qr, int r32, int hi) {
  p0 = f32x16{}; p1 = f32x16{};
#pragma unroll
  for (int d0 = 0; d0 < DK / 16; ++d0) { const int cb = (d0 * 16 + hi * 8) * 2;
    bf16x8 b0, b1;
    if constexpr (DK == 128) { b0 = *reinterpret_cast<const bf16x8*>(Ks + KSWZ128(r32, cb)); b1 = *reinterpret_cast<const bf16x8*>(Ks + KSWZ128(32 + r32, cb)); }
    else { b0 = *reinterpret_cast<const bf16x8*>(Ks + KSWZ64(r32, cb)); b1 = *reinterpret_cast<const bf16x8*>(Ks + KSWZ64(32 + r32, cb)); }
    p0 = __builtin_amdgcn_mfma_f32_32x32x16_bf16(b0, qr[d0], p0, 0, 0, 0);
    p1 = __builtin_amdgcn_mfma_f32_32x32x16_bf16(b1, qr[d0], p1, 0, 0, 0); }
}
__device__ __forceinline__ int v_st(int k, int c) { const int kk = (k & ~0xC) | ((k & 4) << 1) | ((k & 8) >> 1); return ((kk >> 3) * 4 + (c >> 5)) * 512 + ((kk & 7) * 32 + (c & 31)) * 2; }
__device__ __forceinline__ int v_rd_base(int lane) { return ((lane & 3) << 3) | (((lane >> 2) & 3) << 6) | (((lane >> 4) & 1) << 5) | (((lane >> 5) & 1) << 8); }
constexpr int v_rd_off(int d0, int ks, int half) { return d0 * 512 + ks * 4096 + half * 2048; }
template <int OFF> __device__ __forceinline__ s16x4 tr_read(int vb) {
  s16x4 r; asm volatile("ds_read_b64_tr_b16 %0, %1 offset:%2" : "=&v"(r) : "v"(vb), "i"(OFF) : "memory"); return r;
}
template <int D0> __device__ __forceinline__ void pv_one(f32x16& od, int vb, bf16x8 pa0, bf16x8 pa1, bf16x8 pa2, bf16x8 pa3) {
  const s16x4 l0 = tr_read<v_rd_off(D0, 0, 0)>(vb), h0 = tr_read<v_rd_off(D0, 0, 1)>(vb), l1 = tr_read<v_rd_off(D0, 1, 0)>(vb), h1 = tr_read<v_rd_off(D0, 1, 1)>(vb);
  const s16x4 l2 = tr_read<v_rd_off(D0, 2, 0)>(vb), h2 = tr_read<v_rd_off(D0, 2, 1)>(vb), l3 = tr_read<v_rd_off(D0, 3, 0)>(vb), h3 = tr_read<v_rd_off(D0, 3, 1)>(vb);
  asm volatile("s_waitcnt lgkmcnt(0)" ::: "memory"); SBAR();
#define PK(L, H) (bf16x8){L[0], L[1], L[2], L[3], H[0], H[1], H[2], H[3]}
  od = __builtin_amdgcn_mfma_f32_32x32x16_bf16(pa0, PK(l0, h0), od, 0, 0, 0);
  od = __builtin_amdgcn_mfma_f32_32x32x16_bf16(pa1, PK(l1, h1), od, 0, 0, 0);
  od = __builtin_amdgcn_mfma_f32_32x32x16_bf16(pa2, PK(l2, h2), od, 0, 0, 0);
  od = __builtin_amdgcn_mfma_f32_32x32x16_bf16(pa3, PK(l3, h3), od, 0, 0, 0);
#undef PK
}
__device__ __forceinline__ void pv_d0(f32x16* o, int vb, bf16x8 pa0, bf16x8 pa1, bf16x8 pa2, bf16x8 pa3) {
  pv_one<0>(o[0], vb, pa0, pa1, pa2, pa3); pv_one<1>(o[1], vb, pa0, pa1, pa2, pa3); pv_one<2>(o[2], vb, pa0, pa1, pa2, pa3); pv_one<3>(o[3], vb, pa0, pa1, pa2, pa3);
}

typedef __attribute__((address_space(3))) const char* lds_cptr;
typedef short v4i16_t __attribute__((ext_vector_type(4)));
__device__ __forceinline__ s16x4 vtr(lds_cptr p) { return __builtin_bit_cast(s16x4, __builtin_amdgcn_ds_read_tr16_b64_v4i16((__attribute__((address_space(3))) v4i16_t*)p)); }
__device__ __forceinline__ float max3f(float a, float b, float c) { return fmaxf(fmaxf(a, b), c); }
#define PIN(x) asm volatile("" : "+v"(x))
#define PK4R(P, BASE, OUT) do { unsigned a0 = cvtpk(P[BASE + 0], P[BASE + 1]), a1 = cvtpk(P[BASE + 2], P[BASE + 3]);   \
    unsigned b0 = cvtpk(P[BASE + 4], P[BASE + 5]), b1 = cvtpk(P[BASE + 6], P[BASE + 7]);                              \
    auto r0 = __builtin_amdgcn_permlane32_swap(a0, b0, false, false); auto r1 = __builtin_amdgcn_permlane32_swap(a1, b1, false, false); \
    u32x4 w = {r0[0], r1[0], r0[1], r1[1]}; OUT = *reinterpret_cast<bf16x8*>(&w); } while (0)
template <int DK, bool NOMAX>
__device__ __forceinline__ void qk_fs(f32x16& c0, f32x16& c1, const char* Ks, const bf16x8* qr, const int r32, const int hi,
                                      f32x16& p0, f32x16& p1, const float alpha, float& l_reg, bf16x8* pa,
                                      bf16x8 (&kf)[2][2], const lds_cptr vp, s16x4 (&vl)[5], s16x4 (&vh)[5]) {
  constexpr int NS = DK / 16, RPS = 16 / NS;
#define KRD_(S, D0) do { const int cb_ = ((D0) * 16 + hi * 8) * 2; \
    if constexpr (DK == 128) { kf[S][0] = *reinterpret_cast<const bf16x8*>(Ks + KSWZ128(r32, cb_)); kf[S][1] = *reinterpret_cast<const bf16x8*>(Ks + KSWZ128(32 + r32, cb_)); } \
    else { kf[S][0] = *reinterpret_cast<const bf16x8*>(Ks + KSWZ64(r32, cb_)); kf[S][1] = *reinterpret_cast<const bf16x8*>(Ks + KSWZ64(32 + r32, cb_)); } } while (0)
  float psa = 0.f, psb = 0.f;
  SBAR();
#pragma unroll
  for (int d0 = 0; d0 < NS; ++d0) {
    if (d0 == 0) { c0 = __builtin_amdgcn_mfma_f32_32x32x16_bf16(kf[0][0], qr[0], f32x16{}, 0, 0, 0); c1 = __builtin_amdgcn_mfma_f32_32x32x16_bf16(kf[0][1], qr[0], f32x16{}, 0, 0, 0); }
    else { c0 = __builtin_amdgcn_mfma_f32_32x32x16_bf16(kf[d0 & 1][0], qr[d0], c0, 0, 0, 0); c1 = __builtin_amdgcn_mfma_f32_32x32x16_bf16(kf[d0 & 1][1], qr[d0], c1, 0, 0, 0); }
    if (d0 + 2 < NS) KRD_(d0 & 1, d0 + 2);
    if constexpr (NOMAX) { }
    else {
#pragma unroll
    for (int r = d0 * RPS; r < (d0 + 1) * RPS; ++r) { p1[r] = __builtin_amdgcn_exp2f(p1[r]); psa += p0[r]; }
    if (d0 > 0) {
#pragma unroll
      for (int r = (d0 - 1) * RPS; r < d0 * RPS; ++r) psb += p1[r]; } }
    if constexpr (NOMAX) {
      if (d0 == NS / 4 - 1) { PK4R(p0, 0, pa[0]); PIN(pa[0]); }
      if (d0 == NS / 2 - 1) { PK4R(p0, 8, pa[1]); PIN(pa[1]); }
      if (d0 == 3 * NS / 4 - 1) { PK4R(p1, 0, pa[2]); PIN(pa[2]); }
      if (d0 == NS - 1) { PK4R(p1, 8, pa[3]); PIN(pa[3]); }
    } else {
    if (d0 == NS / 2 - 1) { PK4R(p0, 0, pa[0]); PIN(pa[0]); }
    if (d0 == NS / 2) { PK4R(p0, 8, pa[1]); PIN(pa[1]); }
    if (d0 == NS - 1) { PK4R(p1, 0, pa[2]); PIN(pa[2]); }
    }
    if (d0 == NS - 1) {
      vl[0] = vtr(vp + v_rd_off(0, 0, 0)); vh[0] = vtr(vp + v_rd_off(0, 0, 1)); vl[1] = vtr(vp + v_rd_off(1, 0, 0)); vh[1] = vtr(vp + v_rd_off(1, 0, 1));
      vl[2] = vtr(vp + v_rd_off(2, 0, 0)); vh[2] = vtr(vp + v_rd_off(2, 0, 1)); vl[3] = vtr(vp + v_rd_off(3, 0, 0)); vh[3] = vtr(vp + v_rd_off(3, 0, 1)); }
    PIN(p1); PIN(psa); PIN(psb);
    SBAR();
  }
#undef KRD_
  if constexpr (!NOMAX) {
#pragma unroll
  for (int r = (NS - 1) * RPS; r < 16; ++r) psb += p1[r];
  float ps = psa + psb;
  { auto rr = __builtin_amdgcn_permlane32_swap(__float_as_uint(ps), __float_as_uint(ps), false, false);
    ps = __uint_as_float(rr[0]) + __uint_as_float(rr[1]); }
  l_reg = l_reg * alpha + ps;
  PK4R(p1, 8, pa[3]); }
}
template <int DK, bool NOMAX>
__device__ __forceinline__ void pv_psm(f32x16* o, const lds_cptr vp, const bf16x8* pa, f32x16& c0, f32x16& c1, float& m_reg, float& alpha, const float cb,
                                       s16x4 (&vl)[5], s16x4 (&vh)[5], bf16x8 (&kf)[2][2], const char* Kn, const int r32, const int hi, float& l_reg,
                                       const bool dk, const bool dv, const bf16_t* gk0, const bf16_t* gk1, const bf16_t* gv0, const bf16_t* gv1,
                                       __attribute__((address_space(3))) unsigned* lk, __attribute__((address_space(3))) unsigned* lv) {
  typedef __attribute__((address_space(3))) unsigned* lds_up; typedef __attribute__((address_space(3))) char* lds_cp;
  float psa = 0.f, psb = 0.f;
#define VRD_(S, I) do { vl[S] = vtr(vp + v_rd_off((I) & 3, (I) >> 2, 0)); vh[S] = vtr(vp + v_rd_off((I) & 3, (I) >> 2, 1)); } while (0)
#define VFR_(S) (bf16x8){vl[S][0], vl[S][1], vl[S][2], vl[S][3], vh[S][0], vh[S][1], vh[S][2], vh[S][3]}
  float ma = 0.f, mb = 0.f, mnC = 0.f;
  SBAR();
#pragma unroll
  for (int i = 0; i < 16; ++i) {
    if (i + 4 < 16) VRD_((i + 4) % 5, i + 4);
    if (i == 1) { if (dk) __builtin_amdgcn_global_load_lds((const unsigned*)gk0, lk, 16, 0, 0); }
    if (i == 3) { if constexpr (DK == 128) { if (dk) __builtin_amdgcn_global_load_lds((const unsigned*)gk1, (lds_up)((lds_cp)lk + 8192), 16, 0, 0); } }
    if (i == 5) { if (dv) __builtin_amdgcn_global_load_lds((const unsigned*)gv0, lv, 16, 0, 0); }
    if (i == 7) { if (dv) __builtin_amdgcn_global_load_lds((const unsigned*)gv1, (lds_up)((lds_cp)lv + 8192), 16, 0, 0); }
    if (i == 12 || i == 13) { const int cb_ = ((i - 12) * 16 + hi * 8) * 2;
      if constexpr (DK == 128) { kf[i - 12][0] = *reinterpret_cast<const bf16x8*>(Kn + KSWZ128(r32, cb_)); kf[i - 12][1] = *reinterpret_cast<const bf16x8*>(Kn + KSWZ128(32 + r32, cb_)); }
      else { kf[i - 12][0] = *reinterpret_cast<const bf16x8*>(Kn + KSWZ64(r32, cb_)); kf[i - 12][1] = *reinterpret_cast<const bf16x8*>(Kn + KSWZ64(32 + r32, cb_)); } }
    SBAR();
    o[i & 3] = __builtin_amdgcn_mfma_f32_32x32x16_bf16(pa[i >> 2], VFR_(i % 5), o[i & 3], 0, 0, 0);
    if constexpr (NOMAX) { c0[i] = __builtin_amdgcn_exp2f(c0[i]); c1[i] = __builtin_amdgcn_exp2f(c1[i]); if (i > 0) { psa += c0[i - 1]; psb += c1[i - 1]; } PIN(c0); PIN(c1); PIN(psa); PIN(psb); }
    else {
    if (i == 0) { ma = max3f(c0[0], c0[1], c1[0]); mb = max3f(c0[2], c0[3], c1[1]); ma = max3f(ma, c1[2], c1[3]); }
    if (i >= 1 && i <= 3) { const int r = 4 * i; ma = max3f(ma, c0[r], c0[r + 1]); mb = max3f(mb, c0[r + 2], c0[r + 3]); ma = max3f(ma, c1[r], c1[r + 1]); mb = max3f(mb, c1[r + 2], c1[r + 3]); }
    if (i == 4) { float pmax = fmaxf(ma, mb);
      { auto rr = __builtin_amdgcn_permlane32_swap(__float_as_uint(pmax), __float_as_uint(pmax), false, false);
        pmax = fmaxf(__uint_as_float(rr[0]), __uint_as_float(rr[1])); }
      pmax += cb;
      const bool keep = __all(pmax - m_reg <= THR2);
      const float mn = keep ? m_reg : fmaxf(m_reg, pmax);
      alpha = __builtin_amdgcn_exp2f(m_reg - mn); m_reg = mn; mnC = cb - mn; }
    if (i >= 5 && i <= 8) { const int r = 4 * (i - 5);
#pragma unroll
      for (int q = 0; q < 4; ++q) { c0[r + q] += mnC; c1[r + q] += mnC; } }
    if (i >= 9) { const int r0 = (i - 9) * 2 + (i > 14 ? 1 : 0), n = i >= 14 ? 3 : 2;
#pragma unroll
      for (int q = 0; q < n; ++q) c0[r0 + q] = __builtin_amdgcn_exp2f(c0[r0 + q]); }
    if (i <= 3) { PIN(ma); PIN(mb); }
    if (i == 4) { PIN(mnC); PIN(alpha); PIN(m_reg); }
    if (i >= 5 && i <= 8) { PIN(c0); PIN(c1); }
    if (i >= 9) PIN(c0);
    }
    SBAR();
  }
#undef VRD_
#undef VFR_
  if constexpr (NOMAX) { float ps = (psa + c0[15]) + (psb + c1[15]);
    { auto rr = __builtin_amdgcn_permlane32_swap(__float_as_uint(ps), __float_as_uint(ps), false, false);
      ps = __uint_as_float(rr[0]) + __uint_as_float(rr[1]); }
    l_reg = l_reg * alpha + ps; }
}

constexpr int RING_K = 0, RING_V = 4 * SHM_K;
template <int DK, int LDK, bool BIAS, bool NOMAX>
__device__ __forceinline__ void flash_pass(const bf16x8* qr, const bf16_t* __restrict__ Kh, const bf16_t* __restrict__ Vh, const int seq, char* lds,
                                           f32x16* o, float& l_out, const int qlo, const float b_neg, const float b_pos) {
  int tid_ = threadIdx.x; asm volatile("" : "+v"(tid_));
  const int tid = tid_, lane = tid & 63, r32 = lane & 31, hi = lane >> 5; const int wid = __builtin_amdgcn_readfirstlane(tid >> 6);
  typedef __attribute__((address_space(3))) unsigned* lds_uptr;
  char* K_lds = lds + RING_K; char* V_lds = lds + RING_V;
  float* ws = (float*)(lds + LDS_WSOFF) + wid * 64; float* al_l = ws + 32;
  const float* tb = (const float*)(lds + LDS_TB);
  float m_reg = -1e30f, l_reg = 0.f;
  o[0] = f32x16{}; o[1] = f32x16{}; o[2] = f32x16{}; o[3] = f32x16{};
  int koff0, koff1 = 0, voff0, voff1;
  if constexpr (DK == 128) { { const int r = 4 * wid + (lane >> 4), c = (lane & 15) ^ (r & 7); koff0 = r * LDK + c * 8; }
                             { const int r = 4 * (wid + 8) + (lane >> 4), c = (lane & 15) ^ (r & 7); koff1 = r * LDK + c * 8; } }
  else { const int r = 8 * wid + (lane >> 3), c = (lane & 7) ^ ((r >> 1) & 7); koff0 = r * LDK + c * 8; }
  { const int st = 2 * wid + (lane >> 5), kk = (st >> 2) * 8 + ((lane & 31) >> 2), k = (kk & ~0xC) | ((kk & 4) << 1) | ((kk & 8) >> 1); voff0 = k * LDK + (st & 3) * 32 + (lane & 3) * 8; }
  { const int st = 2 * (wid + 8) + (lane >> 5), kk = (st >> 2) * 8 + ((lane & 31) >> 2), k = (kk & ~0xC) | ((kk & 4) << 1) | ((kk & 8) >> 1); voff1 = k * LDK + (st & 3) * 32 + (lane & 3) * 8; }
  const bf16_t* ks0 = Kh + koff0; const bf16_t* ks1 = Kh + koff1; const bf16_t* vs0 = Vh + voff0; const bf16_t* vs1 = Vh + voff1;
  const lds_uptr kdst = (lds_uptr)(K_lds + wid * 1024), vdst = (lds_uptr)(V_lds + wid * 1024);
#define GLDS(G, L) __builtin_amdgcn_global_load_lds((const unsigned*)(G), (L), 16, 0, 0)
#define DMA_K(T, SL) do { const long t_ = (long)(T) * (KVBLK * LDK); GLDS(ks0 + t_, (lds_uptr)((__attribute__((address_space(3))) char*)kdst + (SL))); \
    if constexpr (DK == 128) GLDS(ks1 + t_, (lds_uptr)((__attribute__((address_space(3))) char*)kdst + (SL) + 8192)); } while (0)
#define DMA_V(T, SL) do { const long t_ = (long)(T) * (KVBLK * LDK); GLDS(vs0 + t_, (lds_uptr)((__attribute__((address_space(3))) char*)vdst + (SL))); \
    GLDS(vs1 + t_, (lds_uptr)((__attribute__((address_space(3))) char*)vdst + (SL) + 8192)); } while (0)
#define WBAR(N) asm volatile("s_waitcnt vmcnt(" #N ") lgkmcnt(0)\n\ts_barrier" ::: "memory")
#define RESC(a) do { if (__any((a) != 1.f)) { if (hi == 0) al_l[r32] = (a); asm volatile("s_waitcnt lgkmcnt(0)" ::: "memory"); \
    _Pragma("unroll") for (int d = 0; d < 4; ++d) _Pragma("unroll") for (int r = 0; r < 16; ++r) o[d][r] *= al_l[crow(r, hi)]; } } while (0)
#define PSM(P0, P1, T, MN, AL) do { float cb_ = 0.f; \
    if constexpr (BIAS) { const int k0_ = (T) * KVBLK; const int rmin_ = k0_ - (qlo + 31), rmax_ = k0_ + 63 - qlo; \
      if (rmin_ >= 91) cb_ = b_pos; else if (rmax_ <= -91) cb_ = b_neg; \
      else add_bias(P0, P1, tb, k0_ - (qlo + r32) + 256, hi); } \
    partialSM<DK>(P0, P1, m_reg, MN, AL, cb_); } while (0)
#define TBIAS(P0, P1, T) float cb_ = 0.f; \
    if constexpr (BIAS) { const int k0_ = (T) * KVBLK; const int rmin_ = k0_ - (qlo + 31), rmax_ = k0_ + 63 - qlo; \
      if (rmin_ >= 91) cb_ = b_pos; else if (rmax_ <= -91) cb_ = b_neg; \
      else add_bias(P0, P1, tb, k0_ - (qlo + r32) + 256, hi); }
  float curb = 0.f;
  f32x16 pA0, pA1, pB0, pB1; float mnA, alA, alB; bf16x8 pa[4]; const int NT = seq / KVBLK;
  const lds_cptr vp0 = (lds_cptr)V_lds + v_rd_base(lane);
  const int vb0 = (int)(uintptr_t)V_lds + v_rd_base(lane);
  WBAR(0);
  DMA_K(0, 0); DMA_V(0, 0); DMA_K(1, SHM_K); DMA_K(2, 2 * SHM_K);
  if constexpr (DK == 128) WBAR(6); else WBAR(4);
  qkt<DK>(pA0, pA1, K_lds, qr, r32, hi);
  if constexpr (NOMAX) { TBIAS(pA0, pA1, 0); curb = cb_; alA = 1.f;
#pragma unroll
    for (int r = 0; r < 16; ++r) { pA0[r] = __builtin_amdgcn_exp2f(pA0[r]); pA1[r] = __builtin_amdgcn_exp2f(pA1[r]); }
    float ps0 = 0.f;
#pragma unroll
    for (int r = 0; r < 16; ++r) ps0 += pA0[r] + pA1[r];
    { auto rr = __builtin_amdgcn_permlane32_swap(__float_as_uint(ps0), __float_as_uint(ps0), false, false);
      ps0 = __uint_as_float(rr[0]) + __uint_as_float(rr[1]); }
    l_reg = ps0; }
  else PSM(pA0, pA1, 0, mnA, alA);
  DMA_K(3, 3 * SHM_K); DMA_V(1, SHM_V);
  if constexpr (DK == 128) WBAR(4); else WBAR(3);
  bf16x8 kf[2][2]; s16x4 vl[5], vh[5];
#pragma unroll
  for (int q = 0; q < 2; ++q) { const int cbq = (q * 16 + hi * 8) * 2;
    if constexpr (DK == 128) { kf[q][0] = *reinterpret_cast<const bf16x8*>(K_lds + SHM_K + KSWZ128(r32, cbq)); kf[q][1] = *reinterpret_cast<const bf16x8*>(K_lds + SHM_K + KSWZ128(32 + r32, cbq)); }
    else { kf[q][0] = *reinterpret_cast<const bf16x8*>(K_lds + SHM_K + KSWZ64(r32, cbq)); kf[q][1] = *reinterpret_cast<const bf16x8*>(K_lds + SHM_K + KSWZ64(32 + r32, cbq)); } }
  int sp = 0, sj = SHM_V, sn = 2 * SHM_V;
#define STEPT(C0, C1, P0, P1, ALP, ALC, J) do { \
    qk_fs<DK, NOMAX>(C0, C1, K_lds + ((J) & 3) * SHM_K, qr, r32, hi, P0, P1, ALP, l_reg, pa, kf, vp0 + sp, vl, vh); \
    SBAR(); \
    { TBIAS(C0, C1, J); if constexpr (NOMAX) { ALC = __builtin_amdgcn_exp2f(curb - cb_); curb = cb_; } \
      const long tk_ = (long)((J) + 3) * (KVBLK * LDK), tv_ = (long)((J) + 1) * (KVBLK * LDK); \
      pv_psm<DK, NOMAX>(o, vp0 + sp, pa, C0, C1, m_reg, ALC, cb_, vl, vh, kf, K_lds + (((J) + 1) & 3) * SHM_K, r32, hi, l_reg, \
                        (J) + 3 < NT, (J) + 1 < NT, ks0 + tk_, ks1 + tk_, vs0 + tv_, vs1 + tv_, \
                        (lds_uptr)((__attribute__((address_space(3))) char*)kdst + (((J) + 3) & 3) * SHM_K), (lds_uptr)((__attribute__((address_space(3))) char*)vdst + sn)); } \
    RESC(ALC); \
    if ((J) + 3 < NT) { if constexpr (DK == 128) WBAR(4); else WBAR(3); } else WBAR(0); \
    { const int t_ = sp; sp = sj; sj = sn; sn = t_; } } while (0)
  for (int j = 1; j + 1 < NT; j += 2) {
    STEPT(pB0, pB1, pA0, pA1, alA, alB, j);
    STEPT(pA0, pA1, pB0, pB1, alB, alA, j + 1);
  }
  STEPT(pB0, pB1, pA0, pA1, alA, alB, NT - 1);
  if constexpr (NOMAX) { PK4R(pB0, 0, pa[0]); PK4R(pB0, 8, pa[1]); PK4R(pB1, 0, pa[2]); PK4R(pB1, 8, pa[3]); }
  else finishSM<false>(pB0, pB1, alB, l_reg, pa[0], pa[1], pa[2], pa[3]);
  SBAR();
  pv_d0(o, vb0 + sp, pa[0], pa[1], pa[2], pa[3]);
  l_out = l_reg;
#undef GLDS
#undef DMA_K
#undef DMA_V
#undef WBAR
#undef RESC
#undef PSM
#undef TBIAS
#undef STEPT
}
__device__ __forceinline__ void row_rcp(float l_reg, float* ws, int r32, int hi, float* rli) {
  if (hi == 0) ws[r32] = l_reg; asm volatile("s_waitcnt lgkmcnt(0)" ::: "memory");
#pragma unroll
  for (int r = 0; r < 16; ++r) rli[r] = __builtin_amdgcn_rcpf(ws[crow(r, hi)]);
  asm volatile("s_waitcnt lgkmcnt(0)" ::: "memory");
}
__device__ __forceinline__ float silu(float z) { return z * __builtin_amdgcn_rcpf(1.0f + __builtin_amdgcn_exp2f(-1.4426950408889634f * z)); }
constexpr int STG_LD = 132;
constexpr int STG_WAVE = 32 * STG_LD * 4;
template <bool NORM>
__device__ __forceinline__ void out_rows(const f32x16* o, const float* rli_or_null, char* lds, const float* gain, const float gscale,
                                         const bf16_t* Z, bf16_t* O, const size_t obase  ) {
  int tid_ = threadIdx.x; asm volatile("" : "+v"(tid_));
  const int tid = tid_, wid = tid >> 6, lane = tid & 63, r32 = lane & 31, hi = lane >> 5;
  float* stg = (float*)(lds + wid * STG_WAVE);
  const int c8 = (lane & 15) * 8, rsub = lane >> 4;
  u32x4 zq[8];
#pragma unroll
  for (int it = 0; it < 8; ++it) zq[it] = *(const u32x4*)(Z + obase + (size_t)(it * 4 + rsub) * 1024 + c8);
#pragma unroll
  for (int d0 = 0; d0 < 4; ++d0)
#pragma unroll
    for (int r = 0; r < 16; ++r) stg[crow(r, hi) * STG_LD + d0 * 32 + r32] = rli_or_null ? o[d0][r] * rli_or_null[r] : o[d0][r];
  asm volatile("s_waitcnt lgkmcnt(0)" ::: "memory");
  f32x4 g0 = {1.f, 1.f, 1.f, 1.f}, g1 = {1.f, 1.f, 1.f, 1.f};
  if constexpr (NORM) { g0 = *(const f32x4*)(gain + c8) * gscale; g1 = *(const f32x4*)(gain + c8 + 4) * gscale; }
#pragma unroll
  for (int it = 0; it < 8; ++it) { const int row = it * 4 + rsub;
    f32x4 v0 = *(const f32x4*)(stg + row * STG_LD + c8), v1 = *(const f32x4*)(stg + row * STG_LD + c8 + 4);
    const size_t off = obase + (size_t)row * 1024 + c8;
    const u32x4 zv = zq[it];
    if constexpr (NORM) {
      float ssq = (v0[0] * v0[0] + v0[1] * v0[1]) + (v0[2] * v0[2] + v0[3] * v0[3]) + (v1[0] * v1[0] + v1[1] * v1[1]) + (v1[2] * v1[2] + v1[3] * v1[3]);
      ssq += __shfl_xor(ssq, 1); ssq += __shfl_xor(ssq, 2); ssq += __shfl_xor(ssq, 4); ssq += __shfl_xor(ssq, 8);
      const float rstd = __builtin_amdgcn_rsqf(ssq * (1.0f / 128.0f) + 1e-6f);
      v0 = v0 * rstd * g0; v1 = v1 * rstd * g1; }
    v0[0] *= silu(__uint_as_float(zv.x << 16)); v0[1] *= silu(__uint_as_float(zv.x & 0xffff0000u));
    v0[2] *= silu(__uint_as_float(zv.y << 16)); v0[3] *= silu(__uint_as_float(zv.y & 0xffff0000u));
    v1[0] *= silu(__uint_as_float(zv.z << 16)); v1[1] *= silu(__uint_as_float(zv.z & 0xffff0000u));
    v1[2] *= silu(__uint_as_float(zv.w << 16)); v1[3] *= silu(__uint_as_float(zv.w & 0xffff0000u));
    u32x4 w = {cvtpk(v0[0], v0[1]), cvtpk(v0[2], v0[3]), cvtpk(v1[0], v1[1]), cvtpk(v1[2], v1[3])};
    __builtin_nontemporal_store(w, (u32x4*)(O + off)); }
}

__device__ __forceinline__ void item_a(bf16_t* OUT, const bf16_t* QA, const bf16_t* KA, const bf16_t* VA, const bf16_t* ZA, const float* tabA, const float* subln, const float lam,
                                       float* scr, const int rowbase, const int q0, const int h, const int S, char* lds) {
  int tid_ = threadIdx.x; asm volatile("" : "+v"(tid_));
  const int tid = tid_, wid = tid >> 6, lane = tid & 63, r32 = lane & 31, hi = lane >> 5;
  float* tb = (float*)(lds + LDS_TB); float* ws = (float*)(lds + LDS_WSOFF) + wid * 64;
  tb[tid] = tabA[h * 512 + tid];
  const float b_neg = tabA[h * 512], b_pos = tabA[h * 512 + 511];
  const int qlo = q0 + wid * 32;
  const bf16_t* Kh = KA + (size_t)rowbase * 1024 + h * 128; const bf16_t* Vh = VA + (size_t)rowbase * 1024 + h * 128;
  const bf16_t* Qrow = QA + (size_t)(rowbase + qlo + r32) * 1024 + h * 128 + hi * 8;
  f32x16 o[4]; float l; bf16x8 qr[4];
#pragma unroll 1
  for (int mp = 0; mp < 2; ++mp) {
#pragma unroll
    for (int d0 = 0; d0 < 4; ++d0) qr[d0] = ld8(Qrow + mp * 64 + d0 * 16);
    volatile unsigned* badf = (volatile unsigned*)(lds + LDS_TB + 2048);
    if (tid == 0) *badf = 0u;
    flash_pass<64, 1024, true, true>(qr, Kh + mp * 64, Vh, S, lds, o, l, qlo, b_neg, b_pos);
    if (!(l > 1e-30f && l < 1e30f)) *badf = 1u;
    __syncthreads(); const unsigned redo = (PROBE == 20) ? 1u : *badf; __syncthreads();
    if (redo != 0u) flash_pass<64, 1024, true, false>(qr, Kh + mp * 64, Vh, S, lds, o, l, qlo, b_neg, b_pos);
    float rli[16]; row_rcp(l, ws, r32, hi, rli);
    if (mp == 0) {
#pragma unroll
      for (int d0 = 0; d0 < 4; ++d0)
#pragma unroll
        for (int r = 0; r < 16; r += 8) { u32x4 w;
          w.x = cvtpk(o[d0][r] * rli[r], o[d0][r + 1] * rli[r + 1]);         w.y = cvtpk(o[d0][r + 2] * rli[r + 2], o[d0][r + 3] * rli[r + 3]);
          w.z = cvtpk(o[d0][r + 4] * rli[r + 4], o[d0][r + 5] * rli[r + 5]); w.w = cvtpk(o[d0][r + 6] * rli[r + 6], o[d0][r + 7] * rli[r + 7]);
          ((u32x4*)(scr + tid * 32))[d0 * 2 + (r >> 3)] = w; }
    } else {
#pragma unroll
      for (int d0 = 0; d0 < 4; ++d0)
#pragma unroll
        for (int r = 0; r < 16; r += 8) { const u32x4 w = ((const u32x4*)(scr + tid * 32))[d0 * 2 + (r >> 3)];
          const unsigned ww[4] = {w.x, w.y, w.z, w.w};
#pragma unroll
          for (int q = 0; q < 4; ++q) { o[d0][r + 2 * q] = __uint_as_float(ww[q] << 16) - lam * (o[d0][r + 2 * q] * rli[r + 2 * q]);
            o[d0][r + 2 * q + 1] = __uint_as_float(ww[q] & 0xffff0000u) - lam * (o[d0][r + 2 * q + 1] * rli[r + 2 * q + 1]); } }
    }
  }
  __syncthreads();
  out_rows<true>(o, nullptr, lds, subln, 0.8f, ZA, OUT, (size_t)(rowbase + qlo) * 1024 + h * 128);
  __syncthreads();
}

__device__ __forceinline__ void item_b(bf16_t* OUT, const bf16_t* QB, const bf16_t* KB, const bf16_t* VB, const bf16_t* ZB, const float* qg, const f32x2* rt,
                                       const int rowbase, const int q0, const int h, const int S, char* lds) {
  int tid_ = threadIdx.x; asm volatile("" : "+v"(tid_));
  const int tid = tid_, wid = tid >> 6, lane = tid & 63, r32 = lane & 31, hi = lane >> 5;
  float* ws = (float*)(lds + LDS_WSOFF) + wid * 64;
  const int qlo = q0 + wid * 32, t = qlo + r32, kvh = h >> 2;
  const bf16_t* Kh = KB + (size_t)rowbase * 256 + kvh * 128; const bf16_t* Vh = VB + (size_t)rowbase * 256 + kvh * 128;
  const bf16_t* Qrow = QB + (size_t)(rowbase + t) * 1024 + h * 128 + hi * 8;
  bf16x8 qr[8];
  { float f[8][8]; float ssq = 0.f;
#pragma unroll
    for (int d0 = 0; d0 < 8; ++d0) { const bf16x8 raw = ld8(Qrow + d0 * 16);
#pragma unroll
      for (int j = 0; j < 8; ++j) { f[d0][j] = bf2f(raw[j]); ssq += f[d0][j] * f[d0][j]; } }
    { auto rr = __builtin_amdgcn_permlane32_swap(__float_as_uint(ssq), __float_as_uint(ssq), false, false);
      ssq = __uint_as_float(rr[0]) + __uint_as_float(rr[1]); }
    const float rstd = __builtin_amdgcn_rsqf(ssq * (1.0f / 128.0f) + 1e-6f) * (0.08838834764831845f * 1.4426950408889634f);
#pragma unroll
    for (int d0 = 0; d0 < 8; ++d0) { const f32x4 g0 = *(const f32x4*)(qg + d0 * 16 + hi * 8), g1 = *(const f32x4*)(qg + d0 * 16 + hi * 8 + 4);
#pragma unroll
      for (int j = 0; j < 4; ++j) { f[d0][j] *= rstd * g0[j]; f[d0][4 + j] *= rstd * g1[j]; } }
#pragma unroll
    for (int hf = 0; hf < 2; ++hf) { const int idx = hf == 0 ? (t >> 6) : (t & 63);
#pragma unroll
      for (int dp = 0; dp < 2; ++dp)
#pragma unroll
        for (int j = 0; j < 8; ++j) { const f32x2 cs = rt[idx * 32 + dp * 16 + hi * 8 + j];
          const float u1 = f[hf * 4 + dp][j], u2 = f[hf * 4 + dp + 2][j];
          f[hf * 4 + dp][j] = u1 * cs.x - u2 * cs.y; f[hf * 4 + dp + 2][j] = u1 * cs.y + u2 * cs.x; } }
#pragma unroll
    for (int d0 = 0; d0 < 8; ++d0) { u32x4 w = {cvtpk(f[d0][0], f[d0][1]), cvtpk(f[d0][2], f[d0][3]), cvtpk(f[d0][4], f[d0][5]), cvtpk(f[d0][6], f[d0][7])};
      qr[d0] = *reinterpret_cast<bf16x8*>(&w); }
  }
  f32x16 o[4]; float l; float rli[16];
  volatile unsigned* badf = (volatile unsigned*)(lds + LDS_TB + 2048);
  if (tid == 0) *badf = 0u;
  flash_pass<128, 256, false, true>(qr, Kh, Vh, S, lds, o, l, qlo, 0.f, 0.f);
  if (!(l > 1e-30f && l < 1e30f)) *badf = 1u;
  __syncthreads(); const unsigned redo = (PROBE == 20) ? 1u : *badf; __syncthreads();
  if (redo != 0u) flash_pass<128, 256, false, false>(qr, Kh, Vh, S, lds, o, l, qlo, 0.f, 0.f);
  row_rcp(l, ws, r32, hi, rli);
  __syncthreads();
  out_rows<false>(o, rli, lds, nullptr, 1.f, ZB, OUT, (size_t)(rowbase + qlo) * 1024 + h * 128);
  __syncthreads();
}
#undef SBAR
}
#define LAS __attribute__((address_space(3)))
typedef unsigned short bf16;
typedef unsigned v4u __attribute__((ext_vector_type(4)));
typedef float f32x4 __attribute__((ext_vector_type(4)));
typedef float f32x2 __attribute__((ext_vector_type(2)));
constexpr size_t MiB = 1u << 20;
constexpr size_t WS_WIN = 2 * MiB, WS_WPA = 20 * MiB, WS_WPB = 22 * MiB, WS_WOUT = 24 * MiB, WS_TAB = 26 * MiB;
constexpr size_t WS_XN = 32 * MiB;
constexpr size_t WS_BIG = 192 * MiB;
constexpr size_t WS_KB = 960 * MiB, WS_VB = 984 * MiB;
constexpr size_t WS_SCR = 1008 * MiB;
constexpr size_t WS_END = 1040 * MiB;
constexpr size_t TAB_BIAS = 0, TAB_ROPE = 16384, TAB_LAM = 16384 + 32768;
constexpr int LDS_BYTES = 147456;
constexpr int NWAVES = 8;

__device__ __forceinline__ unsigned f2bf(float f) { unsigned u = __builtin_bit_cast(unsigned, f); return (u + 0x7fffu + ((u >> 16) & 1u)) >> 16; }
__device__ __forceinline__ unsigned pk2(float lo, float hi) { return f2bf(lo) | (f2bf(hi) << 16); }
__device__ __forceinline__ float wave_sum(float v) {
#pragma unroll
    for (int o = 1; o < 64; o <<= 1) v += __shfl_xor(v, o);
    return v;
}
#define LDS_WAIT() asm volatile("s_waitcnt lgkmcnt(0)" ::: "memory")
__device__ __forceinline__ void p0_transpose_item(const float* W, int K, int N, bf16* WT, LAS float* scr, int item, int lane) {
    const int nblk = N / 32, kb = item / nblk, nb = item % nblk, k0 = 64 * kb, n0 = 32 * nb;
#pragma unroll 8
    for (int i = 0; i < 32; ++i) { const int kk = 2 * i + (lane >> 5); scr[kk * 33 + (lane & 31)] = W[(size_t)(k0 + kk) * N + n0 + (lane & 31)]; }
    LDS_WAIT(); asm volatile("" ::: "memory");
    const int c = lane & 7;
#pragma unroll
    for (int j = 0; j < 4; ++j) { const int n = (lane >> 3) + 8 * j; const LAS float* s = scr + (8 * c) * 33 + n;
        v4u o; o.x = pk2(s[0 * 33], s[1 * 33]); o.y = pk2(s[2 * 33], s[3 * 33]); o.z = pk2(s[4 * 33], s[5 * 33]); o.w = pk2(s[6 * 33], s[7 * 33]);
        *(v4u*)(WT + (size_t)(n0 + n) * K + k0 + 8 * c) = o; }
    LDS_WAIT(); asm volatile("" ::: "memory");
}

typedef __attribute__((address_space(1))) unsigned gu32;
#define XB_TMO      128
#define XB_XCNT(j)  (256  + 64 * (j))
#define XB_XSUB(j)  (1280 + 64 * (j))
#define XB_XGEN(j)  (2304 + 64 * (j))
#define XB_TOP      3328
#define XB_TOPGEN   3392
#define XCD_BAR_WORDS 3456
#define XB_SPIN_CAP (1u << 18)

__device__ __forceinline__ unsigned xb_ld(unsigned* p)              { return __hip_atomic_load(p, __ATOMIC_RELAXED, __HIP_MEMORY_SCOPE_AGENT); }
__device__ __forceinline__ unsigned xb_add(unsigned* p, unsigned v) { return __hip_atomic_fetch_add(p, v, __ATOMIC_RELAXED, __HIP_MEMORY_SCOPE_AGENT); }
__device__ __forceinline__ unsigned xb_xcc_id() { return (unsigned)__builtin_amdgcn_s_getreg((3 << 11) | 20) & 0xFu; }
#define XB_SPIN(cond, bar) do { unsigned _sp = 0; while (cond) { __builtin_amdgcn_s_sleep(1); \
    if ((++_sp & 255u) == 0u) { if (xb_ld(&(bar)[XB_TMO])) break; if (_sp > XB_SPIN_CAP) { atomicAdd(&(bar)[XB_TMO], 1u); break; } } } } while (0)

struct XcdBarrier {
    unsigned* bar; unsigned x;
    volatile LAS unsigned* st;
};

__device__ __forceinline__ XcdBarrier xcd_barrier_post(unsigned* bar, volatile LAS unsigned* st) {
    XcdBarrier b; b.bar = bar; b.x = xb_xcc_id(); b.st = st;
    if (threadIdx.x == 0) (void)xb_add(&bar[XB_XCNT(b.x)], 1u);
    return b;
}
__device__ __forceinline__ void xcd_barrier_complete(unsigned* bar, unsigned x, unsigned& nloc, unsigned& nx) {
    const unsigned G = gridDim.x * gridDim.y * gridDim.z;
    unsigned sum, cnt, mine, sp = 0u;
    for (;;) {
        sum = 0u; cnt = 0u; mine = 0u;
#pragma unroll
        for (unsigned j = 0; j < 16; ++j) { const unsigned c = xb_ld(&bar[XB_XCNT(j)]); sum += c; cnt += (c > 0u) ? 1u : 0u; mine = (j == x) ? c : mine; }
        if (sum == G) break;
        __builtin_amdgcn_s_sleep(1);
        if ((++sp & 255u) == 0u) { if (xb_ld(&bar[XB_TMO])) break; if (sp > XB_SPIN_CAP) { atomicAdd(&bar[XB_TMO], 1u); break; } }
    }
    nloc = mine > 0u ? mine : 1u; nx = cnt > 0u ? cnt : 1u;
}

__device__ __forceinline__ void xcd_barrier(const XcdBarrier& b) {
    asm volatile("s_waitcnt vmcnt(0)" ::: "memory");
    __syncthreads();
    if (threadIdx.x == 0) {
        unsigned* bar = b.bar;
        __builtin_amdgcn_s_waitcnt(0);
        unsigned nloc = b.st[0], nx = b.st[1];
        if (nloc == 0u) { xcd_barrier_complete(bar, b.x, nloc, nx); b.st[0] = nloc; b.st[1] = nx; }
        const unsigned old = xb_add(&bar[XB_XSUB(b.x)], 1u);
        const unsigned gen = old / nloc;
        if (old + 1u == (gen + 1u) * nloc) {
            __builtin_amdgcn_fence(__ATOMIC_RELEASE, "agent");
            asm volatile("s_waitcnt vmcnt(0)" ::: "memory");
            const unsigned og = xb_add(&bar[XB_TOP], 1u);
            const unsigned tg = og / nx;
            if (og + 1u == (tg + 1u) * nx) xb_add(&bar[XB_TOPGEN], 1u);
            else XB_SPIN(xb_ld(&bar[XB_TOPGEN]) == tg, bar);
            __builtin_amdgcn_fence(__ATOMIC_ACQUIRE, "agent");
            xb_add(&bar[XB_XGEN(b.x)], 1u);
            asm volatile("s_waitcnt vmcnt(0)" ::: "memory");
        } else {
            XB_SPIN(xb_ld(&bar[XB_XGEN(b.x)]) == gen, bar);
            __builtin_amdgcn_fence(__ATOMIC_ACQUIRE, "agent");
            asm volatile("s_waitcnt vmcnt(0)" ::: "memory");
        }
    }
    __syncthreads();
}

struct Args { const float* in[16]; float* out; unsigned char* ws; };

__global__ void __launch_bounds__(NWAVES * 64, 2) fwd_mega(Args a) {
    extern __shared__ __attribute__((aligned(16))) unsigned char lds[];
    cg::grid_group grid = cg::this_grid();
    const int tid = threadIdx.x, lane = tid & 63, wave = __builtin_amdgcn_readfirstlane(tid >> 6);
    const int G = gridDim.x, bx = blockIdx.x;
    const int vcu = (G % 8 == 0) ? (bx % 8) * (G / 8) + bx / 8 : bx;
    unsigned char* ws = a.ws;
    volatile LAS unsigned* bar_st = (volatile LAS unsigned*)((LAS unsigned char*)lds + (LDS_BYTES - 64));
    if (tid < 2) bar_st[tid] = 0u;
    __syncthreads();
    const XcdBarrier xbar = xcd_barrier_post((unsigned*)ws, bar_st);
#define GRID_BAR() xcd_barrier(xbar)
    const float* xp = a.in[0]; const float* xs = a.in[1]; const float* g_norm = a.in[2]; const float* w_in = a.in[3];
    const float* lq1 = a.in[4]; const float* lk1 = a.in[5]; const float* lq2 = a.in[6]; const float* lk2 = a.in[7];
    const float* subln = a.in[8]; const float* qnb = a.in[9]; const float* knb = a.in[10];
    const float* w_pa = a.in[11]; const float* w_pb = a.in[12]; const float* w_out = a.in[13]; const float* rel_bias = a.in[14]; const float* g_final = a.in[15];
    bf16* WinT = (bf16*)(ws + WS_WIN); bf16* WpaT = (bf16*)(ws + WS_WPA); bf16* WpbT = (bf16*)(ws + WS_WPB); bf16* WoutT = (bf16*)(ws + WS_WOUT);
    float* tabA = (float*)(ws + WS_TAB + TAB_BIAS); f32x2* rt = (f32x2*)(ws + WS_TAB + TAB_ROPE); float* lamp = (float*)(ws + WS_TAB + TAB_LAM);
    bf16* XN = (bf16*)(ws + WS_XN);
    bf16* BIG = (bf16*)(ws + WS_BIG);
    bf16 *QA = BIG, *KA = BIG + pg8::BUFE, *VA = BIG + 2 * pg8::BUFE, *ZA = BIG + 3 * pg8::BUFE, *QB = BIG + 4 * pg8::BUFE, *ZB = BIG + 5 * pg8::BUFE, *GA = BIG + 6 * pg8::BUFE, *GB = BIG + 7 * pg8::BUFE;
    bf16* KB = (bf16*)(ws + WS_KB); bf16* VB = (bf16*)(ws + WS_VB);
    float* scr = (float*)(ws + WS_SCR) + (size_t)bx * 32768;
    const int gw = vcu * NWAVES + wave, NGW = G * NWAVES;

    for (int rep_ = 0; rep_ < (PROBE == 4 ? 2 : 1); ++rep_) {
        LAS float* tscr = (LAS float*)((LAS unsigned char*)lds + wave * 16384);
        constexpr int I_IN = (1024 / 64) * (NIN / 32), I_SQ = (1024 / 64) * (1024 / 32);
        for (int it = gw; it < I_IN + 3 * I_SQ; it += NGW) {
            int r = it;
            if (r < I_IN) { p0_transpose_item(w_in, 1024, NIN, WinT, tscr, r, lane); continue; } r -= I_IN;
            if (r < I_SQ) { p0_transpose_item(w_pa, 1024, 1024, WpaT, tscr, r, lane); continue; } r -= I_SQ;
            if (r < I_SQ) { p0_transpose_item(w_pb, 1024, 1024, WpbT, tscr, r, lane); continue; } r -= I_SQ;
            p0_transpose_item(w_out, 1024, 1024, WoutT, tscr, r, lane);
        }
        f32x4 gv[4];
#pragma unroll
        for (int j = 0; j < 4; ++j) gv[j] = ((const f32x4*)g_norm)[lane + 64 * j];
        for (int m0 = gw; m0 < NTOK; m0 += 4 * NGW) {
            f32x4 v[4][4]; float ssq[4];
#pragma unroll
            for (int q = 0; q < 4; ++q) { const int m = m0 + q * NGW; ssq[q] = 0.f; if (m >= NTOK) continue;
                const f32x4* xr = (const f32x4*)(m < NPTOK ? xp + (size_t)m * 1024 : xs + (size_t)(m - NPTOK) * 1024) + lane;
#pragma unroll
                for (int j = 0; j < 4; ++j) { v[q][j] = xr[64 * j]; ssq[q] += (v[q][j].x * v[q][j].x + v[q][j].y * v[q][j].y) + (v[q][j].z * v[q][j].z + v[q][j].w * v[q][j].w); } }
#pragma unroll
            for (int q = 0; q < 4; ++q) { const int m = m0 + q * NGW; if (m >= NTOK) continue;
                const float rstd = 1.0f / sqrtf(wave_sum(ssq[q]) * (1.f / 1024.f) + EPS);
                unsigned long long* o8 = (unsigned long long*)(XN + (size_t)m * 1024) + lane;
#pragma unroll
                for (int j = 0; j < 4; ++j) { const f32x4 w = v[q][j] * rstd * gv[j];
                    o8[64 * j] = (unsigned long long)pk2(w.x, w.y) | ((unsigned long long)pk2(w.z, w.w) << 32); } }
        }
        if (bx == G - 1) {
            for (int i = tid; i < 8 * 512; i += NWAVES * 64) { const int h = i >> 9, rel = (i & 511) - 256, n = rel < 0 ? -rel : rel;
                const int lg = n < 8 ? n : (n < 12 ? 8 : n < 16 ? 9 : n < 23 ? 10 : n < 32 ? 11 : n < 46 ? 12 : n < 64 ? 13 : n < 91 ? 14 : 15);
                tabA[i] = rel_bias[((rel > 0 ? 16 : 0) + lg) * 8 + h] * 1.4426950408889634f; }
            for (int i = tid; i < 128 * 32; i += NWAVES * 64) { const int idx = i >> 5, fi = i & 31;
                const float inv = __builtin_amdgcn_exp2f(-(float)fi * (13.287712379549449f / 32.0f));
                float rev = (float)idx * inv * 0.15915494309189535f; rev -= rintf(rev);
                rt[i] = (f32x2){__builtin_amdgcn_cosf(rev), __builtin_amdgcn_sinf(rev)}; }
            if (tid == 0) { float s1 = 0.f, s2 = 0.f; for (int i = 0; i < 64; ++i) { s1 += lq1[i] * lk1[i]; s2 += lq2[i] * lk2[i]; }
                lamp[0] = __expf(s1) - __expf(s2) + 0.2f; }
        }
    }
    grid.sync();
#if PROBE == 5
    for (int q_ = 0; q_ < 11; ++q_) GRID_BAR();
#endif
    const float lam = lamp[0];

    for (int g = 0; g < NGRP; ++g) {
        const int GM = g == 0 ? GMAX : G1ROWS, gbase = g == 0 ? 0 : G1BASE;
        bf16* MERGED = XN + (size_t)gbase * 1024;
        {
            pg8::Gemm gm{XN + (size_t)gbase * 1024, WinT, GM, NIN, 1024, nullptr, nullptr}; pg8::StaticOrder S; S.init(GM, NIN, G, bx);
            pg8::EpiProj E{BIG, KB, VB};
            pg8::gemm_phase<pg8::EpiProj, pg8::StaticOrder, true, true>((LAS unsigned char*)lds, gm, S, E);
#if PROBE == 3
            pg8::gemm_phase<pg8::EpiProj, pg8::StaticOrder, true, true>((LAS unsigned char*)lds, gm, S, E);
#endif
        }
        GRID_BAR();
        { int lane_k = threadIdx.x & 63; asm volatile("" : "+v"(lane_k));
          const int c = lane_k & 15, sub = lane_k >> 4;
          const f32x4 kg0 = *(const f32x4*)(knb + c * 8), kg1 = *(const f32x4*)(knb + c * 8 + 4);
          v4u rawn = {0u, 0u, 0u, 0u};
          if (gw * 4 < GM * 2) { const int u = gw * 4 + sub; rawn = *(const v4u*)(KB + (size_t)(u >> 1) * 256 + (u & 1) * 128 + c * 8); }
          for (int u0 = gw * 4; u0 < GM * 2; u0 += NGW * 4) {
            const int u = u0 + sub, lr = u >> 1, kvh = u & 1;
            bf16* kp = KB + (size_t)lr * 256 + kvh * 128 + c * 8;
            const v4u raw = rawn;
            if (u0 + NGW * 4 < GM * 2) { const int un = u0 + NGW * 4 + sub; rawn = *(const v4u*)(KB + (size_t)(un >> 1) * 256 + (un & 1) * 128 + c * 8); }
            float f[8];
            f[0] = __uint_as_float(raw.x << 16); f[1] = __uint_as_float(raw.x & 0xffff0000u); f[2] = __uint_as_float(raw.y << 16); f[3] = __uint_as_float(raw.y & 0xffff0000u);
            f[4] = __uint_as_float(raw.z << 16); f[5] = __uint_as_float(raw.z & 0xffff0000u); f[6] = __uint_as_float(raw.w << 16); f[7] = __uint_as_float(raw.w & 0xffff0000u);
            float ssq = 0.f;
#pragma unroll
            for (int j = 0; j < 8; ++j) ssq += f[j] * f[j];
            ssq += __shfl_xor(ssq, 1); ssq += __shfl_xor(ssq, 2); ssq += __shfl_xor(ssq, 4); ssq += __shfl_xor(ssq, 8);
            const float rstd = 1.0f / sqrtf(ssq * (1.f / 128.f) + EPS);
#pragma unroll
            for (int j = 0; j < 4; ++j) { f[j] *= rstd * kg0[j]; f[4 + j] *= rstd * kg1[j]; }
            const int t = (g == 0 || lr < G1SAMPLE) ? (lr & 4095) : ((lr - G1SAMPLE) & 8191);
            const int idx = c < 8 ? (t >> 6) : (t & 63);
            const f32x4* rp = (const f32x4*)(rt + idx * 32 + (c & 3) * 8);
            const bool second = (c & 4) != 0;
            float o8[8];
#pragma unroll
            for (int j2 = 0; j2 < 4; ++j2) { const f32x4 cs = rp[j2];
              const float pa = __shfl_xor(f[2 * j2], 4), pb = __shfl_xor(f[2 * j2 + 1], 4);
              o8[2 * j2]     = second ? (pa * cs[1] + f[2 * j2] * cs[0])     : (f[2 * j2] * cs[0] - pa * cs[1]);
              o8[2 * j2 + 1] = second ? (pb * cs[3] + f[2 * j2 + 1] * cs[2]) : (f[2 * j2 + 1] * cs[2] - pb * cs[3]); }
            v4u w; w.x = pk2(o8[0], o8[1]); w.y = pk2(o8[2], o8[3]); w.z = pk2(o8[4], o8[5]); w.w = pk2(o8[6], o8[7]);
            *(v4u*)kp = w;
          }
        }
        GRID_BAR();
        {
            char* al = (char*)lds;
            const int nS = g == 0 ? 0 : 512, nP = g == 0 ? 1536 : 512;
            for (int i = vcu; i < nS; i += G) att::item_a(QA, QA, KA, VA, ZA, tabA, subln, lam, scr, G1SAMPLE + (i >> 8) * 8192, (i & 31) * 256, (i >> 5) & 7, 8192, al);
            for (int i = vcu; i < nP; i += G) att::item_a(QA, QA, KA, VA, ZA, tabA, subln, lam, scr, (i >> 7) * 4096, (i & 15) * 256, (i >> 4) & 7, 4096, al);
            for (int i = vcu; i < nS; i += G) att::item_b(QB, QB, KB, VB, ZB, qnb, (const att::f32x2*)rt, G1SAMPLE + (i >> 8) * 8192, (i & 31) * 256, (i >> 5) & 7, 8192, al);
            for (int i = vcu; i < nP; i += G) att::item_b(QB, QB, KB, VB, ZB, qnb, (const att::f32x2*)rt, (i >> 7) * 4096, (i & 15) * 256, (i >> 4) & 7, 4096, al);
        }
        GRID_BAR();
        for (int rep_ = 0; rep_ < (PROBE == 6 ? 2 : 1); ++rep_) {
            pg8::PairOrder S; S.init(GM, 1024, G, bx);
            pg8::Gemm gm{QA, WpaT, GM, 1024, 1024, QB, WpbT}; pg8::EpiPair E{GA, GB, MERGED};
            pg8::gemm_phase<pg8::EpiPair, pg8::PairOrder, true, true>((LAS unsigned char*)lds, gm, S, E);
        }
        GRID_BAR();
        for (int rep_ = 0; rep_ < (PROBE == 6 ? 2 : 1); ++rep_) {
            pg8::StaticOrder S; S.init(GM, 1024, G, bx);
            pg8::Gemm gm{MERGED, WoutT, GM, 1024, 1024, nullptr, nullptr}; pg8::EpiOut E{a.out, gbase};
            pg8::gemm_phase<pg8::EpiOut, pg8::StaticOrder, true, true>((LAS unsigned char*)lds, gm, S, E);
        }
        if (g == NGRP - 1) GRID_BAR();
    }
    {
        int lane5 = threadIdx.x & 63; asm volatile("" : "+v"(lane5)); const int lane = lane5;
        f32x4 gv[4];
#pragma unroll
        for (int j = 0; j < 4; ++j) gv[j] = ((const f32x4*)g_final)[lane + 64 * j];
        for (int m0 = gw; m0 < NTOK; m0 += 2 * NGW) {
            f32x4 v[2][4]; float ssq[2];
#pragma unroll
            for (int q = 0; q < 2; ++q) { const int m = m0 + q * NGW; ssq[q] = 0.f; if (m >= NTOK) continue;
                const f32x4* xr = (const f32x4*)(m < NPTOK ? xp + (size_t)m * 1024 : xs + (size_t)(m - NPTOK) * 1024) + lane;
                const unsigned long long* dr = (const unsigned long long*)(a.out + (size_t)m * 1024) + lane;
#pragma unroll
                for (int j = 0; j < 4; ++j) { const unsigned long long d = dr[64 * j]; const unsigned dlo = (unsigned)d, dhi = (unsigned)(d >> 32);
                    f32x4 h = xr[64 * j];
                    h.x += __uint_as_float(dlo << 16); h.y += __uint_as_float(dlo & 0xffff0000u); h.z += __uint_as_float(dhi << 16); h.w += __uint_as_float(dhi & 0xffff0000u);
                    v[q][j] = h; ssq[q] += (h.x * h.x + h.y * h.y) + (h.z * h.z + h.w * h.w); } }
#pragma unroll
            for (int q = 0; q < 2; ++q) { const int m = m0 + q * NGW; if (m >= NTOK) continue;
                const float rstd = 1.0f / sqrtf(wave_sum(ssq[q]) * (1.f / 1024.f) + EPS);
                f32x4* yr = (f32x4*)(a.out + (size_t)m * 1024) + lane;
#pragma unroll
                for (int j = 0; j < 4; ++j) yr[64 * j] = v[q][j] * rstd * gv[j]; }
        }
    }
}

extern "C" void kernel_launch(void* const* d_in, const int* in_sizes, int n_in, void* d_out, int out_size, void* d_ws, size_t ws_size, hipStream_t stream) {
    static int grid = 0;
    if (grid == 0) {
        if (n_in != 16 || out_size != NTOK * 1024 || ws_size < WS_END) { fprintf(stderr, "kernel_launch: unexpected shapes: n_in %d out %d ws %zu (need %zu)\n", n_in, out_size, ws_size, (size_t)WS_END); grid = -1; return; }
        int dev = 0, cus = 0, per_cu = 0;
        if (hipGetDevice(&dev) != hipSuccess || hipDeviceGetAttribute(&cus, hipDeviceAttributeMultiprocessorCount, dev) != hipSuccess) { grid = -1; return; }
        if (hipFuncSetAttribute((const void*)fwd_mega, hipFuncAttributeMaxDynamicSharedMemorySize, LDS_BYTES) != hipSuccess) { fprintf(stderr, "kernel_launch: hipFuncSetAttribute failed\n"); grid = -1; return; }
        if (hipOccupancyMaxActiveBlocksPerMultiprocessor(&per_cu, (const void*)fwd_mega, NWAVES * 64, LDS_BYTES) != hipSuccess || per_cu < 1) { fprintf(stderr, "kernel_launch: occupancy query gave %d\n", per_cu); per_cu = 1; }
        (void)hipGetLastError();
        grid = cus * (per_cu > 1 ? 1 : per_cu);
    }
    if (grid < 0) return;
    Args a{};
    for (int i = 0; i < 16; ++i) a.in[i] = (const float*)d_in[i];
    a.out = (float*)d_out; a.ws = (unsigned char*)d_ws;
    if (hipMemsetAsync(d_ws, 0, 16384, stream) != hipSuccess) { fprintf(stderr, "kernel_launch: memset failed\n"); return; }
    void* args[] = {&a};
    hipError_t e = hipLaunchCooperativeKernel((const void*)fwd_mega, dim3(grid), dim3(NWAVES * 64), args, LDS_BYTES, stream);
    if (e != hipSuccess) fprintf(stderr, "kernel_launch: cooperative launch failed: %s (grid %d)\n", hipGetErrorString(e), grid);
}
```
